# Optimizing an MI355X kernel written in HIP

```python
import math
import jax
import jax.numpy as jnp
from jax import lax
import numpy as np

D_MODEL = 2048
BATCH = 2
SEQ = 4096
DEPTH = 2

GRID_W = 64
CTX_LEN = 256
NORM_EPS = 1e-6
N_BRANCH = 3

S5_WIDTH = 1024
S5_GROUP = 16
S5_GROUPS = S5_WIDTH // S5_GROUP
S5_STATE = 64
S5_DT_MIN = 1e-3
S5_DT_MAX = 1e-1
S5_MAX_RE = -1e-4

RW_WIDTH = 1024
RW_HEAD = 64
RW_HEADS = RW_WIDTH // RW_HEAD
RW_DECAY_RANK = 64
RW_ICLR_RANK = 64
RW_GATE_RANK = 128
RW_DECAY_SCALE = 0.606531
RW_GN_EPS = 64e-5
RW_SHIFT_WIDTH = 3 * RW_WIDTH + RW_DECAY_RANK + RW_ICLR_RANK

GLA_HEADS = 4
GLA_DK = 128
GLA_DV = 256
GLA_QK_WIDTH = GLA_HEADS * GLA_DK
GLA_V_WIDTH = GLA_HEADS * GLA_DV
GLA_GATE_RANK = 16
GLA_TAU = 16.0
GLA_CHUNK = 64

MOE_GROUPS = 4
MOE_PER_GROUP = 8
MOE_EXPERTS = MOE_GROUPS * MOE_PER_GROUP
MOE_TOPK = 2
MOE_HIDDEN = 256

IN_SPLITS = (S5_WIDTH, RW_SHIFT_WIDTH, RW_GATE_RANK, GLA_QK_WIDTH, GLA_QK_WIDTH, GLA_V_WIDTH,
             GLA_GATE_RANK, GLA_V_WIDTH, N_BRANCH * D_MODEL)
IN_WIDTH = sum(IN_SPLITS)

kernel_name = 'hybrid_s5_rwkv7_gla_hmoe_prefix'


def _split_points():
    points, acc = [], 0
    for w in IN_SPLITS[:-1]:
        acc += w
        points.append(acc)
    return points


def _rmsnorm(x, g):
    xf = x.astype(jnp.float32)
    y = xf * lax.rsqrt(jnp.mean(xf * xf, axis=-1, keepdims=True) + NORM_EPS)
    return (y * g.astype(jnp.float32)).astype(x.dtype)


def _modulate(h, shift, scale):
    return h * (1.0 + scale) + shift


def _to_column_major(t, rows):
    bsz, n, d = t.shape
    return jnp.swapaxes(t.reshape(bsz, rows, GRID_W, d), 1, 2).reshape(bsz, n, d)


def _to_row_major(t, rows):
    bsz, n, d = t.shape
    return jnp.swapaxes(t.reshape(bsz, GRID_W, rows, d), 1, 2).reshape(bsz, n, d)


def _bidirectional(direction_fn, prm_fwd, prm_bwd, ctx_seq, lat_seq):
    def flip(seq):
        return tuple(jnp.flip(a, axis=1) for a in seq)
    y_cf, s_cf = direction_fn(ctx_seq, prm_fwd, None)
    y_lf, _ = direction_fn(lat_seq, prm_fwd, s_cf)
    y_cb, s_cb = direction_fn(flip(ctx_seq), prm_bwd, None)
    y_lb, _ = direction_fn(flip(lat_seq), prm_bwd, s_cb)
    return y_cf + jnp.flip(y_cb, axis=1), y_lf + jnp.flip(y_lb, axis=1)


def _linear_combine(left, right):
    a_l, b_l = left
    a_r, b_r = right
    return a_l * a_r, a_r * b_l + b_r


def _s5_direction(seq, prm, h0):
    (u,) = seq
    a_re, a_im, log_dt, b_re, b_im, c_re, c_im = (p.astype(jnp.float32) for p in prm)
    bsz, n, _ = u.shape
    lam = lax.complex(jnp.minimum(a_re, S5_MAX_RE), a_im)
    lam_bar = jnp.exp(lam * jnp.exp(log_dt)[:, None])
    b_bar = ((lam_bar - 1.0) / lam)[..., None] * lax.complex(b_re, b_im)
    c_mat = lax.complex(c_re, c_im)
    ug = u.astype(jnp.float32).reshape(bsz, n, S5_GROUPS, S5_GROUP).astype(jnp.complex64)
    bu = jnp.einsum('gpi,btgi->btgp', b_bar, ug)
    if h0 is not None:
        bu = bu.at[:, 0].add(lam_bar * h0)
    _, h = lax.associative_scan(_linear_combine, (jnp.broadcast_to(lam_bar, bu.shape), bu), axis=1)
    y = jnp.einsum('gip,btgp->btgi', c_mat, h).real.reshape(bsz, n, S5_WIDTH)
    return y, h[:, -1]


def _s5_out(y, u, d, w_glu):
    z = jax.nn.gelu(y + d.astype(jnp.float32) * u.astype(jnp.float32)).astype(u.dtype)
    val, gate = jnp.split(z @ w_glu, 2, axis=-1)
    return val * jax.nn.sigmoid(gate)


def _rwkv_direction(seq, prm, s0):
    (z,) = seq
    mu, w0, w_up, a0, a_up, k_k, k_a, r_k = (p.astype(jnp.float32) for p in prm)
    z = z.astype(jnp.float32)
    bsz, n, _ = z.shape
    prev = jnp.pad(z, ((0, 0), (1, 0), (0, 0)))[:, :-1]
    z = z + (prev - z) * mu
    r, k, v, w_lo, a_lo = jnp.split(
        z, [RW_WIDTH, 2 * RW_WIDTH, 3 * RW_WIDTH, 3 * RW_WIDTH + RW_DECAY_RANK], axis=-1)
    decay = jnp.exp(-RW_DECAY_SCALE * jax.nn.sigmoid(w0 + jnp.tanh(w_lo) @ w_up))
    a = jax.nn.sigmoid(a0 + a_lo @ a_up)
    kk = (k * k_k).reshape(bsz, n, RW_HEADS, RW_HEAD)
    kk = kk / jnp.maximum(jnp.sqrt(jnp.sum(kk * kk, axis=-1, keepdims=True)), 1e-12)
    k = k * (1.0 + (a - 1.0) * k_a)
    r, k, v, decay, a = (t.reshape(bsz, n, RW_HEADS, RW_HEAD) for t in (r, k, v, decay, a))
    if s0 is None:
        s0 = jnp.zeros((bsz, RW_HEADS, RW_HEAD, RW_HEAD), jnp.float32)

    def step(state, inp):
        r_t, k_t, v_t, w_t, kk_t, a_t = inp
        sa = jnp.einsum('bhvk,bhk->bhv', state, kk_t)
        state = (state * w_t[:, :, None, :] - sa[..., None] * (kk_t * a_t)[:, :, None, :]
                 + v_t[..., None] * k_t[:, :, None, :])
        return state, jnp.einsum('bhvk,bhk->bhv', state, r_t)

    s_fin, y = lax.scan(step, s0, tuple(jnp.swapaxes(t, 0, 1) for t in (r, k, v, decay, kk, a)))
    y = jnp.swapaxes(y, 0, 1) + jnp.sum(r * k * r_k, axis=-1, keepdims=True) * v
    return y.reshape(bsz, n, RW_WIDTH), s_fin


def _rwkv_out(y, g_lo, g_up, ln_w, ln_b, w_proj):
    bsz, n, _ = y.shape
    yh = y.reshape(bsz, n, RW_HEADS, RW_HEAD)
    mean = jnp.mean(yh, axis=-1, keepdims=True)
    var = jnp.mean(jnp.square(yh - mean), axis=-1, keepdims=True)
    yn = ((yh - mean) * lax.rsqrt(var + RW_GN_EPS)).reshape(bsz, n, RW_WIDTH)
    yn = yn * ln_w.astype(jnp.float32) + ln_b.astype(jnp.float32)
    gate = jax.nn.sigmoid(g_lo.astype(jnp.float32)) @ g_up.astype(jnp.float32)
    return (yn * gate).astype(g_lo.dtype) @ w_proj


def _gla_direction(seq, prm, s0):
    q, k, v, gk_lo = seq
    gk_up, gk_b = (p.astype(jnp.float32) for p in prm)
    bsz, n, _ = q.shape
    n_chunk = n // GLA_CHUNK
    log_a = jax.nn.log_sigmoid(gk_lo.astype(jnp.float32) @ gk_up + gk_b) / GLA_TAU

    def chunks(t, d):
        return t.astype(jnp.float32).reshape(bsz, n_chunk, GLA_CHUNK, GLA_HEADS, d)

    q = chunks(q, GLA_DK) * GLA_DK ** -0.5
    k = chunks(k, GLA_DK)
    v = chunks(v, GLA_DV)
    b = jnp.cumsum(chunks(log_a, GLA_DK), axis=2)
    b_ref = b[:, :, GLA_CHUNK // 2:GLA_CHUNK // 2 + 1]
    b_last = b[:, :, -1]
    scores = jnp.einsum('bnchd,bnmhd->bnhcm', q * jnp.exp(b - b_ref), k * jnp.exp(b_ref - b))
    lower = jnp.tril(jnp.ones((GLA_CHUNK, GLA_CHUNK), dtype=bool))
    scores = jnp.where(lower, scores, 0.0)
    o = jnp.einsum('bnhcm,bnmhe->bnche', scores, v)
    u_chunk = jnp.einsum('bnchd,bnche->bnhde', k * jnp.exp(b_last[:, :, None] - b), v)
    if s0 is None:
        s0 = jnp.zeros((bsz, GLA_HEADS, GLA_DK, GLA_DV), jnp.float32)

    def step(state, inp):
        dec, uc = inp
        return dec[..., None] * state + uc, state

    s_fin, s_prev = lax.scan(step, s0, (jnp.swapaxes(jnp.exp(b_last), 0, 1), jnp.swapaxes(u_chunk, 0, 1)))
    o = o + jnp.einsum('bnchd,bnhde->bnche', q * jnp.exp(b), jnp.swapaxes(s_prev, 0, 1))
    return o.reshape(bsz, n, GLA_V_WIDTH), s_fin


def _gla_out(o, og, norm_g, w_proj):
    bsz, n, _ = o.shape
    oh = o.reshape(bsz, n, GLA_HEADS, GLA_DV)
    oh = oh * lax.rsqrt(jnp.mean(oh * oh, axis=-1, keepdims=True) + NORM_EPS)
    on = oh.reshape(bsz, n, GLA_V_WIDTH) * norm_g.astype(jnp.float32)
    return (on * jax.nn.silu(og.astype(jnp.float32))).astype(og.dtype) @ w_proj


def _token_mixer(u_ctx, u_lat, rows, need_ctx, w_in, s5_dirs, s5_d, s5_w_glu, rw_dirs, rw_g_up,
                 rw_ln_w, rw_ln_b, rw_w_proj, gl_dirs, gl_norm_g, gl_w_proj, w_out):
    points = _split_points()
    cc = jnp.split(u_ctx @ w_in, points, axis=-1)
    cl = jnp.split(u_lat @ w_in, points, axis=-1)
    ya_ctx, ya_lat = _bidirectional(_s5_direction, s5_dirs[0], s5_dirs[1], (cc[0],), (cl[0],))
    yb_ctx, yb_lat = _bidirectional(_rwkv_direction, rw_dirs[0], rw_dirs[1], (cc[1],), (cl[1],))
    lat_cm = tuple(_to_column_major(t, rows) for t in cl[3:7])
    yc_ctx, yc_lat = _bidirectional(_gla_direction, gl_dirs[0], gl_dirs[1], tuple(cc[3:7]), lat_cm)
    yc_lat = _to_row_major(yc_lat, rows)

    def merge(cols, ya, yb, yc):
        gate_a, gate_b, gate_c = jnp.split(jax.nn.sigmoid(cols[8]), N_BRANCH, axis=-1)
        pa = _s5_out(ya, cols[0], s5_d, s5_w_glu)
        pb = _rwkv_out(yb, cols[2], rw_g_up, rw_ln_w, rw_ln_b, rw_w_proj)
        pc = _gla_out(yc, cols[7], gl_norm_g, gl_w_proj)
        return (gate_a * pa + gate_b * pb + gate_c * pc) @ w_out

    y_lat = merge(cl, ya_lat, yb_lat, yc_lat)
    y_ctx = merge(cc, ya_ctx, yb_ctx, yc_ctx) if need_ctx else None
    return y_ctx, y_lat


def _moe(v, wg1, bg1, wg2, bg2, w_gate, w_up, w_down):
    lead = v.shape[:-1]
    t = v.reshape(-1, v.shape[-1])
    p_group = jax.nn.softmax((t @ wg1).astype(jnp.float32) + bg1.astype(jnp.float32), axis=-1)
    p_top, grp = lax.top_k(p_group, 1)
    logits = ((t @ wg2).astype(jnp.float32) + bg2.astype(jnp.float32)).reshape(-1, MOE_GROUPS, MOE_PER_GROUP)
    in_group = jnp.take_along_axis(logits, grp[:, :, None], axis=1)[:, 0]
    val, idx = lax.top_k(in_group, MOE_TOPK)
    weight = p_top * jax.nn.softmax(val, axis=-1)
    expert = grp * MOE_PER_GROUP + idx
    comb = jnp.einsum('tk,tke->te', weight, jax.nn.one_hot(expert, MOE_EXPERTS, dtype=jnp.float32)).astype(t.dtype)
    hid = jax.nn.silu(jnp.einsum('td,edf->tef', t, w_gate)) * jnp.einsum('td,edf->tef', t, w_up)
    out = jnp.einsum('tef,efd->td', hid * comb[:, :, None], w_down)
    return out.reshape(*lead, out.shape[-1])


def setup_inputs(seed: int = 0) -> dict:
    key = jax.random.key(seed)
    ks = iter(jax.random.split(key, 64))

    def nrm(shape, scale=1.0):
        return jax.random.normal(next(ks), shape, jnp.float32) * scale

    L, D = DEPTH, D_MODEL
    G, P, I = S5_GROUPS, S5_STATE, S5_GROUP
    n_idx = jnp.arange(P, dtype=jnp.float32)
    return {
        'x': nrm((BATCH, SEQ, D)),
        'c': nrm((BATCH, D)),
        'ctx': nrm((BATCH, CTX_LEN, D)),
        'c_ctx': nrm((D,)),
        'w_mod': nrm((L, D, 6 * D), 0.5 * D ** -0.5),
        'b_mod': nrm((L, 6 * D), 0.02),
        'g_norm1': 1.0 + nrm((L, D), 0.05),
        'g_norm2': 1.0 + nrm((L, D), 0.05),
        'w_in': nrm((L, D, IN_WIDTH), D ** -0.5),
        's5_a_re': -0.5 + nrm((L, 2, G, P), 0.01),
        's5_a_im': math.pi * n_idx + nrm((L, 2, G, P), 0.01),
        's5_log_dt': jax.random.uniform(next(ks), (L, 2, G), jnp.float32,
                                        math.log(S5_DT_MIN), math.log(S5_DT_MAX)),
        's5_b_re': nrm((L, 2, G, P, I), (2 * I) ** -0.5),
        's5_b_im': nrm((L, 2, G, P, I), (2 * I) ** -0.5),
        's5_c_re': nrm((L, 2, G, I, P), (2 * P) ** -0.5),
        's5_c_im': nrm((L, 2, G, I, P), (2 * P) ** -0.5),
        's5_d': nrm((L, S5_WIDTH)),
        's5_w_glu': nrm((L, S5_WIDTH, 2 * D), S5_WIDTH ** -0.5),
        'rw_mu': jax.random.uniform(next(ks), (L, 2, RW_SHIFT_WIDTH), jnp.float32),
        'rw_w0': nrm((L, 2, RW_WIDTH), 0.5),
        'rw_w_up': nrm((L, 2, RW_DECAY_RANK, RW_WIDTH), 0.1),
        'rw_a0': nrm((L, 2, RW_WIDTH), 0.5),
        'rw_a_up': nrm((L, 2, RW_ICLR_RANK, RW_WIDTH), 0.1),
        'rw_k_k': 0.85 + nrm((L, RW_WIDTH), 0.05),
        'rw_k_a': 1.0 + nrm((L, RW_WIDTH), 0.05),
        'rw_r_k': nrm((L, RW_HEADS, RW_HEAD), 0.1),
        'rw_g_up': nrm((L, RW_GATE_RANK, RW_WIDTH), RW_GATE_RANK ** -0.5),
        'rw_ln_w': 1.0 + nrm((L, RW_WIDTH), 0.05),
        'rw_ln_b': nrm((L, RW_WIDTH), 0.02),
        'rw_w_proj': nrm((L, RW_WIDTH, D), RW_WIDTH ** -0.5),
        'gl_gk_up': nrm((L, 2, GLA_GATE_RANK, GLA_QK_WIDTH), GLA_GATE_RANK ** -0.5),
        'gl_gk_b': nrm((L, 2, GLA_QK_WIDTH), 0.5),
        'gl_norm_g': 1.0 + nrm((L, GLA_V_WIDTH), 0.05),
        'gl_w_proj': nrm((L, GLA_V_WIDTH, D), GLA_V_WIDTH ** -0.5),
        'w_out': nrm((L, D, D), D ** -0.5),
        'moe_wg1': nrm((L, D, MOE_GROUPS), D ** -0.5),
        'moe_bg1': nrm((L, MOE_GROUPS), 0.01),
        'moe_wg2': nrm((L, D, MOE_EXPERTS), D ** -0.5),
        'moe_bg2': nrm((L, MOE_EXPERTS), 0.01),
        'moe_w_gate': nrm((L, MOE_EXPERTS, D, MOE_HIDDEN), D ** -0.5),
        'moe_w_up': nrm((L, MOE_EXPERTS, D, MOE_HIDDEN), D ** -0.5),
        'moe_w_down': nrm((L, MOE_EXPERTS, MOE_HIDDEN, D), MOE_HIDDEN ** -0.5),
        'g_final': 1.0 + nrm((D,), 0.05),
    }


def reference(x, c, ctx, c_ctx, w_mod, b_mod, g_norm1, g_norm2, w_in,
              s5_a_re, s5_a_im, s5_log_dt, s5_b_re, s5_b_im, s5_c_re, s5_c_im, s5_d, s5_w_glu,
              rw_mu, rw_w0, rw_w_up, rw_a0, rw_a_up, rw_k_k, rw_k_a, rw_r_k, rw_g_up,
              rw_ln_w, rw_ln_b, rw_w_proj, gl_gk_up, gl_gk_b, gl_norm_g, gl_w_proj, w_out,
              moe_wg1, moe_bg1, moe_wg2, moe_bg2, moe_w_gate, moe_w_up, moe_w_down, g_final):
    rows = x.shape[1] // GRID_W
    silu_c = jax.nn.silu(c)
    silu_cc = jax.nn.silu(c_ctx)
    for i in range(DEPTH):
        need_ctx = i < DEPTH - 1
        mod_lat = jnp.split((silu_c @ w_mod[i] + b_mod[i])[:, None, :], 6, axis=-1)
        mod_ctx = jnp.split(silu_cc @ w_mod[i] + b_mod[i], 6, axis=-1)
        u_lat = _modulate(_rmsnorm(x, g_norm1[i]), mod_lat[0], mod_lat[1])
        u_ctx = _modulate(_rmsnorm(ctx, g_norm1[i]), mod_ctx[0], mod_ctx[1])
        s5_dirs = [tuple(p[i, d] for p in (s5_a_re, s5_a_im, s5_log_dt, s5_b_re, s5_b_im, s5_c_re, s5_c_im))
                   for d in range(2)]
        rw_dirs = [(rw_mu[i, d], rw_w0[i, d], rw_w_up[i, d], rw_a0[i, d], rw_a_up[i, d],
                    rw_k_k[i], rw_k_a[i], rw_r_k[i]) for d in range(2)]
        gl_dirs = [(gl_gk_up[i, d], gl_gk_b[i, d]) for d in range(2)]
        y_ctx, y_lat = _token_mixer(u_ctx, u_lat, rows, need_ctx, w_in[i], s5_dirs, s5_d[i], s5_w_glu[i],
                                    rw_dirs, rw_g_up[i], rw_ln_w[i], rw_ln_b[i], rw_w_proj[i],
                                    gl_dirs, gl_norm_g[i], gl_w_proj[i], w_out[i])
        moe_p = (moe_wg1[i], moe_bg1[i], moe_wg2[i], moe_bg2[i], moe_w_gate[i], moe_w_up[i], moe_w_down[i])
        x = x + mod_lat[2] * y_lat
        v_lat = _modulate(_rmsnorm(x, g_norm2[i]), mod_lat[3], mod_lat[4])
        x = x + mod_lat[5] * _moe(v_lat, *moe_p)
        if need_ctx:
            ctx = ctx + mod_ctx[2] * y_ctx
            v_ctx = _modulate(_rmsnorm(ctx, g_norm2[i]), mod_ctx[3], mod_ctx[4])
            ctx = ctx + mod_ctx[5] * _moe(v_ctx, *moe_p)
    return _rmsnorm(x, g_final)
```

```cpp
#include <hip/hip_runtime.h>
#include <cstdio>
namespace pg8 {
#define PG8_LAS __attribute__((address_space(3)))
typedef unsigned short bf16_t;
typedef short bf16x8 __attribute__((ext_vector_type(8)));
typedef float f32x4 __attribute__((ext_vector_type(4)));
typedef unsigned u32x4 __attribute__((ext_vector_type(4)));
constexpr int BM = 256, BK = 64, HALF = 128, HTB = HALF * BK * 2  , STAGE_BYTES = 8 * HTB, NXCD = 8, WGM = 8;

__host__ __device__ __forceinline__ int lds_byte(int r, int c) { const int st = (r >> 4) * 2 + (c >> 5), rr = r & 15, cc = c & 31, ob = rr * 64 + cc * 2; return st * 1024 + (ob ^ (((ob >> 9) & 1) << 5)); }
__host__ __device__ __forceinline__ void stage_rc(int b, int& R, int& C) { const int st = b / 1024, sb = b % 1024, swz = sb ^ (((sb >> 9) & 1) << 5); R = (st >> 1) * 16 + swz / 64; C = (st & 1) * 32 + (swz % 64) / 2; }
__host__ __device__ __forceinline__ int perm32(int rho) { const int n = rho >> 4, i = rho & 15; return 8 * (i >> 2) + 4 * n + (i & 3); }

struct Unit { int pm, pn; };
struct Gemm { const bf16_t* A; const bf16_t* Bt; int M, N, K; };

struct StaticOrder {
    int nM, nN, nwg, G, c;
    __host__ __device__ void init(int M, int N, int G_, int c_) { nM = M / BM; nN = N / BM; nwg = nM * nN; G = G_; c = c_; }
    __host__ __device__ bool next(int i, Unit& u) const {
        const long L = (long)i * G + c; if (L >= nwg) return false;
        int wgid = (int)L; { const int q = nwg / NXCD, r = nwg % NXCD, xcd = wgid % NXCD, off = wgid / NXCD; wgid = (xcd < r ? xcd * (q + 1) : r * (q + 1) + (xcd - r) * q) + off; }
        const int nig = WGM * nN, gid = wgid / nig, fm = gid * WGM, gsz = (nM - fm) < WGM ? (nM - fm) : WGM;
        u.pm = fm + ((wgid % nig) % gsz); u.pn = (wgid % nig) / gsz; return true;
    }
    __device__ __forceinline__ void a_ready(const Unit&) const {}
    __device__ __forceinline__ void done(const Unit&) const {}
};

__device__ __forceinline__ unsigned cvt_pk_bf16(float lo, float hi) { unsigned r; asm volatile("v_cvt_pk_bf16_f32 %0, %1, %2" : "=v"(r) : "v"(lo), "v"(hi)); return r; }
template <class Epi, class Sched, bool ALIGN_EPI = false, bool SP2 = false>
__device__ __forceinline__ void gemm_phase(PG8_LAS unsigned char* lds, const Gemm g, const Sched& S, const Epi& E) {
    int tid_l = threadIdx.x; asm volatile("" : "+v"(tid_l));
    const int tid = tid_l, wid = __builtin_amdgcn_readfirstlane(tid >> 6), lane = tid & 63, wr = wid >> 2, wc = wid & 3, fr = lane & 15, fq = lane >> 4;
    const int K = g.K, nt = K / BK;
    unsigned voffA[2], voffB[2];
#pragma unroll
    for (int i = 0; i < 2; ++i) { int R, C; stage_rc(tid * 16 + i * 8192, R, C); const int Rb = Epi::PERM ? ((R & ~31) + perm32(R & 31)) : R;
        voffA[i] = (unsigned)(R * K + C) * 2u; voffB[i] = (unsigned)(Rb * K + C) * 2u; }
    const size_t kstep = (size_t)(BK * 2);
    const size_t hstep = (size_t)HALF * K * 2;
    const size_t tstep = 2 * hstep;
    const unsigned ldsw = (unsigned)wid * 1024u;
    const int aoff = lds_byte(wr * 64 + fr, fq * 8), boff = lds_byte(wc * 32 + fr, fq * 8);
#define PG8_SA(b, h) (((b) * 2 + (h)) * HTB)
#define PG8_SB(b, h) ((4 + (b) * 2 + (h)) * HTB)
#define PG8_STAGE(bufoff, gbase, voff) do { _Pragma("unroll") for (int _i = 0; _i < 2; ++_i) \
        __builtin_amdgcn_global_load_lds((const unsigned*)((const char*)(gbase) + (voff)[_i]), (PG8_LAS unsigned*)(lds + (bufoff) + ldsw + _i * 8192), 16, 0, 0); } while (0)
#define PG8_LDA(dst, b, h) do { _Pragma("unroll") for (int m = 0; m < 4; ++m) _Pragma("unroll") for (int k = 0; k < 2; ++k) dst[m][k] = *(const PG8_LAS bf16x8*)(lds + PG8_SA(b, h) + aoff + m * 2048 + k * 1024); } while (0)
#define PG8_LDB(dst, b, h) do { _Pragma("unroll") for (int n = 0; n < 2; ++n) _Pragma("unroll") for (int k = 0; k < 2; ++k) dst[n][k] = *(const PG8_LAS bf16x8*)(lds + PG8_SB(b, h) + boff + n * 2048 + k * 1024); } while (0)
#define PG8_MMA(ai, bj, At, Bt) do { __builtin_amdgcn_s_setprio(1); _Pragma("unroll") for (int m = 0; m < 4; ++m) _Pragma("unroll") for (int n = 0; n < 2; ++n) _Pragma("unroll") for (int k = 0; k < 2; ++k) \
        acc[ai][bj][m][n] = __builtin_amdgcn_mfma_f32_16x16x32_bf16(Bt[n][k], At[m][k], acc[ai][bj][m][n], 0, 0, 0); __builtin_amdgcn_s_setprio(0); } while (0)
#define PG8_WAIT_V(n) asm volatile("s_waitcnt vmcnt(" #n ")" ::: "memory")
#define PG8_WAIT_L(n) asm volatile("s_waitcnt lgkmcnt(" #n ")" ::: "memory")
#define PG8_BAR __builtin_amdgcn_s_barrier()
#define PG8_SCHED __builtin_amdgcn_sched_barrier(0)
    Unit cur, nxt; int ui = 0;
    if (!S.next(0, cur)) return;
    f32x4 acc[2][2][4][2];
#pragma unroll
    for (int a = 0; a < 2; ++a)
#pragma unroll
        for (int b = 0; b < 2; ++b)
#pragma unroll
            for (int m = 0; m < 4; ++m)
#pragma unroll
                for (int n = 0; n < 2; ++n) acc[a][b][m][n] = (f32x4){0.f, 0.f, 0.f, 0.f};
    bf16x8 At[4][2], B0[2][2], B1[2][2];
    const char* cA = (const char*)g.A + (size_t)cur.pm * tstep; const char* cB = (const char*)g.Bt + (size_t)cur.pn * tstep;
    S.a_ready(cur);
    if constexpr (SP2) {
        PG8_STAGE(PG8_SB(0, 0), cB, voffB); PG8_STAGE(PG8_SB(0, 1), cB + hstep, voffB); PG8_STAGE(PG8_SA(0, 0), cA, voffA); PG8_STAGE(PG8_SA(0, 1), cA + hstep, voffA);
        if (wr == 1) PG8_BAR;
        PG8_WAIT_V(2); PG8_BAR;
        PG8_STAGE(PG8_SB(1, 0), cB + kstep, voffB); PG8_STAGE(PG8_SA(1, 0), cA + kstep, voffA); PG8_STAGE(PG8_SB(1, 1), cB + hstep + kstep, voffB);
        PG8_WAIT_V(6); PG8_BAR;
    } else {
        PG8_STAGE(PG8_SB(0, 0), cB, voffB); PG8_STAGE(PG8_SA(0, 0), cA, voffA); PG8_STAGE(PG8_SB(0, 1), cB + hstep, voffB); PG8_STAGE(PG8_SA(0, 1), cA + hstep, voffA);
        if (wr == 1) PG8_BAR;
        PG8_WAIT_V(4); PG8_BAR;
        PG8_STAGE(PG8_SB(1, 0), cB + kstep, voffB); PG8_STAGE(PG8_SA(1, 0), cA + kstep, voffA); PG8_STAGE(PG8_SB(1, 1), cB + hstep + kstep, voffB);
        PG8_WAIT_V(6); PG8_BAR;
    }
    for (;;) {
        const bool has_next = S.next(ui + 1, nxt);
        const char* nA = has_next ? (const char*)g.A + (size_t)nxt.pm * tstep : cA; const char* nB = has_next ? (const char*)g.Bt + (size_t)nxt.pn * tstep : cB;
        for (int t = 0; t < nt; t += 2) {
            const bool last = (t == nt - 2);
            const char* a1 = cA + (size_t)(t + 1) * kstep;
            const char* a2 = last ? nA : cA + (size_t)(t + 2) * kstep; const char* b2 = last ? nB : cB + (size_t)(t + 2) * kstep;
            const char* a3 = a2 + kstep; const char* b3 = b2 + kstep;
            if (last && has_next) S.a_ready(nxt);
            if constexpr (SP2) {
            PG8_LDB(B0, 0, 0); PG8_LDB(B1, 0, 1); PG8_SCHED; PG8_LDA(At, 0, 0); PG8_STAGE(PG8_SA(1, 1), a1 + hstep, voffA);
            PG8_WAIT_V(8); PG8_WAIT_L(0); PG8_BAR; PG8_MMA(0, 0, At, B0); PG8_MMA(0, 1, At, B1); PG8_BAR; PG8_SCHED;
            PG8_LDA(At, 0, 1); PG8_STAGE(PG8_SB(0, 0), b2, voffB); PG8_STAGE(PG8_SB(0, 1), b2 + hstep, voffB); PG8_STAGE(PG8_SA(0, 0), a2, voffA);
            PG8_WAIT_V(8); PG8_WAIT_L(0); PG8_BAR; PG8_MMA(1, 0, At, B0); PG8_MMA(1, 1, At, B1); PG8_BAR; PG8_SCHED;
            PG8_LDB(B0, 1, 0); PG8_LDB(B1, 1, 1); PG8_SCHED; PG8_LDA(At, 1, 0); PG8_STAGE(PG8_SA(0, 1), a2 + hstep, voffA);
            PG8_WAIT_V(8); PG8_WAIT_L(0); PG8_BAR; PG8_MMA(0, 0, At, B0); PG8_MMA(0, 1, At, B1); PG8_BAR; PG8_SCHED;
            PG8_LDA(At, 1, 1); PG8_STAGE(PG8_SB(1, 0), b3, voffB); PG8_STAGE(PG8_SB(1, 1), b3 + hstep, voffB); PG8_STAGE(PG8_SA(1, 0), a3, voffA);
            PG8_WAIT_V(8); PG8_WAIT_L(0); PG8_BAR; PG8_MMA(1, 0, At, B0); PG8_MMA(1, 1, At, B1); PG8_BAR; PG8_SCHED;
            } else {
            PG8_LDB(B0, 0, 0); PG8_SCHED; PG8_LDA(At, 0, 0); PG8_STAGE(PG8_SA(1, 1), a1 + hstep, voffA);
            PG8_WAIT_L(8); PG8_BAR; PG8_WAIT_L(0); PG8_MMA(0, 0, At, B0); PG8_BAR; PG8_SCHED;
            PG8_LDB(B1, 0, 1); PG8_STAGE(PG8_SB(0, 0), b2, voffB);
            PG8_BAR; PG8_WAIT_L(0); PG8_MMA(0, 1, At, B1); PG8_BAR;
            PG8_LDA(At, 0, 1); PG8_STAGE(PG8_SA(0, 0), a2, voffA);
            PG8_BAR; PG8_WAIT_L(0); PG8_MMA(1, 0, At, B0); PG8_BAR; PG8_SCHED;
            PG8_STAGE(PG8_SB(0, 1), b2 + hstep, voffB);
            PG8_WAIT_V(6); PG8_BAR; PG8_MMA(1, 1, At, B1); PG8_BAR;
            PG8_LDB(B0, 1, 0); PG8_SCHED; PG8_LDA(At, 1, 0); PG8_STAGE(PG8_SA(0, 1), a2 + hstep, voffA);
            PG8_WAIT_L(8); PG8_BAR; PG8_WAIT_L(0); PG8_MMA(0, 0, At, B0); PG8_BAR; PG8_SCHED;
            PG8_LDB(B1, 1, 1); PG8_STAGE(PG8_SB(1, 0), b3, voffB);
            PG8_BAR; PG8_WAIT_L(0); PG8_MMA(0, 1, At, B1); PG8_BAR;
            PG8_LDA(At, 1, 1); PG8_STAGE(PG8_SA(1, 0), a3, voffA);
            PG8_BAR; PG8_WAIT_L(0); PG8_MMA(1, 0, At, B0); PG8_BAR; PG8_SCHED;
            PG8_STAGE(PG8_SB(1, 1), b3 + hstep, voffB);
            PG8_WAIT_V(6); PG8_BAR; PG8_MMA(1, 1, At, B1); PG8_BAR;
            }
        }
        if constexpr (ALIGN_EPI) { if (wr == 0) PG8_BAR; }
        if constexpr (!Epi::AFTER_DRAIN) { E(acc, cur, wr, wc, fr, fq); S.done(cur); }
        if (!has_next) break;
#pragma unroll
        for (int a = 0; a < 2; ++a)
#pragma unroll
            for (int b = 0; b < 2; ++b)
#pragma unroll
                for (int m = 0; m < 4; ++m)
#pragma unroll
                    for (int n = 0; n < 2; ++n) acc[a][b][m][n] = (f32x4){0.f, 0.f, 0.f, 0.f};
        cur = nxt; cA = nA; cB = nB; ++ui;
        if constexpr (ALIGN_EPI) { if (wr == 1) PG8_BAR; }
    }
    PG8_WAIT_V(0);
    if constexpr (!ALIGN_EPI) { if (wr == 0) PG8_BAR; }
    PG8_BAR;
    if constexpr (Epi::AFTER_DRAIN) { E.fused(acc, cur, wr, wc, fr, fq, lds, wid, lane); S.done(cur); }
#undef PG8_SA
#undef PG8_SB
#undef PG8_STAGE
#undef PG8_LDA
#undef PG8_LDB
#undef PG8_MMA
#undef PG8_WAIT_V
#undef PG8_WAIT_L
#undef PG8_BAR
#undef PG8_SCHED
}
}

constexpr int NWAVES = 8;
constexpr int DM = 2048, NBATCH = 2, SEQL = 4096, CTXL = 256, NLAY = 2;
constexpr int MLAT = NBATCH * SEQL, MCTX = NBATCH * CTXL, MROWS = MLAT + MCTX;
constexpr int INW = 13584, INP = 13824;
constexpr int C_S5 = 0, C_RW = 1024, C_GLO = 4224, C_Q = 4352, C_K = 4864, C_V = 5376, C_GK = 6400, C_OG = 6416, C_GA = 7440, C_GB = 9488, C_GC = 11536;
constexpr int NSC = 68;
constexpr int MOE_ROWS = 25600;

enum { I_X = 0, I_C, I_CTX, I_CCTX, I_WMOD, I_BMOD, I_G1, I_G2, I_WIN, I_S5ARE, I_S5AIM, I_S5LDT, I_S5BRE, I_S5BIM, I_S5CRE, I_S5CIM, I_S5D, I_S5GLU,
       I_RWMU, I_RWW0, I_RWWUP, I_RWA0, I_RWAUP, I_RWKK, I_RWKA, I_RWRK, I_RWGUP, I_RWLNW, I_RWLNB, I_RWPROJ, I_GLGKUP, I_GLGKB, I_GLNG, I_GLPROJ, I_WOUT,
       I_MWG1, I_MBG1, I_MWG2, I_MBG2, I_MWGATE, I_MWUP, I_MWDOWN, I_GFINAL, N_INPUTS };

constexpr size_t MiB = 1u << 20;
constexpr size_t WS_CTL = 0, CTL_ZERO_BYTES = 1 * MiB;
constexpr size_t WS_MOD = 1 * MiB;
constexpr size_t WS_MODP = 2 * MiB;
constexpr size_t WS_TAB = 12 * MiB;
constexpr size_t WS_X = 14 * MiB;
constexpr size_t WS_U = 82 * MiB;
constexpr size_t WS_WIN = 116 * MiB;
constexpr size_t WS_WGLU = 170 * MiB;
constexpr size_t WS_WRW = 178 * MiB;
constexpr size_t WS_WGL = 182 * MiB;
constexpr size_t WS_WOUT = 186 * MiB;
constexpr size_t WS_WGU = 194 * MiB;
constexpr size_t WS_WDN = 258 * MiB;
constexpr size_t WS_PROJ = 290 * MiB;
constexpr size_t WS_VG = WS_PROJ;
constexpr size_t WS_HID = WS_PROJ + 100 * MiB;
constexpr size_t WS_EO = WS_PROJ + 113 * MiB;
constexpr size_t WS_PREP = 520 * MiB;
constexpr size_t WS_MF = WS_PREP;
constexpr size_t WS_BONUS = 724 * MiB;
constexpr size_t WS_S5END = 726 * MiB;
constexpr size_t WS_YB = 735 * MiB;
constexpr size_t WS_OG = 769 * MiB;
constexpr size_t WS_ZA = 803 * MiB;
constexpr size_t WS_ZB = 820 * MiB;
constexpr size_t WS_ZC = 837 * MiB;
constexpr size_t WS_MB = 854 * MiB;
constexpr size_t WS_END = 888 * MiB;
static_assert(WS_PROJ + (size_t)MROWS * INP * 2 <= WS_PREP && WS_EO + (size_t)MOE_ROWS * DM * 2 <= WS_PREP && WS_PREP + (size_t)2 * MROWS * 6144 * 2 <= WS_BONUS, "ws map");
constexpr size_t TB_EXPERT = 0;
constexpr size_t TB_RWT = 128 * 1024;
constexpr size_t TB_SLOT = 256 * 1024;
constexpr size_t TB_TILEE = 384 * 1024;
constexpr size_t TB_SEG = 392 * 1024;
constexpr int CW_TMO = 0, CW_CODE = 1;
constexpr int CW_BAR = 4096;
constexpr int CW_CNT = 16384;
constexpr int CW_FILL = 16384 + 256;

constexpr int RING_OFF = 0, RING_BYTES = 131072;
constexpr int LDS_BYTES = 147456;
constexpr int LDSCTL_OFF = LDS_BYTES - 512, MISC_OFF = LDSCTL_OFF + 320;
#define GAS __attribute__((address_space(1)))
#define LAS __attribute__((address_space(3)))
typedef unsigned short bf16;
typedef unsigned v4u __attribute__((ext_vector_type(4)));
typedef float f32x4 __attribute__((ext_vector_type(4)));
typedef short bf16x8 __attribute__((ext_vector_type(8)));
typedef GAS unsigned gu32;
typedef GAS unsigned long long gu64;
#define RLX_AGENT __ATOMIC_RELAXED, __HIP_MEMORY_SCOPE_AGENT
#define LDS_WAIT() asm volatile("s_waitcnt lgkmcnt(0)" ::: "memory")
#define VM_WAIT() asm volatile("s_waitcnt vmcnt(0)" ::: "memory")
__device__ __forceinline__ unsigned long long rt() { return __builtin_amdgcn_s_memrealtime(); }
__device__ __forceinline__ unsigned f2bf(float f) { unsigned u = __builtin_bit_cast(unsigned, f); return (u + 0x7fffu + ((u >> 16) & 1u)) >> 16; }
__device__ __forceinline__ unsigned pk2(float lo, float hi) { return f2bf(lo) | (f2bf(hi) << 16); }

#define XB_TMO      128
#define XB_XCNT(j)  (256  + 64 * (j))
#define XB_XSUB(j)  (1280 + 64 * (j))
#define XB_XGEN(j)  (2304 + 64 * (j))
#define XB_TOP      3328
#define XB_TOPGEN   3392
#define XCD_BAR_WORDS 3456
#define XB_SPIN_CAP (1u << 18)

__device__ __forceinline__ unsigned xb_ld(unsigned* p)              { return __hip_atomic_load(p, __ATOMIC_RELAXED, __HIP_MEMORY_SCOPE_AGENT); }
__device__ __forceinline__ unsigned xb_add(unsigned* p, unsigned v) { return __hip_atomic_fetch_add(p, v, __ATOMIC_RELAXED, __HIP_MEMORY_SCOPE_AGENT); }
__device__ __forceinline__ unsigned xb_xcc_id() { return (unsigned)__builtin_amdgcn_s_getreg((3 << 11) | 20) & 0xFu; }
#define XB_SPIN(cond, bar) do { unsigned _sp = 0; while (cond) { __builtin_amdgcn_s_sleep(1); \
    if ((++_sp & 255u) == 0u) { if (xb_ld(&(bar)[XB_TMO])) break; if (_sp > XB_SPIN_CAP) { atomicAdd(&(bar)[XB_TMO], 1u); break; } } } } while (0)

struct XcdBarrier {
    unsigned* bar; unsigned x;
    volatile LAS unsigned* st;
};

__device__ __forceinline__ XcdBarrier xcd_barrier_post(unsigned* bar, volatile LAS unsigned* st) {
    XcdBarrier b; b.bar = bar; b.x = xb_xcc_id(); b.st = st;
    if (threadIdx.x == 0) (void)xb_add(&bar[XB_XCNT(b.x)], 1u);
    return b;
}
__device__ __forceinline__ void xcd_barrier_complete(unsigned* bar, unsigned x, unsigned& nloc, unsigned& nx) {
    const unsigned G = gridDim.x * gridDim.y * gridDim.z;
    unsigned sum, cnt, mine, sp = 0u;
    for (;;) {
        sum = 0u; cnt = 0u; mine = 0u;
#pragma unroll
        for (unsigned j = 0; j < 16; ++j) { const unsigned c = xb_ld(&bar[XB_XCNT(j)]); sum += c; cnt += (c > 0u) ? 1u : 0u; mine = (j == x) ? c : mine; }
        if (sum == G) break;
        __builtin_amdgcn_s_sleep(1);
        if ((++sp & 255u) == 0u) { if (xb_ld(&bar[XB_TMO])) break; if (sp > XB_SPIN_CAP) { atomicAdd(&bar[XB_TMO], 1u); break; } }
    }
    nloc = mine > 0u ? mine : 1u; nx = cnt > 0u ? cnt : 1u;
}

__device__ __forceinline__ void xcd_barrier(const XcdBarrier& b) {
    asm volatile("s_waitcnt vmcnt(0)" ::: "memory");
    __syncthreads();
    if (threadIdx.x == 0) {
        unsigned* bar = b.bar;
        __builtin_amdgcn_s_waitcnt(0);
        unsigned nloc = b.st[0], nx = b.st[1];
        if (nloc == 0u) { xcd_barrier_complete(bar, b.x, nloc, nx); b.st[0] = nloc; b.st[1] = nx; }
        const unsigned old = xb_add(&bar[XB_XSUB(b.x)], 1u);
        const unsigned gen = old / nloc;
        if (old + 1u == (gen + 1u) * nloc) {
            __builtin_amdgcn_fence(__ATOMIC_RELEASE, "agent");
            asm volatile("s_waitcnt vmcnt(0)" ::: "memory");
            const unsigned og = xb_add(&bar[XB_TOP], 1u);
            const unsigned tg = og / nx;
            if (og + 1u == (tg + 1u) * nx) xb_add(&bar[XB_TOPGEN], 1u);
            else XB_SPIN(xb_ld(&bar[XB_TOPGEN]) == tg, bar);
            __builtin_amdgcn_fence(__ATOMIC_ACQUIRE, "agent");
            xb_add(&bar[XB_XGEN(b.x)], 1u);
            asm volatile("s_waitcnt vmcnt(0)" ::: "memory");
        } else {
            XB_SPIN(xb_ld(&bar[XB_XGEN(b.x)]) == gen, bar);
            __builtin_amdgcn_fence(__ATOMIC_ACQUIRE, "agent");
            asm volatile("s_waitcnt vmcnt(0)" ::: "memory");
        }
    }
    __syncthreads();
}


typedef float f32x2 __attribute__((ext_vector_type(2)));
typedef unsigned v2u __attribute__((ext_vector_type(2)));
struct Args { const float* in[N_INPUTS]; float* out; unsigned char* ws; int ph_lo, ph_hi; };
struct Frame { unsigned char* lds; volatile LAS unsigned* MISC; gu32* ctl; unsigned char* ws; float* out; int tid, lane, wave, G, bid; };


template <int I> __device__ __forceinline__ const float* kin() {
    const float* p; auto ka = __builtin_amdgcn_kernarg_segment_ptr();
    asm volatile("s_load_dwordx2 %0, %1, %2\n\ts_waitcnt lgkmcnt(0)" : "=s"(p) : "s"(ka), "n"(I * 8));
    return p;
}
__device__ __forceinline__ float bf2f(unsigned short b) { return __builtin_bit_cast(float, ((unsigned)b) << 16); }
__device__ __forceinline__ float bflo(unsigned w) { return __builtin_bit_cast(float, w << 16); }
__device__ __forceinline__ float bfhi(unsigned w) { return __builtin_bit_cast(float, w & 0xffff0000u); }
__device__ __forceinline__ unsigned short f2h(float f) { return __builtin_bit_cast(unsigned short, (_Float16)f); }
__device__ __forceinline__ float h2f(unsigned short h) { return (float)__builtin_bit_cast(_Float16, h); }
__device__ __forceinline__ float sigmoidf_(float x) { return 1.0f / (1.0f + expf(-x)); }
__device__ __forceinline__ float siluf_(float x) { return x / (1.0f + expf(-x)); }
__device__ __forceinline__ float wave_sum(float v) {
#pragma unroll
    for (int o = 1; o < 64; o <<= 1) v += __shfl_xor(v, o);
    return v;
}
__device__ __forceinline__ float quad_sum(float v) {
    v += __builtin_bit_cast(float, __builtin_amdgcn_mov_dpp(__builtin_bit_cast(int, v), 0xB1, 0xF, 0xF, true));
    v += __builtin_bit_cast(float, __builtin_amdgcn_mov_dpp(__builtin_bit_cast(int, v), 0x4E, 0xF, 0xF, true));
    return v;
}
__device__ __forceinline__ int row_modidx(int row) { return row < MLAT ? (row >> 12) : 2; }
__device__ __forceinline__ int seq_row(int b, int dir, int sc) {
    if (sc < CTXL) { const int j = dir ? (CTXL - 1 - sc) : sc; return MLAT + b * CTXL + j; }
    const int p = sc - CTXL; const int n = dir ? (SEQL - 1 - p) : p; return b * SEQL + n;
}
__device__ __forceinline__ int gla_row(int b, int dir, int sc) {
    if (sc < CTXL) { const int j = dir ? (CTXL - 1 - sc) : sc; return MLAT + b * CTXL + j; }
    int p = sc - CTXL; if (dir) p = SEQL - 1 - p; const int n = (p & 63) * 64 + (p >> 6); return b * SEQL + n;
}
__device__ __forceinline__ int prev_row(int row, int dir) {
    if (row < MLAT) { const int t = row & (SEQL - 1); return dir ? (t == SEQL - 1 ? -1 : row + 1) : (t == 0 ? -1 : row - 1); }
    const int t = (row - MLAT) & (CTXL - 1); return dir ? (t == CTXL - 1 ? -1 : row + 1) : (t == 0 ? -1 : row - 1);
}

__device__ __forceinline__ void ph_mod_partial(const Args& a, Frame& F) {
    float* sv = (float*)F.lds;
    float* MODP = (float*)(F.ws + WS_MODP);
    const float* cptr = kin<I_C>(); const float* ccptr = kin<I_CCTX>(); const float* wmod = kin<I_WMOD>();
    for (int u = F.bid; u < 384; u += F.G) {
        const int l = u / 192, r = u % 192, kc = r / 6, jb = r % 6;
        if (F.tid < 192) { const int r3 = F.tid >> 6, k = kc * 64 + (F.tid & 63); const float cv = r3 < 2 ? cptr[r3 * DM + k] : ccptr[k]; sv[F.tid] = siluf_(cv); }
        __syncthreads();
        const int j = jb * 2048 + F.tid * 4;
        f32x4 acc0 = {0, 0, 0, 0}, acc1 = {0, 0, 0, 0}, acc2 = {0, 0, 0, 0};
        const float* wp = wmod + ((size_t)l * DM + kc * 64) * 12288 + j;
#pragma unroll 8
        for (int kk = 0; kk < 64; ++kk) { const f32x4 w = *(const f32x4*)(wp + (size_t)kk * 12288); acc0 += sv[kk] * w; acc1 += sv[64 + kk] * w; acc2 += sv[128 + kk] * w; }
        float* o = MODP + ((size_t)(l * 32 + kc) * 3) * 12288 + j;
        *(f32x4*)(o) = acc0; *(f32x4*)(o + 12288) = acc1; *(f32x4*)(o + 2 * 12288) = acc2;
        __syncthreads();
    }
    f32x4* X4 = (f32x4*)(F.ws + WS_X);
    const f32x4* x4 = (const f32x4*)kin<I_X>(); const f32x4* c4 = (const f32x4*)kin<I_CTX>();
    const size_t nlat = (size_t)MLAT * DM / 4, ntot = (size_t)MROWS * DM / 4;
    for (size_t i = (size_t)F.bid * 512 + F.tid; i < ntot; i += (size_t)F.G * 512) X4[i] = i < nlat ? x4[i] : c4[i - nlat];
}
__device__ __forceinline__ void ph_mod_reduce(const Args& a, Frame& F) {
    const float* MODP = (const float*)(F.ws + WS_MODP); float* MOD = (float*)(F.ws + WS_MOD);
    const float* bmod = kin<I_BMOD>();
    for (int i = F.bid * 512 + F.tid; i < 2 * 3 * 12288; i += F.G * 512) {
        const int l = i / 36864, r = (i / 12288) % 3, j = i % 12288;
        float s = bmod[l * 12288 + j];
        for (int kc = 0; kc < 32; ++kc) s += MODP[((size_t)(l * 32 + kc) * 3 + r) * 12288 + j];
        MOD[i] = s;
    }
}

__device__ __forceinline__ void cvt_item(const float* S, size_t P, int k0, int c0, int ncol_valid, unsigned short* D, int K, int n0, float* scr, int lane) {
#pragma unroll 8
    for (int i = 0; i < 32; ++i) { const int kk = 2 * i + (lane >> 5), col = c0 + (lane & 31); scr[kk * 33 + (lane & 31)] = col < ncol_valid ? S[(size_t)(k0 + kk) * P + col] : 0.f; }
    LDS_WAIT(); asm volatile("" ::: "memory");
    const int c = lane & 7;
#pragma unroll
    for (int j = 0; j < 4; ++j) { const int n = (lane >> 3) + 8 * j; const float* s = scr + (8 * c) * 33 + n;
        v4u o; o.x = pk2(s[0 * 33], s[1 * 33]); o.y = pk2(s[2 * 33], s[3 * 33]); o.z = pk2(s[4 * 33], s[5 * 33]); o.w = pk2(s[6 * 33], s[7 * 33]);
        *(v4u*)(D + (size_t)(n0 + n) * K + k0 + 8 * c) = o; }
    LDS_WAIT(); asm volatile("" ::: "memory");
}
__device__ __forceinline__ void ph_convert(const Args& a, Frame& F, int l) {
    float* scr = (float*)(F.lds + F.wave * 16384);
    const int gw = F.bid * NWAVES + F.wave, NGW = F.G * NWAVES;
    constexpr int I0 = 32 * 432, I1 = 16 * 128, I2 = 16 * 64, I3 = 16 * 64, I4 = 32 * 64, I5 = 32 * 32 * 16, I6 = 32 * 4 * 64;
    constexpr int NIT = I0 + I1 + I2 + I3 + I4 + I5 + I6;
    unsigned short* ws16 = (unsigned short*)F.ws;
    for (int it = gw; it < NIT; it += NGW) {
        int r = it;
        if (r < I0) { const int kb = r / 432, nb = r % 432; cvt_item(kin<I_WIN>() + (size_t)l * DM * INW, INW, kb * 64, nb * 32, INW, (unsigned short*)(F.ws + WS_WIN), DM, nb * 32, scr, F.lane); continue; } r -= I0;
        if (r < I1) { const int kb = r / 128, nb = r % 128, n0 = nb * 32, pn = n0 >> 8, h = (n0 & 255) >> 7, i0 = n0 & 127;
            cvt_item(kin<I_S5GLU>() + (size_t)l * 1024 * 4096, 4096, kb * 64, h * 2048 + pn * 128 + i0, 4096, (unsigned short*)(F.ws + WS_WGLU), 1024, n0, scr, F.lane); continue; } r -= I1;
        if (r < I2) { const int kb = r / 64, nb = r % 64; cvt_item(kin<I_RWPROJ>() + (size_t)l * 1024 * DM, DM, kb * 64, nb * 32, DM, (unsigned short*)(F.ws + WS_WRW), 1024, nb * 32, scr, F.lane); continue; } r -= I2;
        if (r < I3) { const int kb = r / 64, nb = r % 64; cvt_item(kin<I_GLPROJ>() + (size_t)l * 1024 * DM, DM, kb * 64, nb * 32, DM, (unsigned short*)(F.ws + WS_WGL), 1024, nb * 32, scr, F.lane); continue; } r -= I3;
        if (r < I4) { const int kb = r / 64, nb = r % 64; cvt_item(kin<I_WOUT>() + (size_t)l * DM * DM, DM, kb * 64, nb * 32, DM, (unsigned short*)(F.ws + WS_WOUT), DM, nb * 32, scr, F.lane); continue; } r -= I4;
        if (r < I5) { const int e = r / 512, q = r % 512, kb = q / 16, nb = q % 16, n0 = nb * 32, j = n0 >> 8, h = (n0 & 255) >> 7, i0 = n0 & 127;
            const float* S = (h ? kin<I_MWUP>() : kin<I_MWGATE>()) + (size_t)(l * 32 + e) * DM * 256;
            cvt_item(S, 256, kb * 64, j * 128 + i0, 256, (unsigned short*)(F.ws + WS_WGU) + (size_t)e * 512 * DM, DM, n0, scr, F.lane); continue; } r -= I5;
        { const int e = r / 256, q = r % 256, kb = q / 64, nb = q % 64;
            cvt_item(kin<I_MWDOWN>() + (size_t)(l * 32 + e) * 256 * DM, DM, kb * 64, nb * 32, DM, (unsigned short*)(F.ws + WS_WDN) + (size_t)e * DM * 256, 256, nb * 32, scr, F.lane); }
    }
    (void)ws16;
}

__device__ __forceinline__ void ph_rowpass(const Args& a, Frame& F, int l, int mode, int combine, int nrows, int nrows_comb) {
    const int gw = F.bid * NWAVES + F.wave, NGW = F.G * NWAVES;
    float* X = (float*)(F.ws + WS_X); unsigned short* U = (unsigned short*)(F.ws + WS_U);
    const float* MOD = (const float*)(F.ws + WS_MOD);
    const unsigned short* EO = (const unsigned short*)(F.ws + WS_EO);
    const int* SLOT = (const int*)(F.ws + WS_TAB + TB_SLOT); const float* RWT = (const float*)(F.ws + WS_TAB + TB_RWT);
    const float* g1base = kin<I_G1>(); const float* gfbase = kin<I_GFINAL>();
    for (int row = gw; row < nrows; row += NGW) {
        const int mr = row_modidx(row);
        f32x4 v[8]; float* xr = X + (size_t)row * DM + 4 * F.lane;
#pragma unroll
        for (int j = 0; j < 8; ++j) v[j] = *(const f32x4*)(xr + 256 * j);
        if (combine && row < nrows_comb) {
            const int s0 = SLOT[row * 2], s1 = SLOT[row * 2 + 1]; const float w0 = RWT[row * 2], w1 = RWT[row * 2 + 1];
            const float* g2 = MOD + ((size_t)((l - 1) * 3 + mr)) * 12288 + 5 * DM + 4 * F.lane;
            const unsigned short* e0 = EO + (size_t)s0 * DM + 4 * F.lane; const unsigned short* e1 = EO + (size_t)s1 * DM + 4 * F.lane;
#pragma unroll
            for (int j = 0; j < 8; ++j) { const v2u p0 = *(const v2u*)(e0 + 256 * j), p1 = *(const v2u*)(e1 + 256 * j); const f32x4 g = *(const f32x4*)(g2 + 256 * j);
                f32x4 m; m.x = w0 * bflo(p0.x) + w1 * bflo(p1.x); m.y = w0 * bfhi(p0.x) + w1 * bfhi(p1.x); m.z = w0 * bflo(p0.y) + w1 * bflo(p1.y); m.w = w0 * bfhi(p0.y) + w1 * bfhi(p1.y);
                v[j] += g * m; *(f32x4*)(xr + 256 * j) = v[j]; }
        }
        float ss = 0.f;
#pragma unroll
        for (int j = 0; j < 8; ++j) ss += (v[j].x * v[j].x + v[j].y * v[j].y) + (v[j].z * v[j].z + v[j].w * v[j].w);
        ss = wave_sum(ss);
        const float rs = 1.0f / sqrtf(ss * (1.0f / DM) + 1e-6f);
        if (mode == 0) {
            const float* g1 = g1base + l * DM + 4 * F.lane;
            const float* sh = MOD + ((size_t)(l * 3 + mr)) * 12288 + 4 * F.lane; const float* sc = sh + DM;
            unsigned short* ur = U + (size_t)row * DM + 4 * F.lane;
#pragma unroll
            for (int j = 0; j < 8; ++j) { const f32x4 g = *(const f32x4*)(g1 + 256 * j), s = *(const f32x4*)(sh + 256 * j), c = *(const f32x4*)(sc + 256 * j);
                const f32x4 y = (v[j] * rs * g) * (1.0f + c) + s; v2u o; o.x = pk2(y.x, y.y); o.y = pk2(y.z, y.w); *(v2u*)(ur + 256 * j) = o; }
        } else {
            if (row < MLAT) { const float* gf = gfbase + 4 * F.lane; float* o = F.out + (size_t)row * DM + 4 * F.lane;
#pragma unroll
                for (int j = 0; j < 8; ++j) { const f32x4 g = *(const f32x4*)(gf + 256 * j); *(f32x4*)(o + 256 * j) = v[j] * rs * g; } }
        }
    }
}

struct S5P { f32x2 lb; f32x2 bb[16]; };
__device__ __forceinline__ void s5_params(const Args& a, int l, int d, int g, int p, S5P& P) {
    const int gi = (l * 2 + d) * 64 + g;
    const float are = kin<I_S5ARE>()[gi * 64 + p], aim = kin<I_S5AIM>()[gi * 64 + p], ldt = kin<I_S5LDT>()[gi];
    const float lre = fminf(are, -1e-4f), dt = expf(ldt);
    const float mag = expf(lre * dt), ang = aim * dt;
    float sn, cs; sincosf(ang, &sn, &cs);
    P.lb.x = mag * cs; P.lb.y = mag * sn;
    const float nr = P.lb.x - 1.0f, ni = P.lb.y, den = lre * lre + aim * aim;
    const float cr = (nr * lre + ni * aim) / den, ci = (ni * lre - nr * aim) / den;
    const float* bre = kin<I_S5BRE>() + ((size_t)gi * 64 + p) * 16; const float* bim = kin<I_S5BIM>() + ((size_t)gi * 64 + p) * 16;
#pragma unroll
    for (int i = 0; i < 16; ++i) { const float br = bre[i], bi = bim[i]; P.bb[i].x = cr * br - ci * bi; P.bb[i].y = cr * bi + ci * br; }
}
__device__ __forceinline__ void s5_load_u(const unsigned short* PROJ, int row, int g, float (&u)[16]) {
    const v4u* p = (const v4u*)(PROJ + (size_t)row * INP + C_S5 + g * 16);
    const v4u q0 = p[0], q1 = p[1];
    u[0] = bflo(q0.x); u[1] = bfhi(q0.x); u[2] = bflo(q0.y); u[3] = bfhi(q0.y); u[4] = bflo(q0.z); u[5] = bfhi(q0.z); u[6] = bflo(q0.w); u[7] = bfhi(q0.w);
    u[8] = bflo(q1.x); u[9] = bfhi(q1.x); u[10] = bflo(q1.y); u[11] = bfhi(q1.y); u[12] = bflo(q1.z); u[13] = bfhi(q1.z); u[14] = bflo(q1.w); u[15] = bfhi(q1.w);
}
__device__ __forceinline__ f32x2 s5_step(const S5P& P, f32x2 h, const float (&u)[16]) {
    float br = 0.f, bi = 0.f;
#pragma unroll
    for (int i = 0; i < 16; ++i) { br += P.bb[i].x * u[i]; bi += P.bb[i].y * u[i]; }
    f32x2 o; o.x = P.lb.x * h.x - P.lb.y * h.y + br; o.y = P.lb.x * h.y + P.lb.y * h.x + bi; return o;
}
__device__ __forceinline__ void s5_local(const Args& a, Frame& F, int l, int wu) {
    const int d = wu / (2 * 64 * NSC), r1 = wu % (2 * 64 * NSC), b = r1 / (64 * NSC), r2 = r1 % (64 * NSC), g = r2 / NSC, sc = r2 % NSC;
    const unsigned short* PROJ = (const unsigned short*)(F.ws + WS_PROJ);
    S5P P; s5_params(a, l, d, g, F.lane, P);
    f32x2 h = {0.f, 0.f};
    for (int i = 0; i < 64; ++i) { const int row = seq_row(b, d, sc * 64 + i); float u[16]; s5_load_u(PROJ, row, g, u); h = s5_step(P, h, u); }
    f32x2* END = (f32x2*)(F.ws + WS_S5END);
    END[((size_t)((d * 2 + b) * 64 + g) * NSC + sc) * 64 + F.lane] = h;
}

__device__ __forceinline__ void rwkv_prep_unit(const Args& a, Frame& F, int l, int unit) {
    const int d = unit / 544, r1 = unit % 544, tb = r1 >> 1, ch = r1 & 1;
    const unsigned short* PROJ = (const unsigned short*)(F.ws + WS_PROJ);
    unsigned short* PREP = (unsigned short*)(F.ws + WS_PREP); float* BON = (float*)(F.ws + WS_BONUS);
    float* lora = (float*)F.lds;
    const float* mu = kin<I_RWMU>() + (size_t)(l * 2 + d) * 3200;
    const int row0 = tb * 32;
    {
        const int rr = F.tid >> 4, j0 = (F.tid & 15) * 8, row = row0 + rr, pr = prev_row(row, d);
        const v4u z = *(const v4u*)(PROJ + (size_t)row * INP + C_RW + 3072 + j0);
        v4u zp = {0u, 0u, 0u, 0u}; if (pr >= 0) zp = *(const v4u*)(PROJ + (size_t)pr * INP + C_RW + 3072 + j0);
        const unsigned zw[4] = {z.x, z.y, z.z, z.w}, pw[4] = {zp.x, zp.y, zp.z, zp.w};
#pragma unroll
        for (int e = 0; e < 8; ++e) { const float zv = (e & 1) ? bfhi(zw[e >> 1]) : bflo(zw[e >> 1]), pv = (e & 1) ? bfhi(pw[e >> 1]) : bflo(pw[e >> 1]);
            float zz = zv + (pv - zv) * mu[3072 + j0 + e]; if (j0 + e < 64) zz = tanhf(zz); lora[rr * 128 + j0 + e] = zz; }
    }
    __syncthreads();
    const int c = ch * 512 + F.tid, h = c >> 6;
    float wup[64], aup[64];
    { const float* wp = kin<I_RWWUP>() + (size_t)(l * 2 + d) * 64 * 1024 + c; const float* ap = kin<I_RWAUP>() + (size_t)(l * 2 + d) * 64 * 1024 + c;
#pragma unroll
      for (int j = 0; j < 64; ++j) { wup[j] = wp[(size_t)j * 1024]; aup[j] = ap[(size_t)j * 1024]; } }
    const float w0 = kin<I_RWW0>()[(l * 2 + d) * 1024 + c], a0 = kin<I_RWA0>()[(l * 2 + d) * 1024 + c];
    const float mur = mu[c], muk = mu[1024 + c], muv = mu[2048 + c];
    const float kkw = kin<I_RWKK>()[l * 1024 + c], kaw = kin<I_RWKA>()[l * 1024 + c], rkw = kin<I_RWRK>()[l * 1024 + c];
    for (int rr = 0; rr < 32; ++rr) {
        const int row = row0 + rr, pr = prev_row(row, d);
        const unsigned short* zr = PROJ + (size_t)row * INP + C_RW + c;
        float r = bf2f(zr[0]), k = bf2f(zr[1024]), v = bf2f(zr[2048]);
        float rp = 0.f, kp = 0.f, vp = 0.f;
        if (pr >= 0) { const unsigned short* zq = PROJ + (size_t)pr * INP + C_RW + c; rp = bf2f(zq[0]); kp = bf2f(zq[1024]); vp = bf2f(zq[2048]); }
        r += (rp - r) * mur; k += (kp - k) * muk; v += (vp - v) * muv;
        float accw = w0, acca = a0;
        const f32x4* lo = (const f32x4*)(lora + rr * 128);
#pragma unroll
        for (int j = 0; j < 16; ++j) { const f32x4 x = lo[j], y = lo[16 + j];
            accw += x.x * wup[4 * j] + x.y * wup[4 * j + 1] + x.z * wup[4 * j + 2] + x.w * wup[4 * j + 3];
            acca += y.x * aup[4 * j] + y.y * aup[4 * j + 1] + y.z * aup[4 * j + 2] + y.w * aup[4 * j + 3]; }
        const float dec = expf(-0.606531f * sigmoidf_(accw)), av = sigmoidf_(acca);
        const float kkc = k * kkw; const float ss = wave_sum(kkc * kkc);
        const float kk = kkc / fmaxf(sqrtf(ss), 1e-12f);
        const float kq = k * (1.0f + (av - 1.0f) * kaw);
        const float bon = wave_sum(r * kq * rkw);
        unsigned short* o = PREP + (((size_t)d * MROWS + row) * 16 + h) * 384 + F.lane;
        o[0] = f2h(r); o[64] = f2h(kq); o[128] = f2h(dec); o[192] = f2h(kk); o[256] = f2h(kk * av); o[320] = f2h(v);
        if (F.lane == 0) BON[((size_t)d * MROWS + row) * 16 + h] = bon;
    }
    __syncthreads();
}

constexpr int RW_SB = 32, RW_SP = 392, RW_NBT = (CTXL + SEQL) / RW_SB;
__device__ __forceinline__ void rwkv_stage(const unsigned short* PREP, const float* BON, float* buf, int b, int d, int h, int bt, int slot, int j) {
#pragma unroll
    for (int i = 0; i < 12; ++i) {
        const int q = j + 256 * i, s = q / 96, e4 = q % 96, sc = bt * RW_SB + s, row = seq_row(b, d, sc);
        const v2u w = *(const v2u*)(PREP + (((size_t)d * MROWS + row) * 16 + h) * 384 + e4 * 4);
        f32x4 o; o.x = h2f((unsigned short)(w.x & 0xffff)); o.y = h2f((unsigned short)(w.x >> 16)); o.z = h2f((unsigned short)(w.y & 0xffff)); o.w = h2f((unsigned short)(w.y >> 16));
        *(f32x4*)(buf + (size_t)(slot * RW_SB + s) * RW_SP + e4 * 4) = o;
    }
    if (j < RW_SB) { const int row = seq_row(b, d, bt * RW_SB + j); buf[(size_t)(slot * RW_SB + j) * RW_SP + 384] = BON[((size_t)d * MROWS + row) * 16 + h]; }
}
__device__ __forceinline__ void rwkv_scan_chain(const Args& a, Frame& F, int ci) {
    const int d = ci >> 5, b = (ci >> 4) & 1, h = ci & 15;
    float* buf = (float*)F.lds;
    const unsigned short* PREP = (const unsigned short*)(F.ws + WS_PREP); const float* BON = (const float*)(F.ws + WS_BONUS);
    unsigned short* YB = (unsigned short*)(F.ws + WS_YB);
    const bool scanner = F.tid < 256; const int r = F.tid >> 2, part = F.tid & 3, j = F.tid - 256;
    f32x4 st[4];
#pragma unroll
    for (int i = 0; i < 4; ++i) st[i] = (f32x4){0.f, 0.f, 0.f, 0.f};
    if (!scanner) rwkv_stage(PREP, BON, buf, b, d, h, 0, 0, j);
    __syncthreads();
    for (int bt = 0; bt < RW_NBT; ++bt) {
        const int slot = bt & 1;
        if (!scanner) { if (bt + 1 < RW_NBT) rwkv_stage(PREP, BON, buf, b, d, h, bt + 1, slot ^ 1, j); }
        else {
            for (int s = 0; s < RW_SB; ++s) {
                const float* base = buf + (size_t)(slot * RW_SB + s) * RW_SP;
                const f32x4* rv = (const f32x4*)(base + part * 16); const f32x4* kp = (const f32x4*)(base + 64 + part * 16); const f32x4* wv = (const f32x4*)(base + 128 + part * 16);
                const f32x4* kk = (const f32x4*)(base + 192 + part * 16); const f32x4* ka = (const f32x4*)(base + 256 + part * 16);
                const float v = base[320 + r], bon = base[384];
                f32x4 t = st[0] * kk[0]; t += st[1] * kk[1]; t += st[2] * kk[2]; t += st[3] * kk[3];
                float sa = (t.x + t.y) + (t.z + t.w); sa = quad_sum(sa);
                f32x4 y4 = {0.f, 0.f, 0.f, 0.f};
#pragma unroll
                for (int i = 0; i < 4; ++i) { st[i] = st[i] * wv[i] + (v * kp[i] - sa * ka[i]); y4 += st[i] * rv[i]; }
                float y = (y4.x + y4.y) + (y4.z + y4.w); y = quad_sum(y);
                if (part == 0) { const int row = seq_row(b, d, bt * RW_SB + s); YB[((size_t)d * MROWS + row) * 1024 + h * 64 + r] = (unsigned short)f2bf(y + bon * v); }
            }
        }
        __syncthreads();
    }
}

__device__ __forceinline__ f32x4 mfma16(bf16x8 a_, bf16x8 b_, f32x4 c_) { return __builtin_amdgcn_mfma_f32_16x16x32_bf16(a_, b_, c_, 0, 0, 0); }
__device__ __forceinline__ void gla_unit(const Args& a, Frame& F, int l, int unit) {
    const int d = unit >> 5, b = (unit >> 4) & 1, h = (unit >> 2) & 3, dvs = unit & 3;
    const unsigned short* PROJ = (const unsigned short*)(F.ws + WS_PROJ);
    unsigned short* OG = (unsigned short*)(F.ws + WS_OG) + (size_t)d * MROWS * 1024;
    unsigned short* qe = (unsigned short*)F.lds;
    unsigned short* ke = qe + 64 * 136;
    unsigned short* qb = ke + 64 * 136;
    unsigned short* kdT = qb + 64 * 136;
    unsigned short* vT = kdT + 128 * 72;
    unsigned short* Pm = vT + 64 * 72;
    unsigned short* ST16 = Pm + 64 * 72;
    float* tot = (float*)(ST16 + 64 * 136);
    float* la32 = tot + 512;
    float* decv = la32 + 128;
    float* gkl = decv + 128;
    int* rowi = (int*)(gkl + 1024);
    const int tid = F.tid, lane = F.lane, w = F.wave, l15 = lane & 15, quad = lane >> 4;
    const int dk = tid & 127, cg = tid >> 7;
    float gup[16];
#pragma unroll
    for (int j = 0; j < 16; ++j) gup[j] = kin<I_GLGKUP>()[((size_t)(l * 2 + d) * 16 + j) * 512 + h * 128 + dk];
    const float gbias = kin<I_GLGKB>()[(l * 2 + d) * 512 + h * 128 + dk];
    const float scale = 0.08838834764831845f;
    for (int i = tid; i < 64 * 136 / 2; i += 512) ((unsigned*)ST16)[i] = 0u;
    f32x4 sacc[4];
#pragma unroll
    for (int i = 0; i < 4; ++i) sacc[i] = (f32x4){0.f, 0.f, 0.f, 0.f};
    for (int ch = 0; ch < NSC; ++ch) {
        if (tid < 64) rowi[tid] = gla_row(b, d, ch * 64 + tid);
        __syncthreads();
        if (tid < 128) { const int c = tid >> 1, hf = tid & 1; const v4u z = *(const v4u*)(PROJ + (size_t)rowi[c] * INP + C_GK + hf * 8); float* o = gkl + c * 16 + hf * 8;
            o[0] = bflo(z.x); o[1] = bfhi(z.x); o[2] = bflo(z.y); o[3] = bfhi(z.y); o[4] = bflo(z.z); o[5] = bfhi(z.z); o[6] = bflo(z.w); o[7] = bfhi(z.w); }
        { const int dv = tid & 63, cgv = tid >> 6; unsigned short vv[8];
#pragma unroll
          for (int e = 0; e < 8; ++e) vv[e] = PROJ[(size_t)rowi[cgv * 8 + e] * INP + C_V + h * 256 + dvs * 64 + dv];
          v4u o; o.x = vv[0] | ((unsigned)vv[1] << 16); o.y = vv[2] | ((unsigned)vv[3] << 16); o.z = vv[4] | ((unsigned)vv[5] << 16); o.w = vv[6] | ((unsigned)vv[7] << 16);
          *(v4u*)(vT + dv * 72 + cgv * 8) = o; }
        __syncthreads();
        float bl[16]; float run = 0.f;
#pragma unroll
        for (int e = 0; e < 16; ++e) { const f32x4* gp = (const f32x4*)(gkl + (cg * 16 + e) * 16); float x = gbias;
#pragma unroll
            for (int j = 0; j < 4; ++j) { const f32x4 g4 = gp[j]; x += g4.x * gup[4 * j] + g4.y * gup[4 * j + 1] + g4.z * gup[4 * j + 2] + g4.w * gup[4 * j + 3]; }
            const float la = (fminf(x, 0.f) - log1pf(expf(-fabsf(x)))) * (1.0f / 16.0f);
            if (e == 0 && cg == 2) la32[dk] = la;
            run += la; bl[e] = run; }
        tot[cg * 128 + dk] = run;
        __syncthreads();
        { const float t0 = tot[dk], t1 = tot[128 + dk], t2 = tot[256 + dk], t3 = tot[384 + dk];
          const float off = cg == 0 ? 0.f : (cg == 1 ? t0 : (cg == 2 ? t0 + t1 : t0 + t1 + t2));
          const float bref = t0 + t1 + la32[dk], blast = (t0 + t1) + (t2 + t3);
          unsigned short kdv[16];
#pragma unroll
          for (int e = 0; e < 16; ++e) { const int c = cg * 16 + e; const float bb = off + bl[e];
              const unsigned short* pr = PROJ + (size_t)rowi[c] * INP + h * 128 + dk;
              const float q = bf2f(pr[C_Q]) * scale, k = bf2f(pr[C_K]);
              qe[c * 136 + dk] = (unsigned short)f2bf(q * expf(bb - bref)); ke[c * 136 + dk] = (unsigned short)f2bf(k * expf(bref - bb));
              qb[c * 136 + dk] = (unsigned short)f2bf(q * expf(bb)); kdv[e] = (unsigned short)f2bf(k * expf(blast - bb)); }
          v4u o0, o1; o0.x = kdv[0] | ((unsigned)kdv[1] << 16); o0.y = kdv[2] | ((unsigned)kdv[3] << 16); o0.z = kdv[4] | ((unsigned)kdv[5] << 16); o0.w = kdv[6] | ((unsigned)kdv[7] << 16);
          o1.x = kdv[8] | ((unsigned)kdv[9] << 16); o1.y = kdv[10] | ((unsigned)kdv[11] << 16); o1.z = kdv[12] | ((unsigned)kdv[13] << 16); o1.w = kdv[14] | ((unsigned)kdv[15] << 16);
          *(v4u*)(kdT + dk * 72 + cg * 16) = o0; *(v4u*)(kdT + dk * 72 + cg * 16 + 8) = o1;
          if (cg == 0) decv[dk] = expf(blast); }
        __syncthreads();
#pragma unroll
        for (int tt = 0; tt < 2; ++tt) { const int t = 2 * w + tt, ti = t >> 2, tj = t & 3; f32x4 acc = {0.f, 0.f, 0.f, 0.f};
            if (tj <= ti) {
#pragma unroll
                for (int kb = 0; kb < 4; ++kb) { const bf16x8 af = *(const bf16x8*)(qe + (16 * ti + l15) * 136 + kb * 32 + quad * 8), bfr = *(const bf16x8*)(ke + (16 * tj + l15) * 136 + kb * 32 + quad * 8);
                    acc = mfma16(af, bfr, acc); } }
            const int m = 16 * tj + l15;
#pragma unroll
            for (int jj = 0; jj < 4; ++jj) { const int c = 16 * ti + quad * 4 + jj; Pm[c * 72 + m] = (m <= c) ? (unsigned short)f2bf(acc[jj]) : (unsigned short)0; } }
        __syncthreads();
#pragma unroll
        for (int tt = 0; tt < 2; ++tt) { const int t = 2 * w + tt, tdv = t >> 2, tc = t & 3; f32x4 acc = {0.f, 0.f, 0.f, 0.f};
#pragma unroll
            for (int kb = 0; kb < 2; ++kb) { const bf16x8 af = *(const bf16x8*)(vT + (16 * tdv + l15) * 72 + kb * 32 + quad * 8), bfr = *(const bf16x8*)(Pm + (16 * tc + l15) * 72 + kb * 32 + quad * 8); acc = mfma16(af, bfr, acc); }
#pragma unroll
            for (int kb = 0; kb < 4; ++kb) { const bf16x8 af = *(const bf16x8*)(ST16 + (16 * tdv + l15) * 136 + kb * 32 + quad * 8), bfr = *(const bf16x8*)(qb + (16 * tc + l15) * 136 + kb * 32 + quad * 8); acc = mfma16(af, bfr, acc); }
            const int c = 16 * tc + l15, dv0 = 16 * tdv + quad * 4;
            v2u o; o.x = pk2(acc[0], acc[1]); o.y = pk2(acc[2], acc[3]);
            *(v2u*)(OG + (size_t)rowi[c] * 1024 + h * 256 + dvs * 64 + dv0) = o; }
        __syncthreads();
        { const float dec = decv[16 * w + l15];
#pragma unroll
          for (int tdv = 0; tdv < 4; ++tdv) { f32x4 acc = sacc[tdv] * dec;
#pragma unroll
              for (int kb = 0; kb < 2; ++kb) { const bf16x8 af = *(const bf16x8*)(vT + (16 * tdv + l15) * 72 + kb * 32 + quad * 8), bfr = *(const bf16x8*)(kdT + (16 * w + l15) * 72 + kb * 32 + quad * 8); acc = mfma16(af, bfr, acc); }
              sacc[tdv] = acc;
#pragma unroll
              for (int jj = 0; jj < 4; ++jj) ST16[(16 * tdv + quad * 4 + jj) * 136 + 16 * w + l15] = (unsigned short)f2bf(acc[jj]); } }
        __syncthreads();
    }
}

__device__ __forceinline__ float gelu_tanh(float x) { return 0.5f * x * (1.0f + tanhf(0.7978845608028654f * (x + 0.044715f * x * x * x))); }
__device__ __forceinline__ void s5_final(const Args& a, Frame& F, int l, int wu, unsigned short* Hb) {
    const int b = wu / (64 * NSC), r0 = wu % (64 * NSC), g = r0 / NSC, tcx = r0 % NSC;
    const bool isctx = tcx < 4; const int tc = isctx ? tcx : tcx - 4;
    const unsigned short* PROJ = (const unsigned short*)(F.ws + WS_PROJ);
    const f32x2* END = (const f32x2*)(F.ws + WS_S5END);
    const int lane = F.lane, l15 = lane & 15, quad = lane >> 4;
    f32x4 acc[4];
#pragma unroll
    for (int i = 0; i < 4; ++i) acc[i] = (f32x4){0.f, 0.f, 0.f, 0.f};
    for (int dd = 0; dd < 2; ++dd) {
        S5P P; s5_params(a, l, dd, g, lane, P);
        const int scx = dd == 0 ? tcx : (isctx ? 3 - tc : 4 + 63 - tc);
        f32x2 lamL = P.lb;
#pragma unroll
        for (int i = 0; i < 6; ++i) { f32x2 t; t.x = lamL.x * lamL.x - lamL.y * lamL.y; t.y = 2.0f * lamL.x * lamL.y; lamL = t; }
        f32x2 hcur = {0.f, 0.f};
        const f32x2* ep = END + ((size_t)((dd * 2 + b) * 64 + g) * NSC) * 64 + lane;
        for (int s = 0; s < scx; ++s) { const f32x2 e = ep[(size_t)s * 64]; f32x2 t; t.x = lamL.x * hcur.x - lamL.y * hcur.y + e.x; t.y = lamL.x * hcur.y + lamL.y * hcur.x + e.y; hcur = t; }
        bf16x8 cf[4];
        { const int gi = (l * 2 + dd) * 64 + g;
          const float* cre = kin<I_S5CRE>() + ((size_t)gi * 16 + l15) * 64; const float* cim = kin<I_S5CIM>() + ((size_t)gi * 16 + l15) * 64;
#pragma unroll
          for (int kb = 0; kb < 4; ++kb) { const int k0 = kb * 32 + quad * 8; const float* src = k0 < 64 ? cre + k0 : cim + (k0 - 64); const float sg = k0 < 64 ? 1.f : -1.f;
              const f32x4 x0 = *(const f32x4*)src, x1 = *(const f32x4*)(src + 4);
              cf[kb][0] = (short)f2bf(sg * x0.x); cf[kb][1] = (short)f2bf(sg * x0.y); cf[kb][2] = (short)f2bf(sg * x0.z); cf[kb][3] = (short)f2bf(sg * x0.w);
              cf[kb][4] = (short)f2bf(sg * x1.x); cf[kb][5] = (short)f2bf(sg * x1.y); cf[kb][6] = (short)f2bf(sg * x1.z); cf[kb][7] = (short)f2bf(sg * x1.w); } }
        asm volatile("s_waitcnt lgkmcnt(0)" ::: "memory");
        for (int i = 0; i < 64; ++i) { const int row = seq_row(b, dd, scx * 64 + i); float u[16]; s5_load_u(PROJ, row, g, u); hcur = s5_step(P, hcur, u);
            const int tl = dd ? 63 - i : i; Hb[tl * 136 + lane] = (unsigned short)f2bf(hcur.x); Hb[tl * 136 + 64 + lane] = (unsigned short)f2bf(hcur.y); }
        asm volatile("s_waitcnt lgkmcnt(0)" ::: "memory");
#pragma unroll
        for (int tt = 0; tt < 4; ++tt)
#pragma unroll
            for (int kb = 0; kb < 4; ++kb) { const bf16x8 hf = *(const bf16x8*)(Hb + (16 * tt + l15) * 136 + kb * 32 + quad * 8); acc[tt] = mfma16(cf[kb], hf, acc[tt]); }
    }
    unsigned short* ZA = (unsigned short*)(F.ws + WS_ZA);
    const f32x4 dvec = *(const f32x4*)(kin<I_S5D>() + l * 1024 + g * 16 + quad * 4);
#pragma unroll
    for (int tt = 0; tt < 4; ++tt) { const int tl = 16 * tt + l15; const int row = isctx ? MLAT + b * CTXL + tc * 64 + tl : b * SEQL + tc * 64 + tl;
        const v2u uu = *(const v2u*)(PROJ + (size_t)row * INP + C_S5 + g * 16 + quad * 4);
        const float z0 = gelu_tanh(acc[tt][0] + dvec.x * bflo(uu.x)), z1 = gelu_tanh(acc[tt][1] + dvec.y * bfhi(uu.x)), z2 = gelu_tanh(acc[tt][2] + dvec.z * bflo(uu.y)), z3 = gelu_tanh(acc[tt][3] + dvec.w * bfhi(uu.y));
        v2u o; o.x = pk2(z0, z1); o.y = pk2(z2, z3); *(v2u*)(ZA + (size_t)row * 1024 + g * 16 + quad * 4) = o; }
}

__device__ __forceinline__ void zb_unit(const Args& a, Frame& F, int l, int unit) {
    const int tb = unit >> 1, ch = unit & 1, row0 = tb * 32;
    const unsigned short* PROJ = (const unsigned short*)(F.ws + WS_PROJ);
    const unsigned short* YB = (const unsigned short*)(F.ws + WS_YB); unsigned short* ZB = (unsigned short*)(F.ws + WS_ZB);
    float* sg = (float*)F.lds;
    { const int rr = F.tid >> 4, j0 = (F.tid & 15) * 8; const v4u z = *(const v4u*)(PROJ + (size_t)(row0 + rr) * INP + C_GLO + j0); float* o = sg + rr * 128 + j0;
      o[0] = sigmoidf_(bflo(z.x)); o[1] = sigmoidf_(bfhi(z.x)); o[2] = sigmoidf_(bflo(z.y)); o[3] = sigmoidf_(bfhi(z.y)); o[4] = sigmoidf_(bflo(z.z)); o[5] = sigmoidf_(bfhi(z.z)); o[6] = sigmoidf_(bflo(z.w)); o[7] = sigmoidf_(bfhi(z.w)); }
    __syncthreads();
    const int c = ch * 512 + F.tid;
    float gup[128];
    { const float* gp = kin<I_RWGUP>() + (size_t)l * 128 * 1024 + c;
#pragma unroll
      for (int j = 0; j < 128; ++j) gup[j] = gp[(size_t)j * 1024]; }
    const float lnw = kin<I_RWLNW>()[l * 1024 + c], lnb = kin<I_RWLNB>()[l * 1024 + c];
    for (int rr = 0; rr < 32; ++rr) { const int row = row0 + rr;
        const float y = bf2f(YB[(size_t)row * 1024 + c]) + bf2f(YB[((size_t)MROWS + row) * 1024 + c]);
        const float mean = wave_sum(y) * (1.0f / 64.0f); const float dvv = y - mean; const float var = wave_sum(dvv * dvv) * (1.0f / 64.0f);
        const float yn = dvv * (1.0f / sqrtf(var + 64e-5f)) * lnw + lnb;
        float gate = 0.f; const f32x4* sp = (const f32x4*)(sg + rr * 128);
#pragma unroll
        for (int j = 0; j < 32; ++j) { const f32x4 s = sp[j]; gate += s.x * gup[4 * j] + s.y * gup[4 * j + 1] + s.z * gup[4 * j + 2] + s.w * gup[4 * j + 3]; }
        ZB[(size_t)row * 1024 + c] = (unsigned short)f2bf(yn * gate); }
    __syncthreads();
}
__device__ __forceinline__ void zc_row(const Args& a, Frame& F, int l, int row) {
    const unsigned short* PROJ = (const unsigned short*)(F.ws + WS_PROJ);
    const unsigned short* O0 = (const unsigned short*)(F.ws + WS_OG) + (size_t)row * 1024 + 4 * F.lane; const unsigned short* O1 = O0 + (size_t)MROWS * 1024;
    unsigned short* ZC = (unsigned short*)(F.ws + WS_ZC) + (size_t)row * 1024 + 4 * F.lane;
    const unsigned short* og = PROJ + (size_t)row * INP + C_OG + 4 * F.lane; const float* ng = kin<I_GLNG>() + l * 1024 + 4 * F.lane;
#pragma unroll
    for (int j = 0; j < 4; ++j) { const v2u p0 = *(const v2u*)(O0 + 256 * j), p1 = *(const v2u*)(O1 + 256 * j), g = *(const v2u*)(og + 256 * j); const f32x4 n4 = *(const f32x4*)(ng + 256 * j);
        const float o0 = bflo(p0.x) + bflo(p1.x), o1 = bfhi(p0.x) + bfhi(p1.x), o2 = bflo(p0.y) + bflo(p1.y), o3 = bfhi(p0.y) + bfhi(p1.y);
        const float ss = wave_sum((o0 * o0 + o1 * o1) + (o2 * o2 + o3 * o3)); const float rs = 1.0f / sqrtf(ss * (1.0f / 256.0f) + 1e-6f);
        v2u o; o.x = pk2(o0 * rs * n4.x * siluf_(bflo(g.x)), o1 * rs * n4.y * siluf_(bfhi(g.x))); o.y = pk2(o2 * rs * n4.z * siluf_(bflo(g.y)), o3 * rs * n4.w * siluf_(bfhi(g.y)));
        *(v2u*)(ZC + 256 * j) = o; }
}

template <int NCOLT> struct EpiStoreBf16 {
    static constexpr bool PERM = true, AFTER_DRAIN = false;
    unsigned short* O; int ldc;
    __device__ __forceinline__ void operator()(const pg8::f32x4 (&acc)[2][2][4][2], const pg8::Unit& u, int wr, int wc, int fr, int fq) const {
        const int row0 = u.pm * 256 + wr * 64 + fr, col0 = (NCOLT ? (u.pn % NCOLT) : u.pn) * 256 + wc * 32 + 8 * fq;
#pragma unroll
        for (int ai = 0; ai < 2; ++ai)
#pragma unroll
            for (int m = 0; m < 4; ++m) { unsigned short* rowp = O + (size_t)(row0 + ai * 128 + m * 16) * ldc + col0;
#pragma unroll
                for (int bj = 0; bj < 2; ++bj) { const pg8::f32x4 v0 = acc[ai][bj][m][0], v1 = acc[ai][bj][m][1];
                    v4u w; w.x = pg8::cvt_pk_bf16(v0[0], v0[1]); w.y = pg8::cvt_pk_bf16(v0[2], v0[3]); w.z = pg8::cvt_pk_bf16(v1[0], v1[1]); w.w = pg8::cvt_pk_bf16(v1[2], v1[3]);
                    *(v4u*)(rowp + bj * 128) = w; } }
    }
};
__device__ __forceinline__ f32x4 sig4_bf(const unsigned short* p) { const v2u g = *(const v2u*)p; f32x4 r; r.x = sigmoidf_(bflo(g.x)); r.y = sigmoidf_(bfhi(g.x)); r.z = sigmoidf_(bflo(g.y)); r.w = sigmoidf_(bfhi(g.y)); return r; }
struct EpiGlu {
    static constexpr bool PERM = false, AFTER_DRAIN = false;
    float* MF; const unsigned short* PROJ;
    __device__ __forceinline__ void operator()(const pg8::f32x4 (&acc)[2][2][4][2], const pg8::Unit& u, int wr, int wc, int fr, int fq) const {
        const int row0 = u.pm * 256 + wr * 64 + fr, oc0 = u.pn * 128 + wc * 32 + 4 * fq;
#pragma unroll
        for (int ai = 0; ai < 2; ++ai)
#pragma unroll
            for (int m = 0; m < 4; ++m) { const int r = row0 + ai * 128 + m * 16;
#pragma unroll
                for (int n = 0; n < 2; ++n) { const int oc = oc0 + 16 * n; const f32x4 ga = sig4_bf(PROJ + (size_t)r * INP + C_GA + oc);
                    const pg8::f32x4 val = acc[ai][0][m][n], gt = acc[ai][1][m][n]; f32x4 o;
                    o.x = ga.x * val[0] * sigmoidf_(gt[0]); o.y = ga.y * val[1] * sigmoidf_(gt[1]); o.z = ga.z * val[2] * sigmoidf_(gt[2]); o.w = ga.w * val[3] * sigmoidf_(gt[3]);
                    *(f32x4*)(MF + (size_t)r * DM + oc) = o; } }
    }
};
template <int MODE> struct EpiAcc {
    static constexpr bool PERM = false, AFTER_DRAIN = false;
    float* MF; unsigned short* MB; const unsigned short* PROJ; int gcol; const float* modg;
    __device__ __forceinline__ void operator()(const pg8::f32x4 (&acc)[2][2][4][2], const pg8::Unit& u, int wr, int wc, int fr, int fq) const {
        const int row0 = u.pm * 256 + wr * 64 + fr, c0 = u.pn * 256 + wc * 32 + 4 * fq;
#pragma unroll
        for (int ai = 0; ai < 2; ++ai)
#pragma unroll
            for (int m = 0; m < 4; ++m) { const int r = row0 + ai * 128 + m * 16;
#pragma unroll
                for (int bj = 0; bj < 2; ++bj)
#pragma unroll
                    for (int n = 0; n < 2; ++n) { const int c = c0 + bj * 128 + n * 16; const pg8::f32x4 v = acc[ai][bj][m][n];
                        f32x4 g; if (MODE == 2) g = *(const f32x4*)(modg + (size_t)row_modidx(r) * 12288 + c); else g = sig4_bf(PROJ + (size_t)r * INP + gcol + c);
                        float* mp = MF + (size_t)r * DM + c; f32x4 o = *(const f32x4*)mp;
                        o.x += g.x * v[0]; o.y += g.y * v[1]; o.z += g.z * v[2]; o.w += g.w * v[3];
                        if (MODE == 1) { v2u w; w.x = pk2(o.x, o.y); w.y = pk2(o.z, o.w); *(v2u*)(MB + (size_t)r * DM + c) = w; } else *(f32x4*)mp = o; } }
    }
};
struct EpiMoe1 {
    static constexpr bool PERM = false, AFTER_DRAIN = false;
    unsigned short* HID;
    __device__ __forceinline__ void operator()(const pg8::f32x4 (&acc)[2][2][4][2], const pg8::Unit& u, int wr, int wc, int fr, int fq) const {
        const int row0 = u.pm * 256 + wr * 64 + fr, hc0 = (u.pn & 1) * 128 + wc * 32 + 4 * fq;
#pragma unroll
        for (int ai = 0; ai < 2; ++ai)
#pragma unroll
            for (int m = 0; m < 4; ++m) { const int r = row0 + ai * 128 + m * 16;
#pragma unroll
                for (int n = 0; n < 2; ++n) { const pg8::f32x4 gt = acc[ai][0][m][n], up = acc[ai][1][m][n];
                    v2u w; w.x = pk2(siluf_(gt[0]) * up[0], siluf_(gt[1]) * up[1]); w.y = pk2(siluf_(gt[2]) * up[2], siluf_(gt[3]) * up[3]);
                    *(v2u*)(HID + (size_t)r * 256 + hc0 + 16 * n) = w; } }
    }
};
template <int NN> struct DenseOrder {
    int nM, G, c;
    __device__ __forceinline__ bool next(int i, pg8::Unit& u) const { const int L = i * G + c; if (L >= nM * NN) return false; u.pm = L / NN; u.pn = L % NN; return true; }
    __device__ __forceinline__ void a_ready(const pg8::Unit&) const {}
    __device__ __forceinline__ void done(const pg8::Unit&) const {}
};
template <int NPN> struct MoeOrder {
    const int* tile_e; int ntiles, G, c;
    __device__ __forceinline__ bool next(int i, pg8::Unit& u) const { const int L = i * G + c; if (L >= ntiles * NPN) return false; const int t = L / NPN, j = L % NPN;
        u.pm = t; u.pn = __builtin_amdgcn_readfirstlane(tile_e[t]) * NPN + j; return true; }
    __device__ __forceinline__ void a_ready(const pg8::Unit&) const {}
    __device__ __forceinline__ void done(const pg8::Unit&) const {}
};

__device__ __forceinline__ void ph_router(const Args& a, Frame& F, int l, int nrows) {
    const int gw = F.bid * NWAVES + F.wave, NGW = F.G * NWAVES;
    const float* X = (const float*)(F.ws + WS_X); unsigned short* U = (unsigned short*)(F.ws + WS_U);
    const float* MOD = (const float*)(F.ws + WS_MOD);
    int* EXPERT = (int*)(F.ws + WS_TAB + TB_EXPERT); float* RWT = (float*)(F.ws + WS_TAB + TB_RWT);
    const float* wg1 = kin<I_MWG1>() + (size_t)l * DM * 4; const float* wg2 = kin<I_MWG2>() + (size_t)l * DM * 32;
    const float* g2base = kin<I_G2>() + l * DM; const float* bg1 = kin<I_MBG1>() + l * 4; const float* bg2 = kin<I_MBG2>() + l * 32;
    float b1[4], b2[32];
#pragma unroll
    for (int e = 0; e < 4; ++e) b1[e] = bg1[e];
#pragma unroll
    for (int e = 0; e < 32; ++e) b2[e] = bg2[e];
    for (int row = gw; row < nrows; row += NGW) {
        const int mr = row_modidx(row);
        const float* xr = X + (size_t)row * DM + 4 * F.lane;
        float ss = 0.f;
#pragma unroll
        for (int j = 0; j < 8; ++j) { const f32x4 t = *(const f32x4*)(xr + 256 * j); ss += (t.x * t.x + t.y * t.y) + (t.z * t.z + t.w * t.w); }
        ss = wave_sum(ss);
        const float rs = 1.0f / sqrtf(ss * (1.0f / DM) + 1e-6f);
        const float* g2 = g2base + 4 * F.lane;
        const float* sh = MOD + ((size_t)(l * 3 + mr)) * 12288 + 3 * DM + 4 * F.lane; const float* sc = sh + DM;
        unsigned short* ur = U + (size_t)row * DM + 4 * F.lane;
        float lg[36];
#pragma unroll
        for (int e = 0; e < 36; ++e) lg[e] = 0.f;
#pragma unroll 1
        for (int j = 0; j < 8; ++j) { const f32x4 xv = *(const f32x4*)(xr + 256 * j), g = *(const f32x4*)(g2 + 256 * j), s = *(const f32x4*)(sh + 256 * j), c = *(const f32x4*)(sc + 256 * j);
            const f32x4 y = (xv * rs * g) * (1.0f + c) + s; v2u o; o.x = pk2(y.x, y.y); o.y = pk2(y.z, y.w); *(v2u*)(ur + 256 * j) = o;
            const float yy[4] = {y.x, y.y, y.z, y.w};
#pragma unroll
            for (int q = 0; q < 4; ++q) { const int col = 256 * j + 4 * F.lane + q;
                const f32x4 w1 = *(const f32x4*)(wg1 + (size_t)col * 4);
                lg[0] += yy[q] * w1.x; lg[1] += yy[q] * w1.y; lg[2] += yy[q] * w1.z; lg[3] += yy[q] * w1.w;
                const f32x4* w2 = (const f32x4*)(wg2 + (size_t)col * 32);
#pragma unroll
                for (int e4 = 0; e4 < 8; ++e4) { const f32x4 w = w2[e4]; lg[4 + 4 * e4] += yy[q] * w.x; lg[5 + 4 * e4] += yy[q] * w.y; lg[6 + 4 * e4] += yy[q] * w.z; lg[7 + 4 * e4] += yy[q] * w.w; } } }
#pragma unroll
        for (int e = 0; e < 36; ++e) lg[e] = wave_sum(lg[e]);
        float l1[4]; float mx = -3.0e38f; int grp = 0;
#pragma unroll
        for (int e = 0; e < 4; ++e) { l1[e] = lg[e] + b1[e]; if (l1[e] > mx) { mx = l1[e]; grp = e; } }
        float den = 0.f;
#pragma unroll
        for (int e = 0; e < 4; ++e) den += expf(l1[e] - mx);
        const float ptop = 1.0f / den;
        float v0 = -3.0e38f, v1 = -3.0e38f; int i0 = 0, i1 = 0;
#pragma unroll
        for (int g = 0; g < 4; ++g)
#pragma unroll
            for (int e = 0; e < 8; ++e) { const float x = lg[4 + g * 8 + e] + b2[g * 8 + e];
                if (g == grp) { if (x > v0) { v1 = v0; i1 = i0; v0 = x; i0 = e; } else if (x > v1) { v1 = x; i1 = e; } } }
        const float w0 = ptop / (1.0f + expf(v1 - v0)), w1 = ptop - w0;
        if (F.lane == 0) { const int e0 = grp * 8 + i0, e1 = grp * 8 + i1; EXPERT[row * 2] = e0; EXPERT[row * 2 + 1] = e1; RWT[row * 2] = w0; RWT[row * 2 + 1] = w1;
            __hip_atomic_fetch_add((unsigned*)(F.ctl + CW_CNT + l * 64 + e0), 1u, RLX_AGENT); __hip_atomic_fetch_add((unsigned*)(F.ctl + CW_CNT + l * 64 + e1), 1u, RLX_AGENT); }
    }
}
__device__ __forceinline__ void ph_scatter(const Args& a, Frame& F, int l, int nrows) {
    int* seg = (int*)F.lds;
    if (F.tid == 0) { int s = 0; for (int e = 0; e < 32; ++e) { const int c = (int)__hip_atomic_load((unsigned*)(F.ctl + CW_CNT + l * 64 + e), RLX_AGENT); seg[e] = s; seg[33 + e] = c; s += (c + 255) & ~255; } seg[32] = s; }
    __syncthreads();
    int* SEG = (int*)(F.ws + WS_TAB + TB_SEG) + l * 40; int* TILEE = (int*)(F.ws + WS_TAB + TB_TILEE) + l * 128;
    if (F.bid == 0) { if (F.tid <= 32) SEG[F.tid] = seg[F.tid]; if (F.tid == 0) SEG[36] = seg[32] >> 8;
        if (F.tid < 128) { const int t = F.tid; int e = 0; for (int q = 0; q < 32; ++q) if (t * 256 >= seg[q]) e = q; TILEE[t] = e; } }
    const int gw = F.bid * NWAVES + F.wave, NGW = F.G * NWAVES;
    const int* EXPERT = (const int*)(F.ws + WS_TAB + TB_EXPERT); int* SLOT = (int*)(F.ws + WS_TAB + TB_SLOT);
    const unsigned short* U = (const unsigned short*)(F.ws + WS_U); unsigned short* VG = (unsigned short*)(F.ws + WS_VG);
    for (int q = gw; q < nrows * 2; q += NGW) { const int row = q >> 1, e = EXPERT[q]; int pos = 0;
        if (F.lane == 0) pos = (int)__hip_atomic_fetch_add((unsigned*)(F.ctl + CW_FILL + l * 64 + e), 1u, RLX_AGENT);
        pos = __builtin_amdgcn_readfirstlane(pos); const int slot = seg[e] + pos;
        if (F.lane == 0) SLOT[q] = slot;
        const v4u* src = (const v4u*)(U + (size_t)row * DM); v4u* dst = (v4u*)(VG + (size_t)slot * DM);
#pragma unroll
        for (int j = 0; j < 4; ++j) dst[64 * j + F.lane] = src[64 * j + F.lane]; }
    for (int idx = gw; idx < 32 * 256; idx += NGW) { const int e = idx >> 8, i = idx & 255, c = seg[33 + e];
        if (c + i < ((c + 255) & ~255)) { v4u* dst = (v4u*)(VG + (size_t)(seg[e] + c + i) * DM); const v4u z = {0u, 0u, 0u, 0u};
#pragma unroll
            for (int j = 0; j < 4; ++j) dst[64 * j + F.lane] = z; } }
}

#ifndef MK_PER_PHASE
#define MK_PER_PHASE 1
#endif
constexpr int PH_PER_LAYER = 13, PH_TOTAL = 2 + NLAY * PH_PER_LAYER + 1;

#ifdef DBG_ONLY
#define LSEL(j) ((j) == DBG_ONLY)
#else
#define LSEL(j) true
#endif
#define LAUNDER() do { int t_ = threadIdx.x; asm volatile("" : "+v"(t_)); F.tid = t_; F.lane = t_ & 63; unsigned char* w_ = args.ws; asm volatile("" : "+s"(w_)); F.ws = w_; F.ctl = (gu32*)(w_ + WS_CTL); } while (0)
#define IN(k) (lo <= (k) && (k) < hi)
#define BOTH(k) (IN(k) && IN((k) + 1))
#define GRID_BAR() do { if (MK_PER_PHASE) { if (F.tid == 0) __hip_atomic_store(F.ctl + CW_TMO, 0xBADBA0u, RLX_AGENT); } else { xcd_barrier(bar); } } while (0)
template <int l> __device__ __forceinline__ void layer_phases(const Args& args, Frame& F, const XcdBarrier& bar, const int lo, const int hi, unsigned char* lds, LAS unsigned char* ldsl) {
    const int gw = F.bid * NWAVES + F.wave, NGW = F.G * NWAVES;
        const int pb = 2 + l * PH_PER_LAYER;
        const bool lastl = (l == NLAY - 1);
        const int mrows = lastl ? MLAT : MROWS;
        if (LSEL(0) && IN(pb + 0)) { LAUNDER(); ph_convert(args, F, l); __syncthreads(); ph_rowpass(args, F, l, 0, l > 0 ? 1 : 0, MROWS, MROWS); if (BOTH(pb + 0)) GRID_BAR(); }
        if (LSEL(1) && IN(pb + 1)) { LAUNDER();
            pg8::Gemm g{(const pg8::bf16_t*)(F.ws + WS_U), (const pg8::bf16_t*)(F.ws + WS_WIN), MROWS, INP, DM};
            DenseOrder<INP / 256> S{MROWS / 256, F.G, F.bid};
            EpiStoreBf16<0> E{(unsigned short*)(F.ws + WS_PROJ), INP};
            pg8::gemm_phase<EpiStoreBf16<0>, DenseOrder<INP / 256>, true, true>(ldsl + RING_OFF, g, S, E);
            if (BOTH(pb + 1)) GRID_BAR();
        }
        if (LSEL(2) && IN(pb + 2)) { LAUNDER();
            for (int u = F.bid; u < 1088; u += F.G) rwkv_prep_unit(args, F, l, u);
            for (int wu = gw; wu < 2 * 2 * 64 * NSC; wu += NGW) s5_local(args, F, l, wu);
            if (BOTH(pb + 2)) GRID_BAR();
        }
        if (LSEL(3) && IN(pb + 3)) { LAUNDER();
            const int nrw = F.G / 4, ngl = F.G / 4, ns5 = F.G - nrw - ngl;
            if (F.bid < nrw) { for (int ci = F.bid; ci < 64; ci += nrw) rwkv_scan_chain(args, F, ci); }
            else if (F.bid < nrw + ngl) { for (int u = F.bid - nrw; u < 64; u += ngl) gla_unit(args, F, l, u); }
            else { unsigned short* Hb = (unsigned short*)(lds + F.wave * 17408);
                for (int wu = (F.bid - nrw - ngl) * NWAVES + F.wave; wu < 2 * 64 * NSC; wu += ns5 * NWAVES) s5_final(args, F, l, wu, Hb); }
            if (BOTH(pb + 3)) GRID_BAR();
        }
        if (LSEL(4) && IN(pb + 4)) { LAUNDER();
            for (int u = F.bid; u < (mrows / 32) * 2; u += F.G) zb_unit(args, F, l, u);
            for (int row = gw; row < mrows; row += NGW) zc_row(args, F, l, row);
            if (BOTH(pb + 4)) GRID_BAR();
        }
        if (LSEL(5) && IN(pb + 5)) { LAUNDER();
            pg8::Gemm g{(const pg8::bf16_t*)(F.ws + WS_ZA), (const pg8::bf16_t*)(F.ws + WS_WGLU), mrows, 4096, 1024};
            DenseOrder<16> S{mrows / 256, F.G, F.bid};
            EpiGlu E{(float*)(F.ws + WS_MF), (const unsigned short*)(F.ws + WS_PROJ)};
            pg8::gemm_phase<EpiGlu, DenseOrder<16>, true, true>(ldsl + RING_OFF, g, S, E);
            if (BOTH(pb + 5)) GRID_BAR();
        }
        if (LSEL(6) && IN(pb + 6)) { LAUNDER();
            pg8::Gemm g{(const pg8::bf16_t*)(F.ws + WS_ZB), (const pg8::bf16_t*)(F.ws + WS_WRW), mrows, DM, 1024};
            DenseOrder<8> S{mrows / 256, F.G, F.bid};
            EpiAcc<0> E{(float*)(F.ws + WS_MF), nullptr, (const unsigned short*)(F.ws + WS_PROJ), C_GB, nullptr};
            pg8::gemm_phase<EpiAcc<0>, DenseOrder<8>, true, true>(ldsl + RING_OFF, g, S, E);
            if (BOTH(pb + 6)) GRID_BAR();
        }
        if (LSEL(7) && IN(pb + 7)) { LAUNDER();
            pg8::Gemm g{(const pg8::bf16_t*)(F.ws + WS_ZC), (const pg8::bf16_t*)(F.ws + WS_WGL), mrows, DM, 1024};
            DenseOrder<8> S{mrows / 256, F.G, F.bid};
            EpiAcc<1> E{(float*)(F.ws + WS_MF), (unsigned short*)(F.ws + WS_MB), (const unsigned short*)(F.ws + WS_PROJ), C_GC, nullptr};
            pg8::gemm_phase<EpiAcc<1>, DenseOrder<8>, true, true>(ldsl + RING_OFF, g, S, E);
            if (BOTH(pb + 7)) GRID_BAR();
        }
        if (LSEL(8) && IN(pb + 8)) { LAUNDER();
            pg8::Gemm g{(const pg8::bf16_t*)(F.ws + WS_MB), (const pg8::bf16_t*)(F.ws + WS_WOUT), mrows, DM, DM};
            DenseOrder<8> S{mrows / 256, F.G, F.bid};
            EpiAcc<2> E{(float*)(F.ws + WS_X), nullptr, nullptr, 0, (const float*)(F.ws + WS_MOD) + (size_t)(l * 3) * 12288 + 2 * DM};
            pg8::gemm_phase<EpiAcc<2>, DenseOrder<8>, true, true>(ldsl + RING_OFF, g, S, E);
            if (BOTH(pb + 8)) GRID_BAR();
        }
        if (LSEL(9) && IN(pb + 9)) { LAUNDER(); ph_router(args, F, l, mrows); if (BOTH(pb + 9)) GRID_BAR(); }
        if (LSEL(10) && IN(pb + 10)) { LAUNDER(); ph_scatter(args, F, l, mrows); if (BOTH(pb + 10)) GRID_BAR(); }
        if (LSEL(11) && IN(pb + 11)) { LAUNDER();
            const int* SEG = (const int*)(F.ws + WS_TAB + TB_SEG) + l * 40; const int nt = __builtin_amdgcn_readfirstlane(SEG[36]);
            pg8::Gemm g{(const pg8::bf16_t*)(F.ws + WS_VG), (const pg8::bf16_t*)(F.ws + WS_WGU), MOE_ROWS, 32 * 512, DM};
            MoeOrder<2> S{(const int*)(F.ws + WS_TAB + TB_TILEE) + l * 128, nt, F.G, F.bid};
            EpiMoe1 E{(unsigned short*)(F.ws + WS_HID)};
            pg8::gemm_phase<EpiMoe1, MoeOrder<2>, true, true>(ldsl + RING_OFF, g, S, E);
            if (BOTH(pb + 11)) GRID_BAR();
        }
        if (LSEL(12) && IN(pb + 12)) { LAUNDER();
            const int* SEG = (const int*)(F.ws + WS_TAB + TB_SEG) + l * 40; const int nt = __builtin_amdgcn_readfirstlane(SEG[36]);
            int kdn = 256; asm volatile("" : "+s"(kdn));
            pg8::Gemm g{(const pg8::bf16_t*)(F.ws + WS_HID), (const pg8::bf16_t*)(F.ws + WS_WDN), MOE_ROWS, 32 * DM, kdn};
            MoeOrder<8> S{(const int*)(F.ws + WS_TAB + TB_TILEE) + l * 128, nt, F.G, F.bid};
            EpiStoreBf16<8> E{(unsigned short*)(F.ws + WS_EO), DM};
            pg8::gemm_phase<EpiStoreBf16<8>, MoeOrder<8>, true, true>(ldsl + RING_OFF, g, S, E);
            if (BOTH(pb + 12)) GRID_BAR();
        }
    }

__global__ void __launch_bounds__(NWAVES * 64, 2) mega_fwd(Args args) {
    extern __shared__ __attribute__((aligned(16))) unsigned char lds[];
    Frame F;
    F.lds = lds; F.MISC = (volatile LAS unsigned*)((LAS unsigned char*)lds + MISC_OFF);
    F.tid = threadIdx.x; F.lane = F.tid & 63; F.wave = __builtin_amdgcn_readfirstlane(F.tid >> 6);
    F.G = gridDim.x; F.bid = blockIdx.x;
    F.ctl = (gu32*)(args.ws + WS_CTL); F.ws = args.ws; F.out = args.out;
    for (int u = F.tid; u < (LDS_BYTES - LDSCTL_OFF) / 4; u += NWAVES * 64) ((LAS unsigned*)((LAS unsigned char*)lds + LDSCTL_OFF))[u] = 0u;
    __syncthreads();
    XcdBarrier bar; bar.bar = (unsigned*)(F.ctl + CW_BAR); bar.x = 0; bar.st = nullptr;
    if (!MK_PER_PHASE) bar = xcd_barrier_post((unsigned*)(F.ctl + CW_BAR), F.MISC + 8);
    const int lo = args.ph_lo, hi = args.ph_hi;
    LAS unsigned char* ldsl = (LAS unsigned char*)lds;
    const int gw = F.bid * NWAVES + F.wave, NGW = F.G * NWAVES;

    if (LSEL(100) && IN(0)) { LAUNDER(); ph_mod_partial(args, F); if (BOTH(0)) GRID_BAR(); }
    if (LSEL(101) && IN(1)) { LAUNDER(); ph_mod_reduce(args, F); if (BOTH(1)) GRID_BAR(); }

    layer_phases<0>(args, F, bar, lo, hi, lds, ldsl);
    layer_phases<1>(args, F, bar, lo, hi, lds, ldsl);
    if (LSEL(102) && IN(PH_TOTAL - 1)) { LAUNDER(); ph_rowpass(args, F, NLAY, 2, 1, MLAT, MLAT); }
}

extern "C" void kernel_launch(void* const* d_in, const int* in_sizes, int n_in, void* d_out, int out_size, void* d_ws, size_t ws_size, hipStream_t stream) {
    static int grid = 0;
    if (grid == 0) {
        if (n_in != N_INPUTS || out_size != MLAT * DM || ws_size < WS_END) { fprintf(stderr, "kernel_launch: unexpected shapes (n_in %d out %d ws %zu)\n", n_in, out_size, ws_size); grid = -1; return; }
        int dev = 0, cus = 0;
        if (hipGetDevice(&dev) != hipSuccess || hipDeviceGetAttribute(&cus, hipDeviceAttributeMultiprocessorCount, dev) != hipSuccess) { grid = -1; return; }
        if (hipFuncSetAttribute((const void*)mega_fwd, hipFuncAttributeMaxDynamicSharedMemorySize, LDS_BYTES) != hipSuccess) { fprintf(stderr, "kernel_launch: hipFuncSetAttribute failed\n"); grid = -1; return; }
        int per_cu = 0;
        if (hipOccupancyMaxActiveBlocksPerMultiprocessor(&per_cu, (const void*)mega_fwd, NWAVES * 64, LDS_BYTES) != hipSuccess || per_cu < 1) fprintf(stderr, "kernel_launch: occupancy query reports %d\n", per_cu);
        (void)hipGetLastError();
        grid = cus;
    }
    if (grid < 0) return;
    if (hipMemsetAsync((char*)d_ws + WS_CTL, 0, CTL_ZERO_BYTES, stream) != hipSuccess) return;
    Args a{};
    for (int i = 0; i < N_INPUTS; ++i) a.in[i] = (const float*)d_in[i];
    a.out = (float*)d_out; a.ws = (unsigned char*)d_ws;
#if MK_PER_PHASE
    for (int p = 0; p < PH_TOTAL; ++p) { a.ph_lo = p; a.ph_hi = p + 1; hipLaunchKernelGGL(mega_fwd, dim3(grid), dim3(NWAVES * 64), LDS_BYTES, stream, a); }
#else
    a.ph_lo = 0; a.ph_hi = PH_TOTAL; hipLaunchKernelGGL(mega_fwd, dim3(grid), dim3(NWAVES * 64), LDS_BYTES, stream, a);
#endif
}
```

```cpp
#include <hip/hip_runtime.h>
#include <cstdio>
#define OLD_MERGE
#define INPROJ_XCD
#define LDU_PAD 0
namespace pg8 {
#define PG8_LAS __attribute__((address_space(3)))
typedef unsigned short bf16_t;
typedef short bf16x8 __attribute__((ext_vector_type(8)));
typedef float f32x4 __attribute__((ext_vector_type(4)));
typedef unsigned u32x4 __attribute__((ext_vector_type(4)));
constexpr int BM = 256, BK = 64, HALF = 128, HTB = HALF * BK * 2  , STAGE_BYTES = 8 * HTB, NXCD = 8, WGM = 8;

__host__ __device__ __forceinline__ int lds_byte(int r, int c) { const int st = (r >> 4) * 2 + (c >> 5), rr = r & 15, cc = c & 31, ob = rr * 64 + cc * 2; return st * 1024 + (ob ^ (((ob >> 9) & 1) << 5)); }
__host__ __device__ __forceinline__ void stage_rc(int b, int& R, int& C) { const int st = b / 1024, sb = b % 1024, swz = sb ^ (((sb >> 9) & 1) << 5); R = (st >> 1) * 16 + swz / 64; C = (st & 1) * 32 + (swz % 64) / 2; }
__host__ __device__ __forceinline__ int perm32(int rho) { const int n = rho >> 4, i = rho & 15; return 8 * (i >> 2) + 4 * n + (i & 3); }

struct Unit { int pm, pn; };
struct Gemm { const bf16_t* A; const bf16_t* Bt; int M, N, K, lda, ldb; };

struct StaticOrder {
    int nM, nN, nwg, G, c;
    __host__ __device__ void init(int M, int N, int G_, int c_) { nM = M / BM; nN = N / BM; nwg = nM * nN; G = G_; c = c_; }
    __host__ __device__ bool next(int i, Unit& u) const {
        const long L = (long)i * G + c; if (L >= nwg) return false;
        int wgid = (int)L; { const int q = nwg / NXCD, r = nwg % NXCD, xcd = wgid % NXCD, off = wgid / NXCD; wgid = (xcd < r ? xcd * (q + 1) : r * (q + 1) + (xcd - r) * q) + off; }
        const int nig = WGM * nN, gid = wgid / nig, fm = gid * WGM, gsz = (nM - fm) < WGM ? (nM - fm) : WGM;
        u.pm = fm + ((wgid % nig) % gsz); u.pn = (wgid % nig) / gsz; return true;
    }
    __device__ __forceinline__ void a_ready(const Unit&) const {}
    __device__ __forceinline__ void done(const Unit&) const {}
};

typedef __bf16 bf16x2_cv __attribute__((ext_vector_type(2))); typedef float f32x2_cv __attribute__((ext_vector_type(2)));
__device__ __forceinline__ unsigned cvt_pk_bf16(float lo, float hi) { const f32x2_cv v = {lo, hi}; return __builtin_bit_cast(unsigned, __builtin_convertvector(v, bf16x2_cv)); }
template <class T, class = void> struct sched_gather { static constexpr bool value = false; };
template <class T> struct sched_gather<T, decltype((void)T::GATHER)> { static constexpr bool value = T::GATHER; };
template <class Epi, class Sched, bool ALIGN_EPI = false, bool SP2 = false>
__device__ __forceinline__ void gemm_phase(PG8_LAS unsigned char* lds, const Gemm g, const Sched& S, const Epi& E) {
    static_assert(SP2 || !sched_gather<Sched>::value, "gather staging is wired into the SP2 K-loop only");
    int tid_l = threadIdx.x; asm volatile("" : "+v"(tid_l));
    const int tid = tid_l, wid = __builtin_amdgcn_readfirstlane(tid >> 6), lane = tid & 63, wr = wid >> 2, wc = wid & 3, fr = lane & 15, fq = lane >> 4;
    const int K = g.K, nt = K / BK;
    unsigned voffA[2], voffB[2]; int stR[2], stC[2];
#pragma unroll
    for (int i = 0; i < 2; ++i) { int R, C; stage_rc(tid * 16 + i * 8192, R, C); const int Rb = Epi::PERM ? ((R & ~31) + perm32(R & 31)) : R; stR[i] = R; stC[i] = C;
        voffA[i] = (unsigned)(R * g.lda + C) * 2u; voffB[i] = (unsigned)(Rb * g.ldb + C) * 2u; }
    constexpr bool GATHER = sched_gather<Sched>::value;
    unsigned vgC[2][2] = {{0u, 0u}, {0u, 0u}}, vgN[2][2] = {{0u, 0u}, {0u, 0u}};
#define PG8_GLOAD(dst, unit) do { if constexpr (GATHER) { _Pragma("unroll") for (int h_ = 0; h_ < 2; ++h_) _Pragma("unroll") for (int i_ = 0; i_ < 2; ++i_) \
        dst[h_][i_] = (unsigned)(S.src_row((unit), h_ * HALF + stR[i_]) * g.lda + stC[i_]) * 2u; } } while (0)
    const size_t kstep = (size_t)(BK * 2);
    const size_t hstepA = (size_t)HALF * g.lda * 2, hstepB = (size_t)HALF * g.ldb * 2;
    const size_t tstepA = 2 * hstepA, tstepB = 2 * hstepB;
    const unsigned ldsw = (unsigned)wid * 1024u;
    const int aoff = lds_byte(wr * 64 + fr, fq * 8), boff = lds_byte(wc * 32 + fr, fq * 8);
#define PG8_SA(b, h) (((b) * 2 + (h)) * HTB)
#define PG8_SB(b, h) ((4 + (b) * 2 + (h)) * HTB)
#define PG8_STAGE(bufoff, gbase, voff) do { _Pragma("unroll") for (int _i = 0; _i < 2; ++_i) \
        __builtin_amdgcn_global_load_lds((const unsigned*)((const char*)(gbase) + (voff)[_i]), (PG8_LAS unsigned*)(lds + (bufoff) + ldsw + _i * 8192), 16, 0, 0); } while (0)
#define PG8_STAGE_A(bufoff, p, h, nx) do { if constexpr (GATHER) { const unsigned vv_[2] = {(nx) ? vgN[h][0] : vgC[h][0], (nx) ? vgN[h][1] : vgC[h][1]}; PG8_STAGE(bufoff, p, vv_); } else PG8_STAGE(bufoff, (p) + (h) * hstepA, voffA); } while (0)
#define PG8_LDA(dst, b, h) do { _Pragma("unroll") for (int m = 0; m < 4; ++m) _Pragma("unroll") for (int k = 0; k < 2; ++k) dst[m][k] = *(const PG8_LAS bf16x8*)(lds + PG8_SA(b, h) + aoff + m * 2048 + k * 1024); } while (0)
#define PG8_LDB(dst, b, h) do { _Pragma("unroll") for (int n = 0; n < 2; ++n) _Pragma("unroll") for (int k = 0; k < 2; ++k) dst[n][k] = *(const PG8_LAS bf16x8*)(lds + PG8_SB(b, h) + boff + n * 2048 + k * 1024); } while (0)
#define PG8_MMA(ai, bj, At, Bt) do { __builtin_amdgcn_s_setprio(1); _Pragma("unroll") for (int m = 0; m < 4; ++m) _Pragma("unroll") for (int n = 0; n < 2; ++n) _Pragma("unroll") for (int k = 0; k < 2; ++k) \
        acc[ai][bj][m][n] = __builtin_amdgcn_mfma_f32_16x16x32_bf16(Bt[n][k], At[m][k], acc[ai][bj][m][n], 0, 0, 0); __builtin_amdgcn_s_setprio(0); } while (0)
#define PG8_WAIT_V(n) asm volatile("s_waitcnt vmcnt(" #n ")" ::: "memory")
#define PG8_WAIT_L(n) asm volatile("s_waitcnt lgkmcnt(" #n ")" ::: "memory")
#define PG8_BAR __builtin_amdgcn_s_barrier()
#define PG8_SCHED __builtin_amdgcn_sched_barrier(0)
    Unit cur, nxt; int ui = 0;
    if (!S.next(0, cur)) return;
    f32x4 acc[2][2][4][2];
#pragma unroll
    for (int a = 0; a < 2; ++a)
#pragma unroll
        for (int b = 0; b < 2; ++b)
#pragma unroll
            for (int m = 0; m < 4; ++m)
#pragma unroll
                for (int n = 0; n < 2; ++n) acc[a][b][m][n] = (f32x4){0.f, 0.f, 0.f, 0.f};
    bf16x8 At[4][2], B0[2][2], B1[2][2];
    const char* cA = (const char*)g.A + (GATHER ? (size_t)0 : (size_t)cur.pm * tstepA); const char* cB = (const char*)g.Bt + (size_t)cur.pn * tstepB;
    PG8_GLOAD(vgC, cur);
    S.a_ready(cur);
    if constexpr (SP2) {
        PG8_STAGE(PG8_SB(0, 0), cB, voffB); PG8_STAGE(PG8_SB(0, 1), cB + hstepB, voffB); PG8_STAGE_A(PG8_SA(0, 0), cA, 0, false); PG8_STAGE_A(PG8_SA(0, 1), cA, 1, false);
        if (wr == 1) PG8_BAR;
        PG8_WAIT_V(2); PG8_BAR;
        PG8_STAGE(PG8_SB(1, 0), cB + kstep, voffB); PG8_STAGE_A(PG8_SA(1, 0), cA + kstep, 0, false); PG8_STAGE(PG8_SB(1, 1), cB + hstepB + kstep, voffB);
        PG8_WAIT_V(6); PG8_BAR;
    } else {
        PG8_STAGE(PG8_SB(0, 0), cB, voffB); PG8_STAGE(PG8_SA(0, 0), cA, voffA); PG8_STAGE(PG8_SB(0, 1), cB + hstepB, voffB); PG8_STAGE(PG8_SA(0, 1), cA + hstepA, voffA);
        if (wr == 1) PG8_BAR;
        PG8_WAIT_V(4); PG8_BAR;
        PG8_STAGE(PG8_SB(1, 0), cB + kstep, voffB); PG8_STAGE(PG8_SA(1, 0), cA + kstep, voffA); PG8_STAGE(PG8_SB(1, 1), cB + hstepB + kstep, voffB);
        PG8_WAIT_V(6); PG8_BAR;
    }
    for (;;) {
        const bool has_next = S.next(ui + 1, nxt);
        const char* nA = (has_next && !GATHER) ? (const char*)g.A + (size_t)nxt.pm * tstepA : cA;
        if constexpr (GATHER) { if (has_next) PG8_GLOAD(vgN, nxt); else {
#pragma unroll
            for (int h_ = 0; h_ < 2; ++h_) { vgN[h_][0] = vgC[h_][0]; vgN[h_][1] = vgC[h_][1]; } } } const char* nB = has_next ? (const char*)g.Bt + (size_t)nxt.pn * tstepB : cB;
        for (int t = 0; t < nt; t += 2) {
            const bool last = (t == nt - 2);
            const char* a1 = cA + (size_t)(t + 1) * kstep;
            const char* a2 = last ? nA : cA + (size_t)(t + 2) * kstep; const char* b2 = last ? nB : cB + (size_t)(t + 2) * kstep;
            const char* a3 = a2 + kstep; const char* b3 = b2 + kstep;
            if (last && has_next) S.a_ready(nxt);
            if constexpr (SP2) {
            PG8_LDB(B0, 0, 0); PG8_LDB(B1, 0, 1); PG8_SCHED; PG8_LDA(At, 0, 0); PG8_STAGE_A(PG8_SA(1, 1), a1, 1, false);
            PG8_WAIT_V(8); PG8_WAIT_L(0); PG8_BAR; PG8_MMA(0, 0, At, B0); PG8_MMA(0, 1, At, B1); PG8_BAR; PG8_SCHED;
            PG8_LDA(At, 0, 1); PG8_STAGE(PG8_SB(0, 0), b2, voffB); PG8_STAGE(PG8_SB(0, 1), b2 + hstepB, voffB); PG8_STAGE_A(PG8_SA(0, 0), a2, 0, last);
            PG8_WAIT_V(8); PG8_WAIT_L(0); PG8_BAR; PG8_MMA(1, 0, At, B0); PG8_MMA(1, 1, At, B1); PG8_BAR; PG8_SCHED;
            PG8_LDB(B0, 1, 0); PG8_LDB(B1, 1, 1); PG8_SCHED; PG8_LDA(At, 1, 0); PG8_STAGE_A(PG8_SA(0, 1), a2, 1, last);
            PG8_WAIT_V(8); PG8_WAIT_L(0); PG8_BAR; PG8_MMA(0, 0, At, B0); PG8_MMA(0, 1, At, B1); PG8_BAR; PG8_SCHED;
            PG8_LDA(At, 1, 1); PG8_STAGE(PG8_SB(1, 0), b3, voffB); PG8_STAGE(PG8_SB(1, 1), b3 + hstepB, voffB); PG8_STAGE_A(PG8_SA(1, 0), a3, 0, last);
            PG8_WAIT_V(8); PG8_WAIT_L(0); PG8_BAR; PG8_MMA(1, 0, At, B0); PG8_MMA(1, 1, At, B1); PG8_BAR; PG8_SCHED;
            } else {
            PG8_LDB(B0, 0, 0); PG8_SCHED; PG8_LDA(At, 0, 0); PG8_STAGE(PG8_SA(1, 1), a1 + hstepA, voffA);
            PG8_WAIT_L(8); PG8_BAR; PG8_WAIT_L(0); PG8_MMA(0, 0, At, B0); PG8_BAR; PG8_SCHED;
            PG8_LDB(B1, 0, 1); PG8_STAGE(PG8_SB(0, 0), b2, voffB);
            PG8_BAR; PG8_WAIT_L(0); PG8_MMA(0, 1, At, B1); PG8_BAR;
            PG8_LDA(At, 0, 1); PG8_STAGE(PG8_SA(0, 0), a2, voffA);
            PG8_BAR; PG8_WAIT_L(0); PG8_MMA(1, 0, At, B0); PG8_BAR; PG8_SCHED;
            PG8_STAGE(PG8_SB(0, 1), b2 + hstepB, voffB);
            PG8_WAIT_V(6); PG8_BAR; PG8_MMA(1, 1, At, B1); PG8_BAR;
            PG8_LDB(B0, 1, 0); PG8_SCHED; PG8_LDA(At, 1, 0); PG8_STAGE(PG8_SA(0, 1), a2 + hstepA, voffA);
            PG8_WAIT_L(8); PG8_BAR; PG8_WAIT_L(0); PG8_MMA(0, 0, At, B0); PG8_BAR; PG8_SCHED;
            PG8_LDB(B1, 1, 1); PG8_STAGE(PG8_SB(1, 0), b3, voffB);
            PG8_BAR; PG8_WAIT_L(0); PG8_MMA(0, 1, At, B1); PG8_BAR;
            PG8_LDA(At, 1, 1); PG8_STAGE(PG8_SA(1, 0), a3, voffA);
            PG8_BAR; PG8_WAIT_L(0); PG8_MMA(1, 0, At, B0); PG8_BAR; PG8_SCHED;
            PG8_STAGE(PG8_SB(1, 1), b3 + hstepB, voffB);
            PG8_WAIT_V(6); PG8_BAR; PG8_MMA(1, 1, At, B1); PG8_BAR;
            }
        }
        if constexpr (ALIGN_EPI) { if (wr == 0) PG8_BAR; }
        if constexpr (!Epi::AFTER_DRAIN) { E(acc, cur, wr, wc, fr, fq); S.done(cur); }
        if (!has_next) break;
#pragma unroll
        for (int a = 0; a < 2; ++a)
#pragma unroll
            for (int b = 0; b < 2; ++b)
#pragma unroll
                for (int m = 0; m < 4; ++m)
#pragma unroll
                    for (int n = 0; n < 2; ++n) acc[a][b][m][n] = (f32x4){0.f, 0.f, 0.f, 0.f};
        cur = nxt; cA = nA; cB = nB; ++ui;
        if constexpr (GATHER) {
#pragma unroll
            for (int h_ = 0; h_ < 2; ++h_) { vgC[h_][0] = vgN[h_][0]; vgC[h_][1] = vgN[h_][1]; } }
        if constexpr (ALIGN_EPI) { if (wr == 1) PG8_BAR; }
    }
    PG8_WAIT_V(0);
    if constexpr (!ALIGN_EPI) { if (wr == 0) PG8_BAR; }
    PG8_BAR;
    if constexpr (Epi::AFTER_DRAIN) { E.fused(acc, cur, wr, wc, fr, fq, lds, wid, lane); S.done(cur); }
#undef PG8_SA
#undef PG8_SB
#undef PG8_STAGE
#undef PG8_STAGE_A
#undef PG8_GLOAD
#undef PG8_LDA
#undef PG8_LDB
#undef PG8_MMA
#undef PG8_WAIT_V
#undef PG8_WAIT_L
#undef PG8_BAR
#undef PG8_SCHED
}
}

constexpr int NWAVES = 8;
constexpr int DM = 2048, NBATCH = 2, SEQL = 4096, CTXL = 256, NLAY = 2;
constexpr int MLAT = NBATCH * SEQL, MCTX = NBATCH * CTXL, MROWS = MLAT + MCTX;
constexpr int INW = 13584, INP = 13824;
constexpr int C_S5 = 0, C_RW = 1024, C_GLO = 4224, C_Q = 4352, C_K = 4864, C_V = 5376, C_GK = 6400, C_OG = 6416, C_GA = 7440, C_GB = 9488, C_GC = 11536;
constexpr int LDU = DM + LDU_PAD;
constexpr int NSC = 68;
constexpr int MOE_ROWS = 25600;

enum { I_X = 0, I_C, I_CTX, I_CCTX, I_WMOD, I_BMOD, I_G1, I_G2, I_WIN, I_S5ARE, I_S5AIM, I_S5LDT, I_S5BRE, I_S5BIM, I_S5CRE, I_S5CIM, I_S5D, I_S5GLU,
       I_RWMU, I_RWW0, I_RWWUP, I_RWA0, I_RWAUP, I_RWKK, I_RWKA, I_RWRK, I_RWGUP, I_RWLNW, I_RWLNB, I_RWPROJ, I_GLGKUP, I_GLGKB, I_GLNG, I_GLPROJ, I_WOUT,
       I_MWG1, I_MBG1, I_MWG2, I_MBG2, I_MWGATE, I_MWUP, I_MWDOWN, I_GFINAL, N_INPUTS };

constexpr size_t MiB = 1u << 20;
constexpr size_t WS_CTL = 0, CTL_ZERO_BYTES = 256 * 1024;
constexpr size_t WS_MOD = 1 * MiB;
constexpr size_t WS_POSTAB = 2 * MiB;
constexpr int POSTAB_CAP = 2 * MROWS;
constexpr size_t WS_MODP = 2 * MiB;
constexpr size_t WS_TAB = 12 * MiB;
constexpr size_t WS_X = 14 * MiB;
constexpr size_t WS_U = 82 * MiB;
constexpr size_t WS_WIN = 118 * MiB;
constexpr size_t WS_WGLU = 174 * MiB;
constexpr size_t WS_WRW = 182 * MiB;
constexpr size_t WS_WGL = 186 * MiB;
constexpr size_t WS_WOUT = 190 * MiB;
constexpr size_t WS_WGU = 198 * MiB;
constexpr size_t WS_WDN = 262 * MiB;
constexpr size_t WS_PROJ = 294 * MiB;
constexpr size_t WS_MODP2 = WS_PROJ;
constexpr size_t WS_VG = WS_PROJ;
constexpr size_t WS_HID = WS_PROJ + 100 * MiB;
constexpr size_t WS_EO = WS_PROJ + 113 * MiB;
constexpr size_t WS_PREP = 524 * MiB;
constexpr size_t WS_MF = WS_PREP;
constexpr size_t WS_BONUS = 728 * MiB;
constexpr size_t WS_S5END = 730 * MiB;
constexpr size_t WS_YB = 739 * MiB;
constexpr size_t WS_OG = 773 * MiB;
constexpr size_t WS_ZA = 807 * MiB;
constexpr size_t WS_ZB = 824 * MiB;
constexpr size_t WS_ZC = 841 * MiB;
constexpr size_t WS_MB = 858 * MiB;
constexpr size_t WS_GLA = 892 * MiB;
constexpr size_t WS_YS0 = 936 * MiB;
constexpr size_t WS_END = 953 * MiB;
static_assert(WS_PROJ + (size_t)MROWS * INP * 2 <= WS_PREP && WS_EO + (size_t)MOE_ROWS * DM * 2 <= WS_PREP && WS_PREP + (size_t)2 * MROWS * 6144 * 2 <= WS_BONUS, "ws map");
constexpr size_t TB_EXPERT = 0;
constexpr size_t TB_RWT = 128 * 1024;
constexpr size_t TB_SLOT = 256 * 1024;
constexpr size_t TB_TILEE = 384 * 1024;
constexpr size_t TB_ROWIDX = 1024 * 1024;
constexpr size_t TB_SEG = 392 * 1024;
constexpr int CW_TMO = 0, CW_CODE = 1;
constexpr int CW_BAR = 4096;
constexpr int CW_CNT = 16384;
constexpr int CW_FILL = 16384 + 256;
constexpr int CW_Q2 = 16384 + 768, CW_Q4 = 16384 + 1024;
constexpr int CW_CP2 = 16384 + 1280;
constexpr int CW_MRG = 32768, MRG_LSTRIDE = 8192;
constexpr int CW_CVQ = 16384 + 1536;
constexpr int CW_S5Q = 16384 + 512;

constexpr int RING_OFF = 0, RING_BYTES = 131072;
constexpr int LDS_BYTES = 147456;
constexpr int LDSCTL_OFF = LDS_BYTES - 512, MISC_OFF = LDSCTL_OFF + 320;
#define GAS __attribute__((address_space(1)))
#define LAS __attribute__((address_space(3)))
typedef unsigned short bf16;
typedef unsigned v4u __attribute__((ext_vector_type(4)));
typedef float f32x4 __attribute__((ext_vector_type(4)));
typedef short bf16x8 __attribute__((ext_vector_type(8)));
typedef GAS unsigned gu32;
typedef GAS unsigned long long gu64;
#define RLX_AGENT __ATOMIC_RELAXED, __HIP_MEMORY_SCOPE_AGENT
#define LDS_WAIT() asm volatile("s_waitcnt lgkmcnt(0)" ::: "memory")
#define VM_WAIT() asm volatile("s_waitcnt vmcnt(0)" ::: "memory")
__device__ __forceinline__ unsigned long long rt() { return __builtin_amdgcn_s_memrealtime(); }
typedef __bf16 bf16x2_hw __attribute__((ext_vector_type(2))); typedef float f32x2_hw __attribute__((ext_vector_type(2)));
__device__ __forceinline__ unsigned pk2(float lo, float hi) { const f32x2_hw v = {lo, hi}; return __builtin_bit_cast(unsigned, __builtin_convertvector(v, bf16x2_hw)); }
__device__ __forceinline__ unsigned f2bf(float f) { return (unsigned)__builtin_bit_cast(unsigned short, (__bf16)f); }

#define XB_TMO      128
#define XB_XCNT(j)  (256  + 64 * (j))
#define XB_XSUB(j)  (1280 + 64 * (j))
#define XB_XGEN(j)  (2304 + 64 * (j))
#define XB_TOP      3328
#define XB_TOPGEN   3392
#define XCD_BAR_WORDS 3456
#define XB_SPIN_CAP (1u << 18)

__device__ __forceinline__ unsigned xb_ld(unsigned* p)              { return __hip_atomic_load(p, __ATOMIC_RELAXED, __HIP_MEMORY_SCOPE_AGENT); }
__device__ __forceinline__ unsigned xb_add(unsigned* p, unsigned v) { return __hip_atomic_fetch_add(p, v, __ATOMIC_RELAXED, __HIP_MEMORY_SCOPE_AGENT); }
__device__ __forceinline__ unsigned xb_xcc_id() { return (unsigned)__builtin_amdgcn_s_getreg((3 << 11) | 20) & 0xFu; }
#define XB_SPIN(cond, bar) do { unsigned _sp = 0; while (cond) { __builtin_amdgcn_s_sleep(1); \
    if ((++_sp & 255u) == 0u) { if (xb_ld(&(bar)[XB_TMO])) break; if (_sp > XB_SPIN_CAP) { atomicAdd(&(bar)[XB_TMO], 1u); break; } } } } while (0)

struct XcdBarrier {
    unsigned* bar; unsigned x;
    volatile LAS unsigned* st;
};

__device__ __forceinline__ XcdBarrier xcd_barrier_post(unsigned* bar, volatile LAS unsigned* st) {
    XcdBarrier b; b.bar = bar; b.x = xb_xcc_id(); b.st = st;
    if (threadIdx.x == 0) (void)xb_add(&bar[XB_XCNT(b.x)], 1u);
    return b;
}
__device__ __forceinline__ void xcd_barrier_complete(unsigned* bar, unsigned x, unsigned& nloc, unsigned& nx) {
    const unsigned G = gridDim.x * gridDim.y * gridDim.z;
    unsigned sum, cnt, mine, sp = 0u;
    for (;;) {
        sum = 0u; cnt = 0u; mine = 0u;
#pragma unroll
        for (unsigned j = 0; j < 16; ++j) { const unsigned c = xb_ld(&bar[XB_XCNT(j)]); sum += c; cnt += (c > 0u) ? 1u : 0u; mine = (j == x) ? c : mine; }
        if (sum == G) break;
        __builtin_amdgcn_s_sleep(1);
        if ((++sp & 255u) == 0u) { if (xb_ld(&bar[XB_TMO])) break; if (sp > XB_SPIN_CAP) { atomicAdd(&bar[XB_TMO], 1u); break; } }
    }
    nloc = mine > 0u ? mine : 1u; nx = cnt > 0u ? cnt : 1u;
}

__device__ __forceinline__ void xcd_barrier(const XcdBarrier& b) {
    asm volatile("s_waitcnt vmcnt(0)" ::: "memory");
    __syncthreads();
    if (threadIdx.x == 0) {
        unsigned* bar = b.bar;
        __builtin_amdgcn_s_waitcnt(0);
        unsigned nloc = b.st[0], nx = b.st[1];
        if (nloc == 0u) { xcd_barrier_complete(bar, b.x, nloc, nx); b.st[0] = nloc; b.st[1] = nx; }
        const unsigned old = xb_add(&bar[XB_XSUB(b.x)], 1u);
        const unsigned gen = old / nloc;
        if (old + 1u == (gen + 1u) * nloc) {
            __builtin_amdgcn_fence(__ATOMIC_RELEASE, "agent");
            asm volatile("s_waitcnt vmcnt(0)" ::: "memory");
            const unsigned og = xb_add(&bar[XB_TOP], 1u);
            const unsigned tg = og / nx;
            if (og + 1u == (tg + 1u) * nx) xb_add(&bar[XB_TOPGEN], 1u);
            else XB_SPIN(xb_ld(&bar[XB_TOPGEN]) == tg, bar);
            __builtin_amdgcn_fence(__ATOMIC_ACQUIRE, "agent");
            xb_add(&bar[XB_XGEN(b.x)], 1u);
            asm volatile("s_waitcnt vmcnt(0)" ::: "memory");
        } else {
            XB_SPIN(xb_ld(&bar[XB_XGEN(b.x)]) == gen, bar);
            __builtin_amdgcn_fence(__ATOMIC_ACQUIRE, "agent");
            asm volatile("s_waitcnt vmcnt(0)" ::: "memory");
        }
    }
    __syncthreads();
}


typedef float f32x2 __attribute__((ext_vector_type(2)));
typedef unsigned v2u __attribute__((ext_vector_type(2)));
struct Args { const float* in[N_INPUTS]; float* out; unsigned char* ws; int ph_lo, ph_hi; };
struct Frame { unsigned char* lds; volatile LAS unsigned* MISC; gu32* ctl; unsigned char* ws; float* out; int tid, lane, wave, G, bid; };


template <int I> __device__ __forceinline__ const float* kin() {
    const GAS float* p; auto ka = __builtin_amdgcn_kernarg_segment_ptr();
    asm volatile("s_load_dwordx2 %0, %1, %2\n\ts_waitcnt lgkmcnt(0)" : "=s"(p) : "s"(ka), "n"(I * 8));
    return (const float*)p;
}
__device__ __forceinline__ float bf2f(unsigned short b) { return __builtin_bit_cast(float, ((unsigned)b) << 16); }
__device__ __forceinline__ float bflo(unsigned w) { return __builtin_bit_cast(float, w << 16); }
__device__ __forceinline__ float bfhi(unsigned w) { return __builtin_bit_cast(float, w & 0xffff0000u); }
__device__ __forceinline__ unsigned short f2h(float f) { return __builtin_bit_cast(unsigned short, (_Float16)f); }
__device__ __forceinline__ float h2f(unsigned short h) { return (float)__builtin_bit_cast(_Float16, h); }
__device__ __forceinline__ float sigmoidf_(float x) { return __builtin_amdgcn_rcpf(1.0f + __expf(-x)); }
__device__ __forceinline__ float siluf_(float x) { return x * __builtin_amdgcn_rcpf(1.0f + __expf(-x)); }
__device__ __forceinline__ float wave_sum(float v) {
#pragma unroll
    for (int o = 1; o < 64; o <<= 1) v += __shfl_xor(v, o);
    return v;
}
__device__ __forceinline__ float quad_sum(float v) {
    v += __builtin_bit_cast(float, __builtin_amdgcn_mov_dpp(__builtin_bit_cast(int, v), 0xB1, 0xF, 0xF, true));
    v += __builtin_bit_cast(float, __builtin_amdgcn_mov_dpp(__builtin_bit_cast(int, v), 0x4E, 0xF, 0xF, true));
    return v;
}
__device__ __forceinline__ int row_modidx(int row) { return row < MLAT ? (row >> 12) : 2; }
__device__ __forceinline__ int seq_row(int b, int dir, int sc) {
    if (sc < CTXL) { const int j = dir ? (CTXL - 1 - sc) : sc; return MLAT + b * CTXL + j; }
    const int p = sc - CTXL; const int n = dir ? (SEQL - 1 - p) : p; return b * SEQL + n;
}
__device__ __forceinline__ int gla_row(int b, int dir, int sc) {
    if (sc < CTXL) { const int j = dir ? (CTXL - 1 - sc) : sc; return MLAT + b * CTXL + j; }
    int p = sc - CTXL; if (dir) p = SEQL - 1 - p; const int n = (p & 63) * 64 + (p >> 6); return b * SEQL + n;
}
__device__ __forceinline__ int prev_row(int row, int dir) {
    if (row < MLAT) { const int t = row & (SEQL - 1); return dir ? (t == SEQL - 1 ? -1 : row + 1) : (t == 0 ? -1 : row - 1); }
    const int t = (row - MLAT) & (CTXL - 1); return dir ? (t == CTXL - 1 ? -1 : row + 1) : (t == 0 ? -1 : row - 1);
}

__device__ __forceinline__ void ph_mod_partial(const Args& a, Frame& F) {
    float* sv = (float*)F.lds;
    float* MODP = (float*)(F.ws + WS_MODP2);
    const float* cptr = kin<I_C>(); const float* ccptr = kin<I_CCTX>(); const float* wmod = kin<I_WMOD>();
    for (int u = F.bid; u < 768; u += F.G) {
        const int l = u / 384, r = u % 384, kc = r / 6, jb = r % 6;
        if (F.tid < 192) { const int r3 = F.tid >> 6, k = kc * 32 + (F.tid & 31); const float cv = r3 < 2 ? cptr[r3 * DM + k] : ccptr[k]; sv[F.tid] = siluf_(cv); }
        __syncthreads();
        const int j = jb * 2048 + F.tid * 4;
        f32x4 acc0 = {0, 0, 0, 0}, acc1 = {0, 0, 0, 0}, acc2 = {0, 0, 0, 0};
        const GAS float* wp = (const GAS float*)wmod + ((size_t)l * DM + kc * 32) * 12288 + j;
#pragma unroll 8
        for (int kk = 0; kk < 32; ++kk) { const f32x4 w = *(const GAS f32x4*)(wp + (size_t)kk * 12288); acc0 += sv[kk] * w; acc1 += sv[64 + kk] * w; acc2 += sv[128 + kk] * w; }
        float* o = MODP + ((size_t)(l * 64 + kc) * 3) * 12288 + j;
        *(f32x4*)(o) = acc0; *(f32x4*)(o + 12288) = acc1; *(f32x4*)(o + 2 * 12288) = acc2;
        __syncthreads();
    }
}
__device__ __forceinline__ void ph_mod_reduce(const Args& a, Frame& F) {
    const GAS float* MODP = (const GAS float*)(F.ws + WS_MODP2); float* MOD = (float*)(F.ws + WS_MOD);
    const float* bmod = kin<I_BMOD>();
    for (int i = F.bid * 512 + F.tid; i < 2 * 3 * 12288; i += F.G * 512) {
        const int l = i / 36864, r = (i / 12288) % 3, j = i % 12288;
        float s = bmod[l * 12288 + j];
#pragma unroll 16
        for (int kc = 0; kc < 64; ++kc) s += MODP[((size_t)(l * 64 + kc) * 3 + r) * 12288 + j];
        MOD[i] = s;
    }
}

__device__ __forceinline__ void cvt_item(const float* S, size_t P, int k0, int c0, int ncol_valid, unsigned short* D, int K, int n0, float* scr_, int lane) {
    LAS float* scr = (LAS float*)scr_;
    { const int col = c0 + (lane & 31); const bool ok = col < ncol_valid; const GAS float* sp = (const GAS float*)(S + (size_t)(k0 + (lane >> 5)) * P + col); float v[32];
#pragma unroll
      for (int i = 0; i < 32; ++i) v[i] = ok ? sp[(size_t)(2 * i) * P] : 0.f;
#pragma unroll
      for (int i = 0; i < 32; ++i) scr[(2 * i + (lane >> 5)) * 33 + (lane & 31)] = v[i]; }
    LDS_WAIT(); asm volatile("" ::: "memory");
    const int c = lane & 7;
#pragma unroll
    for (int j = 0; j < 4; ++j) { const int n = (lane >> 3) + 8 * j; const LAS float* s = scr + (8 * c) * 33 + n;
        v4u o; o.x = pk2(s[0 * 33], s[1 * 33]); o.y = pk2(s[2 * 33], s[3 * 33]); o.z = pk2(s[4 * 33], s[5 * 33]); o.w = pk2(s[6 * 33], s[7 * 33]);
        *(GAS v4u*)(D + (size_t)(n0 + n) * K + k0 + 8 * c) = o; }
    LDS_WAIT(); asm volatile("" ::: "memory");
}
constexpr int CV_I0 = 32 * 432, CV_I1 = 16 * 128, CV_I2 = 16 * 64, CV_I3 = 16 * 64, CV_I4 = 32 * 64, CV_I5 = 32 * 32 * 16, CV_I6 = 32 * 4 * 64;
constexpr int CV_MRG0 = CV_I0, CV_MOE0 = CV_I0 + CV_I1 + CV_I2 + CV_I3 + CV_I4, CV_NIT = CV_MOE0 + CV_I5 + CV_I6;
__device__ __forceinline__ void ph_convert_range(const Args& a, Frame& F, int l, int it0, int it1, int wi, int nw) {
    float* scr = (float*)(F.lds + F.wave * 16384);
    constexpr int I0 = CV_I0, I1 = CV_I1, I2 = CV_I2, I3 = CV_I3, I4 = CV_I4, I5 = CV_I5;
    unsigned short* ws16 = (unsigned short*)F.ws;
    for (int it = it0 + wi; it < it1; it += nw) {
        int r = it;
        if (r < I0) { const int kb = r / 432, nb = r % 432; cvt_item(kin<I_WIN>() + (size_t)l * DM * INW, INW, kb * 64, nb * 32, INW, (unsigned short*)(F.ws + WS_WIN), LDU, nb * 32, scr, F.lane); continue; } r -= I0;
        if (r < I1) { const int kb = r / 128, nb = r % 128, n0 = nb * 32, pn = n0 >> 8, h = (n0 & 255) >> 7, i0 = n0 & 127;
            cvt_item(kin<I_S5GLU>() + (size_t)l * 1024 * 4096, 4096, kb * 64, h * 2048 + pn * 128 + i0, 4096, (unsigned short*)(F.ws + WS_WGLU), 1024, n0, scr, F.lane); continue; } r -= I1;
        if (r < I2) { const int kb = r / 64, nb = r % 64; cvt_item(kin<I_RWPROJ>() + (size_t)l * 1024 * DM, DM, kb * 64, nb * 32, DM, (unsigned short*)(F.ws + WS_WRW), 1024, nb * 32, scr, F.lane); continue; } r -= I2;
        if (r < I3) { const int kb = r / 64, nb = r % 64; cvt_item(kin<I_GLPROJ>() + (size_t)l * 1024 * DM, DM, kb * 64, nb * 32, DM, (unsigned short*)(F.ws + WS_WGL), 1024, nb * 32, scr, F.lane); continue; } r -= I3;
        if (r < I4) { const int kb = r / 64, nb = r % 64; cvt_item(kin<I_WOUT>() + (size_t)l * DM * DM, DM, kb * 64, nb * 32, DM, (unsigned short*)(F.ws + WS_WOUT), DM, nb * 32, scr, F.lane); continue; } r -= I4;
        if (r < I5) { const int e = r / 512, q = r % 512, kb = q / 16, nb = q % 16, n0 = nb * 32, j = n0 >> 8, h = (n0 & 255) >> 7, i0 = n0 & 127;
            const float* S = (h ? kin<I_MWUP>() : kin<I_MWGATE>()) + (size_t)(l * 32 + e) * DM * 256;
            cvt_item(S, 256, kb * 64, j * 128 + i0, 256, (unsigned short*)(F.ws + WS_WGU) + (size_t)e * 512 * DM, DM, n0, scr, F.lane); continue; } r -= I5;
        { const int e = r / 256, q = r % 256, kb = q / 64, nb = q % 64;
            cvt_item(kin<I_MWDOWN>() + (size_t)(l * 32 + e) * 256 * DM, DM, kb * 64, nb * 32, DM, (unsigned short*)(F.ws + WS_WDN) + (size_t)e * DM * 256, 256, nb * 32, scr, F.lane); }
    }
    (void)ws16;
}
__device__ __forceinline__ void ph_convert(const Args& a, Frame& F, int l, int it0 = 0) { ph_convert_range(a, F, l, it0, CV_NIT, F.bid * NWAVES + F.wave, F.G * NWAVES); }

__device__ __forceinline__ void ph_rowpass(const Args& a, Frame& F, int l, int mode, int combine, int nrows, int nrows_comb) {
    const int gw = F.bid * NWAVES + F.wave, NGW = F.G * NWAVES;
    float* X = (float*)(F.ws + WS_X); unsigned short* U = (unsigned short*)(F.ws + WS_U);
    const float* MOD = (const float*)(F.ws + WS_MOD);
    const unsigned short* EO = (const unsigned short*)(F.ws + WS_EO);
    const int* SLOT = (const int*)(F.ws + WS_TAB + TB_SLOT); const float* RWT = (const float*)(F.ws + WS_TAB + TB_RWT);
    const float* g1base = kin<I_G1>(); const float* gfbase = kin<I_GFINAL>();
    for (int row = gw; row < nrows; row += NGW) {
        const int mr = row_modidx(row);
        f32x4 v[8]; float* xr = X + (size_t)row * DM + 4 * F.lane;
        const float* xin = (l == 0 && mode == 0) ? (row < MLAT ? kin<I_X>() + (size_t)row * DM : kin<I_CTX>() + (size_t)(row - MLAT) * DM) + 4 * F.lane : xr;
#pragma unroll
        for (int j = 0; j < 8; ++j) v[j] = *(const f32x4*)(xin + 256 * j);
        if (combine && row < nrows_comb) {
            const int* SEGp = (const int*)(F.ws + WS_TAB + TB_SEG) + (l - 1) * 40; const int* EXPERT = (const int*)(F.ws + WS_TAB + TB_EXPERT);
            const int s0 = SEGp[EXPERT[row * 2]] + SLOT[row * 2], s1 = SEGp[EXPERT[row * 2 + 1]] + SLOT[row * 2 + 1]; const float w0 = RWT[row * 2], w1 = RWT[row * 2 + 1];
            const float* g2 = MOD + ((size_t)((l - 1) * 3 + mr)) * 12288 + 5 * DM + 4 * F.lane;
            const unsigned short* e0 = EO + (size_t)s0 * DM + 4 * F.lane; const unsigned short* e1 = EO + (size_t)s1 * DM + 4 * F.lane;
            v2u p0[8], p1[8]; f32x4 gq[8];
#pragma unroll
            for (int j = 0; j < 8; ++j) { p0[j] = *(const GAS v2u*)((const GAS unsigned short*)e0 + 256 * j); p1[j] = *(const GAS v2u*)((const GAS unsigned short*)e1 + 256 * j); gq[j] = *(const GAS f32x4*)((const GAS float*)g2 + 256 * j); }
#pragma unroll
            for (int j = 0; j < 8; ++j) { const f32x4 g = gq[j];
                f32x4 m; m.x = w0 * bflo(p0[j].x) + w1 * bflo(p1[j].x); m.y = w0 * bfhi(p0[j].x) + w1 * bfhi(p1[j].x); m.z = w0 * bflo(p0[j].y) + w1 * bflo(p1[j].y); m.w = w0 * bfhi(p0[j].y) + w1 * bfhi(p1[j].y);
                v[j] += g * m; }
#pragma unroll
            for (int j = 0; j < 8; ++j) *(GAS f32x4*)((GAS float*)xr + 256 * j) = v[j];
        }
        float ss = 0.f;
#pragma unroll
        for (int j = 0; j < 8; ++j) ss += (v[j].x * v[j].x + v[j].y * v[j].y) + (v[j].z * v[j].z + v[j].w * v[j].w);
        ss = wave_sum(ss);
        const float rs = 1.0f / sqrtf(ss * (1.0f / DM) + 1e-6f);
        if (mode == 0) {
            const float* g1 = g1base + l * DM + 4 * F.lane;
            const float* sh = MOD + ((size_t)(l * 3 + mr)) * 12288 + 4 * F.lane; const float* sc = sh + DM;
            unsigned short* ur = U + (size_t)row * LDU + 4 * F.lane;
            f32x4 gg[8], ssv[8], ccv[8];
#pragma unroll
            for (int j = 0; j < 8; ++j) { gg[j] = *(const GAS f32x4*)((const GAS float*)g1 + 256 * j); ssv[j] = *(const GAS f32x4*)((const GAS float*)sh + 256 * j); ccv[j] = *(const GAS f32x4*)((const GAS float*)sc + 256 * j); }
#pragma unroll
            for (int j = 0; j < 8; ++j) { const f32x4 y = (v[j] * rs * gg[j]) * (1.0f + ccv[j]) + ssv[j]; v2u o; o.x = pk2(y.x, y.y); o.y = pk2(y.z, y.w); *(GAS v2u*)((GAS unsigned short*)ur + 256 * j) = o; }
        } else {
            if (row < MLAT) { const float* gf = gfbase + 4 * F.lane; float* o = F.out + (size_t)row * DM + 4 * F.lane;
                f32x4 gg[8];
#pragma unroll
                for (int j = 0; j < 8; ++j) gg[j] = *(const GAS f32x4*)((const GAS float*)gf + 256 * j);
#pragma unroll
                for (int j = 0; j < 8; ++j) *(GAS f32x4*)((GAS float*)o + 256 * j) = v[j] * rs * gg[j]; }
        }
    }
}

struct S5P { f32x2 lb; f32x2 bb[16]; };
__device__ __forceinline__ void s5_params(const Args& a, int l, int d, int g, int p, S5P& P) {
    const int gi = (l * 2 + d) * 64 + g;
    const float are = kin<I_S5ARE>()[gi * 64 + p], aim = kin<I_S5AIM>()[gi * 64 + p], ldt = kin<I_S5LDT>()[gi];
    const float lre = fminf(are, -1e-4f), dt = expf(ldt);
    const float mag = expf(lre * dt), ang = aim * dt;
    float sn, cs; sincosf(ang, &sn, &cs);
    P.lb.x = mag * cs; P.lb.y = mag * sn;
    const float nr = P.lb.x - 1.0f, ni = P.lb.y, den = lre * lre + aim * aim;
    const float cr = (nr * lre + ni * aim) / den, ci = (ni * lre - nr * aim) / den;
    const float* bre = kin<I_S5BRE>() + ((size_t)gi * 64 + p) * 16; const float* bim = kin<I_S5BIM>() + ((size_t)gi * 64 + p) * 16;
#pragma unroll
    for (int i = 0; i < 16; ++i) { const float br = bre[i], bi = bim[i]; P.bb[i].x = cr * br - ci * bi; P.bb[i].y = cr * bi + ci * br; }
}
__device__ __forceinline__ void s5_load_u(const unsigned short* PROJ, int row, int g, float (&u)[16]) {
    const v4u* p = (const v4u*)(PROJ + (size_t)row * INP + C_S5 + g * 16);
    const v4u q0 = p[0], q1 = p[1];
    u[0] = bflo(q0.x); u[1] = bfhi(q0.x); u[2] = bflo(q0.y); u[3] = bfhi(q0.y); u[4] = bflo(q0.z); u[5] = bfhi(q0.z); u[6] = bflo(q0.w); u[7] = bfhi(q0.w);
    u[8] = bflo(q1.x); u[9] = bfhi(q1.x); u[10] = bflo(q1.y); u[11] = bfhi(q1.y); u[12] = bflo(q1.z); u[13] = bfhi(q1.z); u[14] = bflo(q1.w); u[15] = bfhi(q1.w);
}
__device__ __forceinline__ f32x2 s5_step(const S5P& P, f32x2 h, const float (&u)[16]) {
    float br = 0.f, bi = 0.f;
#pragma unroll
    for (int i = 0; i < 16; ++i) { br += P.bb[i].x * u[i]; bi += P.bb[i].y * u[i]; }
    f32x2 o; o.x = P.lb.x * h.x - P.lb.y * h.y + br; o.y = P.lb.x * h.y + P.lb.y * h.x + bi; return o;
}
__device__ __forceinline__ void s5_stage_u(const unsigned short* PROJ, int b, int d, int sc, int g, int lane, float* Ul) {
    float u[16]; s5_load_u(PROJ, seq_row(b, d, sc * 64 + lane), g, u);
    f32x4* o = (f32x4*)(Ul + lane * 16);
    o[0] = (f32x4){u[0], u[1], u[2], u[3]}; o[1] = (f32x4){u[4], u[5], u[6], u[7]}; o[2] = (f32x4){u[8], u[9], u[10], u[11]}; o[3] = (f32x4){u[12], u[13], u[14], u[15]};
    asm volatile("s_waitcnt lgkmcnt(0)" ::: "memory");
}
__device__ __forceinline__ void s5_read_u(const float* Ul, int i, float (&u)[16]) {
    const f32x4* p = (const f32x4*)(Ul + i * 16); const f32x4 a = p[0], b = p[1], c = p[2], d = p[3];
    u[0] = a.x; u[1] = a.y; u[2] = a.z; u[3] = a.w; u[4] = b.x; u[5] = b.y; u[6] = b.z; u[7] = b.w; u[8] = c.x; u[9] = c.y; u[10] = c.z; u[11] = c.w; u[12] = d.x; u[13] = d.y; u[14] = d.z; u[15] = d.w;
}
__device__ __forceinline__ void s5_local(const Args& a, Frame& F, int l, int wu, float* Ul) {
    const int d = wu / (2 * 64 * NSC), r1 = wu % (2 * 64 * NSC), b = r1 / (64 * NSC), r2 = r1 % (64 * NSC), g = r2 / NSC, sc = r2 % NSC;
    const unsigned short* PROJ = (const unsigned short*)(F.ws + WS_PROJ);
    S5P P; s5_params(a, l, d, g, F.lane, P);
    s5_stage_u(PROJ, b, d, sc, g, F.lane, Ul);
    f32x2 h = {0.f, 0.f};
#pragma unroll 4
    for (int i = 0; i < 64; ++i) { float u[16]; s5_read_u(Ul, i, u); h = s5_step(P, h, u); }
    f32x2* END = (f32x2*)(F.ws + WS_S5END);
    END[((size_t)((d * 2 + b) * 64 + g) * NSC + sc) * 64 + F.lane] = h;
    asm volatile("s_waitcnt lgkmcnt(0)" ::: "memory");
}

__device__ __forceinline__ float row16_sum(float v) { v += __shfl_xor(v, 1); v += __shfl_xor(v, 2); v += __shfl_xor(v, 4); v += __shfl_xor(v, 8); return v; }
__device__ __forceinline__ f32x4 mfma16b(v4u a_, v4u b_, f32x4 c_) { typedef short s8 __attribute__((ext_vector_type(8))); return __builtin_amdgcn_mfma_f32_16x16x32_bf16(__builtin_bit_cast(s8, a_), __builtin_bit_cast(s8, b_), c_, 0, 0, 0); }
struct RwLora { v4u w[4][2], a[4][2]; };
constexpr size_t TB_LORAW = 1280 * 1024, TB_LORAA = 1536 * 1024;
__device__ __forceinline__ void ph_lora_split(Frame& F, int l) {
    GAS unsigned short* FW = (GAS unsigned short*)(F.ws + WS_TAB + TB_LORAW); GAS unsigned short* FA = (GAS unsigned short*)(F.ws + WS_TAB + TB_LORAA);
    const GAS float* wp = (const GAS float*)kin<I_RWWUP>() + (size_t)(l * 2) * 64 * 1024; const GAS float* ap = (const GAS float*)kin<I_RWAUP>() + (size_t)(l * 2) * 64 * 1024;
    for (int i = F.bid * (NWAVES * 64) + F.tid; i < 2 * 64 * 1024; i += F.G * NWAVES * 64) { const int d = i >> 16, k = (i >> 10) & 63, c = i & 1023;
        const int head = c >> 6, ct = (c >> 4) & 3, l15 = c & 15, ks = k >> 5, q = (k >> 3) & 3, e = k & 7;
        const int fo = (((((d * 16 + head) * 4 + ct) * 2 + ks) * 64) + q * 16 + l15) * 8 + e;
        FW[fo] = (unsigned short)f2bf(wp[i]); FA[fo] = (unsigned short)f2bf(ap[i]); }
}
__device__ __forceinline__ void rwkv_lora_frags(Frame& F, int l, int d, int ch, RwLora& B) {
    const GAS unsigned short* FW = (const GAS unsigned short*)(F.ws + WS_TAB + TB_LORAW) + (size_t)((d * 16 + ch * 8 + F.wave) * 8) * 512 + F.lane * 8;
    const GAS unsigned short* FA = (const GAS unsigned short*)(F.ws + WS_TAB + TB_LORAA) + (size_t)((d * 16 + ch * 8 + F.wave) * 8) * 512 + F.lane * 8;
#pragma unroll
    for (int ct = 0; ct < 4; ++ct)
#pragma unroll
        for (int ks = 0; ks < 2; ++ks) { B.w[ct][ks] = *(const GAS v4u*)(FW + (ct * 2 + ks) * 512); B.a[ct][ks] = *(const GAS v4u*)(FA + (ct * 2 + ks) * 512); }
}
template <int VAR> __device__ __forceinline__ void rwkv_prep_unit(Frame& F, int l, int d, int ch, int tb, const RwLora& B) {
    const unsigned short* PROJ = (const unsigned short*)(F.ws + WS_PROJ);
    unsigned short* PREP = (unsigned short*)(F.ws + WS_PREP); float* BON = (float*)(F.ws + WS_BONUS);
    unsigned short* lora = (unsigned short*)F.lds;
    unsigned short* zs = (unsigned short*)(F.lds + 16384);
    const float* mu = kin<I_RWMU>() + (size_t)(l * 2 + d) * 3200;
    const int row0 = tb * 32;
#pragma unroll 1
    for (int i = 0; i < 13; ++i) { const int p = F.tid + 512 * i; if (p < 34 * 3 * 64) { const int rr = p / 192, qq = p % 192, seg = qq >> 6, pc = qq & 63; int row = row0 - 1 + rr; row = row < 0 ? 0 : (row >= MROWS ? MROWS - 1 : row);
        __builtin_amdgcn_global_load_lds((const GAS unsigned*)(PROJ + (size_t)row * INP + C_RW + seg * 1024 + ch * 512 + pc * 8), (LAS unsigned*)((LAS unsigned char*)zs + (size_t)(p - F.lane) * 16), 16, 0, 0); } }
    {   const int rr = F.tid >> 4, j0 = (F.tid & 15) * 8, row = row0 + rr, pr = prev_row(row, d);
        const v4u z = *(const v4u*)(PROJ + (size_t)row * INP + C_RW + 3072 + j0);
        v4u zp = {0u, 0u, 0u, 0u}; if (pr >= 0) zp = *(const v4u*)(PROJ + (size_t)pr * INP + C_RW + 3072 + j0);
        const unsigned zw[4] = {z.x, z.y, z.z, z.w}, pw[4] = {zp.x, zp.y, zp.z, zp.w}; float o[8];
#pragma unroll
        for (int e = 0; e < 8; ++e) { const float zv = (e & 1) ? bfhi(zw[e >> 1]) : bflo(zw[e >> 1]), pv = (e & 1) ? bfhi(pw[e >> 1]) : bflo(pw[e >> 1]);
            float zz = zv + (pv - zv) * mu[3072 + j0 + e]; if (j0 + e < 64) zz = 1.0f - 2.0f * __builtin_amdgcn_rcpf(1.0f + __expf(2.0f * zz)); o[e] = zz; }
        *(v4u*)(lora + rr * 136 + j0) = (v4u){pk2(o[0], o[1]), pk2(o[2], o[3]), pk2(o[4], o[5]), pk2(o[6], o[7])}; }
    const int lane = F.lane, l15 = lane & 15, q = lane >> 4, h = ch * 8 + F.wave;
    float w0[4], a0[4], mur[4], muk[4], muv[4], kkw[4], kaw[4], rkw[4];
#pragma unroll
    for (int ct = 0; ct < 4; ++ct) { const int c = h * 64 + 16 * ct + l15;
        w0[ct] = ((const GAS float*)kin<I_RWW0>())[(l * 2 + d) * 1024 + c]; a0[ct] = ((const GAS float*)kin<I_RWA0>())[(l * 2 + d) * 1024 + c]; mur[ct] = ((const GAS float*)mu)[c]; muk[ct] = ((const GAS float*)mu)[1024 + c]; muv[ct] = ((const GAS float*)mu)[2048 + c];
        kkw[ct] = ((const GAS float*)kin<I_RWKK>())[l * 1024 + c]; kaw[ct] = ((const GAS float*)kin<I_RWKA>())[l * 1024 + c]; rkw[ct] = ((const GAS float*)kin<I_RWRK>())[l * 1024 + c]; }
    __syncthreads();
#pragma unroll 1
    for (int rt = 0; rt < 2; ++rt) {
        f32x4 accw[4], acca[4];
        { v4u af[4];
#pragma unroll
          for (int ks = 0; ks < 4; ++ks) af[ks] = *(const v4u*)(lora + (16 * rt + l15) * 136 + 32 * ks + 8 * q);
#pragma unroll
          for (int ct = 0; ct < 4; ++ct) { f32x4 w_ = {0.f, 0.f, 0.f, 0.f}, a_ = w_;
              w_ = mfma16b(af[0], B.w[ct][0], w_); w_ = mfma16b(af[1], B.w[ct][1], w_); a_ = mfma16b(af[2], B.a[ct][0], a_); a_ = mfma16b(af[3], B.a[ct][1], a_);
              accw[ct] = w_; acca[ct] = a_; } }
#pragma unroll
        for (int jj = 0; jj < 4; ++jj) { asm volatile("" ::: "memory"); const int rr = 16 * rt + 4 * q + jj, row = row0 + rr, pr = prev_row(row, d);
            float r[4], k[4], v[4], lw[4], av[4], kkc[4], ss = 0.f;
#pragma unroll
            for (int ct = 0; ct < 4; ++ct) { const int cl = F.wave * 64 + 16 * ct + l15; const unsigned short* zr = zs + ((rr + 1) * 3) * 512 + cl;
                float r_ = bf2f(zr[0]), k_ = bf2f(zr[512]), v_ = bf2f(zr[1024]), rp = 0.f, kp = 0.f, vp = 0.f;
                if (pr >= 0) { const unsigned short* zq = zs + ((pr - row0 + 1) * 3) * 512 + cl; rp = bf2f(zq[0]); kp = bf2f(zq[512]); vp = bf2f(zq[1024]); }
                r[ct] = r_ + (rp - r_) * mur[ct]; k[ct] = k_ + (kp - k_) * muk[ct]; v[ct] = v_ + (vp - v_) * muv[ct];
                lw[ct] = -0.606531f * sigmoidf_(w0[ct] + accw[ct][jj]); av[ct] = sigmoidf_(a0[ct] + acca[ct][jj]);
                kkc[ct] = k[ct] * kkw[ct]; ss += kkc[ct] * kkc[ct]; }
            ss = row16_sum(ss); const float inv = 1.0f / fmaxf(sqrtf(ss), 1e-12f);
            float bon = 0.f; unsigned short hr[4], hk[4], hw[4], hkk[4], hka[4], hv[4];
#pragma unroll
            for (int ct = 0; ct < 4; ++ct) { const float kk = kkc[ct] * inv, kq = k[ct] * (1.0f + (av[ct] - 1.0f) * kaw[ct]); bon += r[ct] * kq * rkw[ct];
                hr[ct] = f2h(r[ct]); hk[ct] = f2h(kq); hw[ct] = f2h(lw[ct]); hkk[ct] = f2h(kk); hka[ct] = f2h(kk * av[ct]); hv[ct] = f2h(v[ct]); }
#define PK4(hh) ((v2u){(unsigned)hh[0] | ((unsigned)hh[1] << 16), (unsigned)hh[2] | ((unsigned)hh[3] << 16)})
            { GAS v2u* o8 = (GAS v2u*)(PREP + (((size_t)d * MROWS + row) * 16 + h) * 384) + l15; o8[0] = PK4(hr); o8[16] = PK4(hk); o8[32] = PK4(hw); o8[48] = PK4(hkk); o8[64] = PK4(hka); o8[80] = PK4(hv); }
#undef PK4
            bon = row16_sum(bon);
            if (l15 == 0) BON[((size_t)d * MROWS + row) * 16 + h] = bon; } }
    __syncthreads();
}

constexpr int RW_SB = 32, RW_SP = 392, RW_NBT = (CTXL + SEQL) / RW_SB;
__device__ __forceinline__ void rwkv_stage(const unsigned short* PREP, const float* BON, float* buf, int b, int d, int h, int bt, int slot, int j) {
#pragma unroll
    for (int i = 0; i < 12; ++i) {
        const int q = j + 256 * i, s = q / 96, e4 = q % 96, sc = bt * RW_SB + s, row = seq_row(b, d, sc);
        const v2u w = *(const v2u*)(PREP + (((size_t)d * MROWS + row) * 16 + h) * 384 + e4 * 4);
        f32x4 o; o.x = h2f((unsigned short)(w.x & 0xffff)); o.y = h2f((unsigned short)(w.x >> 16)); o.z = h2f((unsigned short)(w.y & 0xffff)); o.w = h2f((unsigned short)(w.y >> 16));
        *(f32x4*)(buf + (size_t)(slot * RW_SB + s) * RW_SP + e4 * 4) = o;
    }
    if (j < RW_SB) { const int row = seq_row(b, d, bt * RW_SB + j); buf[(size_t)(slot * RW_SB + j) * RW_SP + 384] = BON[((size_t)d * MROWS + row) * 16 + h]; }
}
__device__ __forceinline__ void rwkv_scan_chain(const Args& a, Frame& F, int ci) {
    const int d = ci >> 5, b = (ci >> 4) & 1, h = ci & 15;
    float* buf = (float*)F.lds;
    const unsigned short* PREP = (const unsigned short*)(F.ws + WS_PREP); const float* BON = (const float*)(F.ws + WS_BONUS);
    unsigned short* YB = (unsigned short*)(F.ws + WS_YB);
    const bool scanner = F.tid < 256; const int r = F.tid >> 2, part = F.tid & 3, j = F.tid - 256;
    f32x4 st[4];
#pragma unroll
    for (int i = 0; i < 4; ++i) st[i] = (f32x4){0.f, 0.f, 0.f, 0.f};
    if (!scanner) rwkv_stage(PREP, BON, buf, b, d, h, 0, 0, j);
    __syncthreads();
    for (int bt = 0; bt < RW_NBT; ++bt) {
        const int slot = bt & 1;
        if (!scanner) { if (bt + 1 < RW_NBT) rwkv_stage(PREP, BON, buf, b, d, h, bt + 1, slot ^ 1, j); }
        else {
            for (int s = 0; s < RW_SB; ++s) {
                const float* base = buf + (size_t)(slot * RW_SB + s) * RW_SP;
                const f32x4* rv = (const f32x4*)(base + part * 16); const f32x4* kp = (const f32x4*)(base + 64 + part * 16); const f32x4* wv = (const f32x4*)(base + 128 + part * 16);
                const f32x4* kk = (const f32x4*)(base + 192 + part * 16); const f32x4* ka = (const f32x4*)(base + 256 + part * 16);
                const float v = base[320 + r], bon = base[384];
                f32x4 t = st[0] * kk[0]; t += st[1] * kk[1]; t += st[2] * kk[2]; t += st[3] * kk[3];
                float sa = (t.x + t.y) + (t.z + t.w); sa = quad_sum(sa);
                f32x4 y4 = {0.f, 0.f, 0.f, 0.f};
#pragma unroll
                for (int i = 0; i < 4; ++i) { st[i] = st[i] * wv[i] + (v * kp[i] - sa * ka[i]); y4 += st[i] * rv[i]; }
                float y = (y4.x + y4.y) + (y4.z + y4.w); y = quad_sum(y);
                if (part == 0) { const int row = seq_row(b, d, bt * RW_SB + s); YB[((size_t)d * MROWS + row) * 1024 + h * 64 + r] = (unsigned short)f2bf(y + bon * v); }
            }
        }
        __syncthreads();
    }
}

__device__ __forceinline__ f32x4 mfma16(bf16x8 a_, bf16x8 b_, f32x4 c_) { return __builtin_amdgcn_mfma_f32_16x16x32_bf16(a_, b_, c_, 0, 0, 0); }
__device__ __forceinline__ void gla_unit(const Args& a, Frame& F, int l, int unit) {
    const int d = unit >> 5, b = (unit >> 4) & 1, h = (unit >> 2) & 3, dvs = unit & 3;
    const unsigned short* PROJ = (const unsigned short*)(F.ws + WS_PROJ);
    unsigned short* OG = (unsigned short*)(F.ws + WS_OG) + (size_t)d * MROWS * 1024;
    unsigned short* qe = (unsigned short*)F.lds;
    unsigned short* ke = qe + 64 * 136;
    unsigned short* qb = ke + 64 * 136;
    unsigned short* kdT = qb + 64 * 136;
    unsigned short* vT = kdT + 128 * 72;
    unsigned short* Pm = vT + 64 * 72;
    unsigned short* ST16 = Pm + 64 * 72;
    float* tot = (float*)(ST16 + 64 * 136);
    float* la32 = tot + 512;
    float* decv = la32 + 128;
    float* gkl = decv + 128;
    int* rowi = (int*)(gkl + 1024);
    const int tid = F.tid, lane = F.lane, w = F.wave, l15 = lane & 15, quad = lane >> 4;
    const int dk = tid & 127, cg = tid >> 7;
    float gup[16];
#pragma unroll
    for (int j = 0; j < 16; ++j) gup[j] = kin<I_GLGKUP>()[((size_t)(l * 2 + d) * 16 + j) * 512 + h * 128 + dk];
    const float gbias = kin<I_GLGKB>()[(l * 2 + d) * 512 + h * 128 + dk];
    const float scale = 0.08838834764831845f;
    for (int i = tid; i < 64 * 136 / 2; i += 512) ((unsigned*)ST16)[i] = 0u;
    f32x4 sacc[4];
#pragma unroll
    for (int i = 0; i < 4; ++i) sacc[i] = (f32x4){0.f, 0.f, 0.f, 0.f};
    for (int ch = 0; ch < NSC; ++ch) {
        if (tid < 64) rowi[tid] = gla_row(b, d, ch * 64 + tid);
        __syncthreads();
        if (tid < 128) { const int c = tid >> 1, hf = tid & 1; const v4u z = *(const v4u*)(PROJ + (size_t)rowi[c] * INP + C_GK + hf * 8); float* o = gkl + c * 16 + hf * 8;
            o[0] = bflo(z.x); o[1] = bfhi(z.x); o[2] = bflo(z.y); o[3] = bfhi(z.y); o[4] = bflo(z.z); o[5] = bfhi(z.z); o[6] = bflo(z.w); o[7] = bfhi(z.w); }
        { const int dv = tid & 63, cgv = tid >> 6; unsigned short vv[8];
#pragma unroll
          for (int e = 0; e < 8; ++e) vv[e] = PROJ[(size_t)rowi[cgv * 8 + e] * INP + C_V + h * 256 + dvs * 64 + dv];
          v4u o; o.x = vv[0] | ((unsigned)vv[1] << 16); o.y = vv[2] | ((unsigned)vv[3] << 16); o.z = vv[4] | ((unsigned)vv[5] << 16); o.w = vv[6] | ((unsigned)vv[7] << 16);
          *(v4u*)(vT + dv * 72 + cgv * 8) = o; }
        __syncthreads();
        float bl[16]; float run = 0.f;
#pragma unroll
        for (int e = 0; e < 16; ++e) { const f32x4* gp = (const f32x4*)(gkl + (cg * 16 + e) * 16); float x = gbias;
#pragma unroll
            for (int j = 0; j < 4; ++j) { const f32x4 g4 = gp[j]; x += g4.x * gup[4 * j] + g4.y * gup[4 * j + 1] + g4.z * gup[4 * j + 2] + g4.w * gup[4 * j + 3]; }
            const float la = (fminf(x, 0.f) - log1pf(expf(-fabsf(x)))) * (1.0f / 16.0f);
            if (e == 0 && cg == 2) la32[dk] = la;
            run += la; bl[e] = run; }
        tot[cg * 128 + dk] = run;
        __syncthreads();
        { const float t0 = tot[dk], t1 = tot[128 + dk], t2 = tot[256 + dk], t3 = tot[384 + dk];
          const float off = cg == 0 ? 0.f : (cg == 1 ? t0 : (cg == 2 ? t0 + t1 : t0 + t1 + t2));
          const float bref = t0 + t1 + la32[dk], blast = (t0 + t1) + (t2 + t3);
          unsigned short kdv[16];
#pragma unroll
          for (int e = 0; e < 16; ++e) { const int c = cg * 16 + e; const float bb = off + bl[e];
              const unsigned short* pr = PROJ + (size_t)rowi[c] * INP + h * 128 + dk;
              const float q = bf2f(pr[C_Q]) * scale, k = bf2f(pr[C_K]);
              qe[c * 136 + dk] = (unsigned short)f2bf(q * expf(bb - bref)); ke[c * 136 + dk] = (unsigned short)f2bf(k * expf(bref - bb));
              qb[c * 136 + dk] = (unsigned short)f2bf(q * expf(bb)); kdv[e] = (unsigned short)f2bf(k * expf(blast - bb)); }
          v4u o0, o1; o0.x = kdv[0] | ((unsigned)kdv[1] << 16); o0.y = kdv[2] | ((unsigned)kdv[3] << 16); o0.z = kdv[4] | ((unsigned)kdv[5] << 16); o0.w = kdv[6] | ((unsigned)kdv[7] << 16);
          o1.x = kdv[8] | ((unsigned)kdv[9] << 16); o1.y = kdv[10] | ((unsigned)kdv[11] << 16); o1.z = kdv[12] | ((unsigned)kdv[13] << 16); o1.w = kdv[14] | ((unsigned)kdv[15] << 16);
          *(v4u*)(kdT + dk * 72 + cg * 16) = o0; *(v4u*)(kdT + dk * 72 + cg * 16 + 8) = o1;
          if (cg == 0) decv[dk] = expf(blast); }
        __syncthreads();
#pragma unroll
        for (int tt = 0; tt < 2; ++tt) { const int t = 2 * w + tt, ti = t >> 2, tj = t & 3; f32x4 acc = {0.f, 0.f, 0.f, 0.f};
            if (tj <= ti) {
#pragma unroll
                for (int kb = 0; kb < 4; ++kb) { const bf16x8 af = *(const bf16x8*)(qe + (16 * ti + l15) * 136 + kb * 32 + quad * 8), bfr = *(const bf16x8*)(ke + (16 * tj + l15) * 136 + kb * 32 + quad * 8);
                    acc = mfma16(af, bfr, acc); } }
            const int m = 16 * tj + l15;
#pragma unroll
            for (int jj = 0; jj < 4; ++jj) { const int c = 16 * ti + quad * 4 + jj; Pm[c * 72 + m] = (m <= c) ? (unsigned short)f2bf(acc[jj]) : (unsigned short)0; } }
        __syncthreads();
#pragma unroll
        for (int tt = 0; tt < 2; ++tt) { const int t = 2 * w + tt, tdv = t >> 2, tc = t & 3; f32x4 acc = {0.f, 0.f, 0.f, 0.f};
#pragma unroll
            for (int kb = 0; kb < 2; ++kb) { const bf16x8 af = *(const bf16x8*)(vT + (16 * tdv + l15) * 72 + kb * 32 + quad * 8), bfr = *(const bf16x8*)(Pm + (16 * tc + l15) * 72 + kb * 32 + quad * 8); acc = mfma16(af, bfr, acc); }
#pragma unroll
            for (int kb = 0; kb < 4; ++kb) { const bf16x8 af = *(const bf16x8*)(ST16 + (16 * tdv + l15) * 136 + kb * 32 + quad * 8), bfr = *(const bf16x8*)(qb + (16 * tc + l15) * 136 + kb * 32 + quad * 8); acc = mfma16(af, bfr, acc); }
            const int c = 16 * tc + l15, dv0 = 16 * tdv + quad * 4;
            v2u o; o.x = pk2(acc[0], acc[1]); o.y = pk2(acc[2], acc[3]);
            *(v2u*)(OG + (size_t)rowi[c] * 1024 + h * 256 + dvs * 64 + dv0) = o; }
        __syncthreads();
        { const float dec = decv[16 * w + l15];
#pragma unroll
          for (int tdv = 0; tdv < 4; ++tdv) { f32x4 acc = sacc[tdv] * dec;
#pragma unroll
              for (int kb = 0; kb < 2; ++kb) { const bf16x8 af = *(const bf16x8*)(vT + (16 * tdv + l15) * 72 + kb * 32 + quad * 8), bfr = *(const bf16x8*)(kdT + (16 * w + l15) * 72 + kb * 32 + quad * 8); acc = mfma16(af, bfr, acc); }
              sacc[tdv] = acc;
#pragma unroll
              for (int jj = 0; jj < 4; ++jj) ST16[(16 * tdv + quad * 4 + jj) * 136 + 16 * w + l15] = (unsigned short)f2bf(acc[jj]); } }
        __syncthreads();
    }
}

__device__ __forceinline__ float gelu_tanh(float x) { const float t = 0.7978845608028654f * (x + 0.044715f * x * x * x); return x * (1.0f - __builtin_amdgcn_rcpf(1.0f + __expf(2.0f * t))); }
__device__ __forceinline__ void s5_final(const Args& a, Frame& F, int l, int wu, unsigned short* Hb, float* Ul) {
    const int b = wu / (64 * NSC), r0 = wu % (64 * NSC), g = r0 / NSC, tcx = r0 % NSC;
    const bool isctx = tcx < 4; const int tc = isctx ? tcx : tcx - 4;
    const unsigned short* PROJ = (const unsigned short*)(F.ws + WS_PROJ);
    const f32x2* END = (const f32x2*)(F.ws + WS_S5END);
    const int lane = F.lane, l15 = lane & 15, quad = lane >> 4;
    f32x4 acc[4];
#pragma unroll
    for (int i = 0; i < 4; ++i) acc[i] = (f32x4){0.f, 0.f, 0.f, 0.f};
#pragma unroll
    for (int dd = 0; dd < 2; ++dd) {
        S5P P; s5_params(a, l, dd, g, lane, P);
        const int scx = dd == 0 ? tcx : (isctx ? 3 - tc : 4 + 63 - tc);
        s5_stage_u(PROJ, b, dd, scx, g, lane, Ul);
        f32x2 lamL = P.lb;
#pragma unroll
        for (int i = 0; i < 6; ++i) { f32x2 t; t.x = lamL.x * lamL.x - lamL.y * lamL.y; t.y = 2.0f * lamL.x * lamL.y; lamL = t; }
        f32x2 hcur = {0.f, 0.f};
        const f32x2* ep = END + ((size_t)((dd * 2 + b) * 64 + g) * NSC) * 64 + lane;
        for (int s0 = 0; s0 < scx; s0 += 4) {
            f32x2 e[4];
#pragma unroll
            for (int k = 0; k < 4; ++k) e[k] = (s0 + k < scx) ? ep[(size_t)(s0 + k) * 64] : (f32x2){0.f, 0.f};
#pragma unroll
            for (int k = 0; k < 4; ++k) if (s0 + k < scx) { f32x2 t; t.x = lamL.x * hcur.x - lamL.y * hcur.y + e[k].x; t.y = lamL.x * hcur.y + lamL.y * hcur.x + e[k].y; hcur = t; } }
        bf16x8 cf[4];
        { const int gi = (l * 2 + dd) * 64 + g;
          const float* cre = kin<I_S5CRE>() + ((size_t)gi * 16 + l15) * 64; const float* cim = kin<I_S5CIM>() + ((size_t)gi * 16 + l15) * 64;
#pragma unroll
          for (int kb = 0; kb < 4; ++kb) { const int k0 = kb * 32 + quad * 8; const float* src = k0 < 64 ? cre + k0 : cim + (k0 - 64); const float sg = k0 < 64 ? 1.f : -1.f;
              const f32x4 x0 = *(const f32x4*)src, x1 = *(const f32x4*)(src + 4);
              cf[kb][0] = (short)f2bf(sg * x0.x); cf[kb][1] = (short)f2bf(sg * x0.y); cf[kb][2] = (short)f2bf(sg * x0.z); cf[kb][3] = (short)f2bf(sg * x0.w);
              cf[kb][4] = (short)f2bf(sg * x1.x); cf[kb][5] = (short)f2bf(sg * x1.y); cf[kb][6] = (short)f2bf(sg * x1.z); cf[kb][7] = (short)f2bf(sg * x1.w); } }
#pragma unroll
        for (int half = 0; half < 2; ++half) {
#pragma unroll 4
            for (int i = 32 * half; i < 32 * half + 32; ++i) { float u[16]; s5_read_u(Ul, i, u); hcur = s5_step(P, hcur, u);
                const int tl = dd ? 63 - i : i; Hb[(tl & 31) * 136 + lane] = (unsigned short)f2bf(hcur.x); Hb[(tl & 31) * 136 + 64 + lane] = (unsigned short)f2bf(hcur.y); }
            asm volatile("s_waitcnt lgkmcnt(0)" ::: "memory");
            const int tbase = (dd ? 1 - half : half) * 2;
#pragma unroll
            for (int t2 = 0; t2 < 2; ++t2)
#pragma unroll
                for (int kb = 0; kb < 4; ++kb) { const bf16x8 hf = *(const bf16x8*)(Hb + (16 * t2 + l15) * 136 + kb * 32 + quad * 8);
                    if (tbase == 0) acc[t2] = mfma16(cf[kb], hf, acc[t2]); else acc[2 + t2] = mfma16(cf[kb], hf, acc[2 + t2]); }
            asm volatile("s_waitcnt lgkmcnt(0)" ::: "memory");
        }
    }
    unsigned short* ZA = (unsigned short*)(F.ws + WS_ZA);
    const f32x4 dvec = *(const f32x4*)(kin<I_S5D>() + l * 1024 + g * 16 + quad * 4);
#pragma unroll
    for (int tt = 0; tt < 4; ++tt) { const int tl = 16 * tt + l15; const int row = isctx ? MLAT + b * CTXL + tc * 64 + tl : b * SEQL + tc * 64 + tl;
        const v2u uu = *(const v2u*)(PROJ + (size_t)row * INP + C_S5 + g * 16 + quad * 4);
        const float z0 = gelu_tanh(acc[tt][0] + dvec.x * bflo(uu.x)), z1 = gelu_tanh(acc[tt][1] + dvec.y * bfhi(uu.x)), z2 = gelu_tanh(acc[tt][2] + dvec.z * bflo(uu.y)), z3 = gelu_tanh(acc[tt][3] + dvec.w * bfhi(uu.y));
        v2u o; o.x = pk2(z0, z1); o.y = pk2(z2, z3); *(v2u*)(ZA + (size_t)row * 1024 + g * 16 + quad * 4) = o; }
}

struct ZbGate { v4u g[4][4]; };
constexpr size_t TB_GATEF = 1792 * 1024;
__device__ __forceinline__ void ph_gate_split(Frame& F, int l) {
    GAS unsigned short* FG = (GAS unsigned short*)(F.ws + WS_TAB + TB_GATEF); const GAS float* gp = (const GAS float*)kin<I_RWGUP>() + (size_t)l * 128 * 1024;
    for (int i = F.bid * (NWAVES * 64) + F.tid; i < 128 * 1024; i += F.G * NWAVES * 64) { const int k = i >> 10, c = i & 1023;
        const int head = c >> 6, ct = (c >> 4) & 3, l15 = c & 15, ks = k >> 5, q = (k >> 3) & 3, e = k & 7;
        FG[((((head * 4 + ct) * 4 + ks) * 64) + q * 16 + l15) * 8 + e] = (unsigned short)f2bf(gp[i]); }
}
__device__ __forceinline__ void zb_gate_frags(Frame& F, int l, int ch, ZbGate& B) {
    const GAS unsigned short* FG = (const GAS unsigned short*)(F.ws + WS_TAB + TB_GATEF) + (size_t)((ch * 8 + F.wave) * 16) * 512 + F.lane * 8;
#pragma unroll
    for (int ct = 0; ct < 4; ++ct)
#pragma unroll
        for (int ks = 0; ks < 4; ++ks) B.g[ct][ks] = *(const GAS v4u*)(FG + (ct * 4 + ks) * 512);
}
__device__ __forceinline__ void zb_unit(Frame& F, int l, int ch, int tb, const ZbGate& B) {
    const int row0 = tb * 32;
    const unsigned short* PROJ = (const unsigned short*)(F.ws + WS_PROJ);
    const unsigned short* YB = (const unsigned short*)(F.ws + WS_YB); unsigned short* ZB = (unsigned short*)(F.ws + WS_ZB);
    unsigned short* sg = (unsigned short*)F.lds;
    { const int rr = F.tid >> 4, j0 = (F.tid & 15) * 8; const v4u z = *(const v4u*)(PROJ + (size_t)(row0 + rr) * INP + C_GLO + j0);
      *(v4u*)(sg + rr * 136 + j0) = (v4u){pk2(sigmoidf_(bflo(z.x)), sigmoidf_(bfhi(z.x))), pk2(sigmoidf_(bflo(z.y)), sigmoidf_(bfhi(z.y))), pk2(sigmoidf_(bflo(z.z)), sigmoidf_(bfhi(z.z))), pk2(sigmoidf_(bflo(z.w)), sigmoidf_(bfhi(z.w)))}; }
    const int lane = F.lane, l15 = lane & 15, q = lane >> 4, h = ch * 8 + F.wave;
    float lnw[4], lnb[4];
#pragma unroll
    for (int ct = 0; ct < 4; ++ct) { const int c = h * 64 + 16 * ct + l15; lnw[ct] = ((const GAS float*)kin<I_RWLNW>())[l * 1024 + c]; lnb[ct] = ((const GAS float*)kin<I_RWLNB>())[l * 1024 + c]; }
    unsigned short yraw[2][2][4][4];
#define ZB_YLOAD(rt_) do { _Pragma("unroll") for (int jj = 0; jj < 4; ++jj) { _Pragma("unroll") for (int ct = 0; ct < 4; ++ct) { const int row = row0 + 16 * (rt_) + 4 * q + jj, c = h * 64 + 16 * ct + l15; \
        yraw[rt_][0][jj][ct] = ((const GAS unsigned short*)YB)[(size_t)row * 1024 + c]; yraw[rt_][1][jj][ct] = ((const GAS unsigned short*)YB)[((size_t)MROWS + row) * 1024 + c]; } } } while (0)
    ZB_YLOAD(0);
    __syncthreads();
#pragma unroll
    for (int rt = 0; rt < 2; ++rt) { v4u af[4]; f32x4 gate[4];
#pragma unroll
        for (int ks = 0; ks < 4; ++ks) af[ks] = *(const v4u*)(sg + (16 * rt + l15) * 136 + 32 * ks + 8 * q);
#pragma unroll
        for (int ct = 0; ct < 4; ++ct) { f32x4 g_ = {0.f, 0.f, 0.f, 0.f};
#pragma unroll
            for (int ks = 0; ks < 4; ++ks) g_ = mfma16b(af[ks], B.g[ct][ks], g_);
            gate[ct] = g_; }
        float yv[4][4];
#pragma unroll
        for (int jj = 0; jj < 4; ++jj)
#pragma unroll
            for (int ct = 0; ct < 4; ++ct) yv[jj][ct] = bf2f(yraw[rt][0][jj][ct]) + bf2f(yraw[rt][1][jj][ct]);
        if (rt == 0) ZB_YLOAD(1);
#pragma unroll
        for (int jj = 0; jj < 4; ++jj) { const int row = row0 + 16 * rt + 4 * q + jj; float y[4], s = 0.f;
#pragma unroll
            for (int ct = 0; ct < 4; ++ct) { y[ct] = yv[jj][ct]; s += y[ct]; }
            const float mean = row16_sum(s) * (1.0f / 64.0f); float vs = 0.f;
#pragma unroll
            for (int ct = 0; ct < 4; ++ct) { y[ct] -= mean; vs += y[ct] * y[ct]; }
            const float rstd = 1.0f / sqrtf(row16_sum(vs) * (1.0f / 64.0f) + 64e-5f);
#pragma unroll
            for (int ct = 0; ct < 4; ++ct) ZB[(size_t)row * 1024 + h * 64 + 16 * ct + l15] = (unsigned short)f2bf((y[ct] * rstd * lnw[ct] + lnb[ct]) * gate[ct][jj]); } }
    __syncthreads();
}
struct ZcIn { v2u p0[4], p1[4], g[4]; };
__device__ __forceinline__ void zc_load(Frame& F, int row, ZcIn& I) {
    const GAS unsigned short* O0 = (const GAS unsigned short*)(F.ws + WS_OG) + (size_t)row * 1024 + 4 * F.lane; const GAS unsigned short* O1 = O0 + (size_t)MROWS * 1024;
    const GAS unsigned short* og = (const GAS unsigned short*)(F.ws + WS_PROJ) + (size_t)row * INP + C_OG + 4 * F.lane;
#pragma unroll
    for (int j = 0; j < 4; ++j) { I.p0[j] = *(const GAS v2u*)(O0 + 256 * j); I.p1[j] = *(const GAS v2u*)(O1 + 256 * j); I.g[j] = *(const GAS v2u*)(og + 256 * j); }
}
struct ZcPar { f32x4 n4[4]; };
__device__ __forceinline__ void zc_params(Frame& F, int l, ZcPar& P) { const GAS float* ng = (const GAS float*)kin<I_GLNG>() + l * 1024 + 4 * F.lane;
#pragma unroll
    for (int j = 0; j < 4; ++j) P.n4[j] = *(const GAS f32x4*)(ng + 256 * j); }
__device__ __forceinline__ void zc_finish(Frame& F, int l, int row, const ZcIn& I, const ZcPar& P) {
    GAS unsigned short* ZC = (GAS unsigned short*)(F.ws + WS_ZC) + (size_t)row * 1024 + 4 * F.lane;
#pragma unroll
    for (int j = 0; j < 4; ++j) { const v2u p0 = I.p0[j], p1 = I.p1[j], g = I.g[j]; const f32x4 n4 = P.n4[j];
        const float o0 = bflo(p0.x) + bflo(p1.x), o1 = bfhi(p0.x) + bfhi(p1.x), o2 = bflo(p0.y) + bflo(p1.y), o3 = bfhi(p0.y) + bfhi(p1.y);
        const float ss = wave_sum((o0 * o0 + o1 * o1) + (o2 * o2 + o3 * o3)); const float rs = 1.0f / sqrtf(ss * (1.0f / 256.0f) + 1e-6f);
        v2u o; o.x = pk2(o0 * rs * n4.x * siluf_(bflo(g.x)), o1 * rs * n4.y * siluf_(bfhi(g.x))); o.y = pk2(o2 * rs * n4.z * siluf_(bflo(g.y)), o3 * rs * n4.w * siluf_(bfhi(g.y)));
        *(GAS v2u*)(ZC + 256 * j) = o; }
}
__device__ __forceinline__ void zc_row(const Args& a, Frame& F, int l, int row) { ZcIn I; ZcPar P; zc_params(F, l, P); zc_load(F, row, I); zc_finish(F, l, row, I, P); }

#define LBAR() do { asm volatile("s_waitcnt lgkmcnt(0)" ::: "memory"); __builtin_amdgcn_s_barrier(); asm volatile("" ::: "memory"); } while (0)

constexpr int RC_A1 = 0, RC_R = 2048, RC_KD = 4096, RC_NB = 6144, RC_V = 8192, RC_A2 = 10240, RC_F = 10752, RC_NE = 11264, RC_GC = 11776, RC_BON = 12032, RC_BYTES = 12288;
constexpr int RW_NCH = (CTXL + SEQL) / 16;
constexpr int RW_NH = RW_NCH;
constexpr int CP_NAT = 72, CP_TR = 16, CP_TT = 20;
constexpr int CP_BYTES = 4 * 16 * CP_NAT * 2 + 3 * 64 * CP_TR * 2 + 16 * 16 * 4 + 16 * CP_TT * 2 + 2 * 64 * 4;
typedef unsigned short bf16x4u __attribute__((ext_vector_type(4)));
__device__ __forceinline__ GAS unsigned char* rec_addr(unsigned char* base0, long sstep, int o) { return (GAS unsigned char*)(base0 + (long)(o / 768) * sstep + (o % 768)); }
__device__ __forceinline__ bf16x8 frag_lo(v2u lo) { v4u t; t.x = lo.x; t.y = lo.y; t.z = 0u; t.w = 0u; return __builtin_bit_cast(bf16x8, t); }
__device__ __forceinline__ v2u cvt4(f32x4 v) { v2u r; r.x = pk2(v[0], v[1]); r.y = pk2(v[2], v[3]); return r; }
__device__ __forceinline__ bf16x8 frag2(f32x4 a0, f32x4 a1) { v4u t; t.x = pk2(a0[0], a0[1]); t.y = pk2(a0[2], a0[3]); t.z = pk2(a1[0], a1[1]); t.w = pk2(a1[2], a1[3]); return __builtin_bit_cast(bf16x8, t); }

__device__ __forceinline__ void rwkv_chunk_prep(Frame& F, int wu, unsigned char* scr) {
    const int chain = wu / RW_NCH, ci = wu % RW_NCH, d = chain >> 5, b = (chain >> 4) & 1, h = chain & 15;
    const int lane = F.lane, l15 = lane & 15, q = lane >> 4;
    const int row0 = seq_row(b, d, 16 * ci); const long sstep = d ? -12288 : 12288;
    unsigned char* base0 = F.ws + WS_PREP + (((size_t)d * MROWS + row0) * 16 + h) * 768;
    const float* BON = (const float*)(F.ws + WS_BONUS);
    unsigned short* nK = (unsigned short*)scr;
    unsigned short* nA = nK + 16 * CP_NAT; unsigned short* nk = nA + 16 * CP_NAT; unsigned short* nR = nk + 16 * CP_NAT;
    unsigned short* tK = nR + 16 * CP_NAT;
    unsigned short* tB = tK + 64 * CP_TR; unsigned short* tD = tB + 64 * CP_TR;
    float* Gl = (float*)(tD + 64 * CP_TR);
    unsigned short* Tl = (unsigned short*)(Gl + 256);
    float* eref = (float*)(Tl + 16 * CP_TT); float* gCv = eref + 64;
    float vr[16], vk[16], vw[16], vkk[16], vka[16];
    const int pl = (lane & 15) * 4 + (lane >> 4);
#pragma unroll
    for (int t = 0; t < 16; ++t) { const GAS unsigned short* p = (const GAS unsigned short*)(base0 + t * sstep) + pl;
        vr[t] = h2f(p[0]); vk[t] = h2f(p[64]); vw[t] = h2f(p[128]); vkk[t] = h2f(p[192]); vka[t] = h2f(p[256]); }
    v2u vfr[4];
#pragma unroll
    for (int vt = 0; vt < 4; ++vt) { float x[4];
#pragma unroll
        for (int jj = 0; jj < 4; ++jj) x[jj] = h2f(((const GAS unsigned short*)(base0 + (4 * q + jj) * sstep))[320 + 4 * l15 + vt]);
        vfr[vt].x = pk2(x[0], x[1]); vfr[vt].y = pk2(x[2], x[3]); }
    float bonv = 0.f; if (lane < 16) bonv = ((const GAS float*)BON)[((size_t)d * MROWS + (row0 + (d ? -lane : lane))) * 16 + h];
    asm volatile("s_waitcnt vmcnt(0)" ::: "memory");
    float lg[16]; { float run = 0.f;
#pragma unroll
        for (int t = 0; t < 16; ++t) { run += vw[t]; lg[t] = run; } }
    const float ref = lg[7], lgC = lg[15];
    eref[lane] = __expf(ref); gCv[lane] = __expf(lgC);
    { unsigned short a1[16], a2[16], a3[16];
#pragma unroll
      for (int t = 0; t < 16; ++t) { const float lm1 = t ? lg[t - 1] : 0.f;
          const float em = __expf(lm1 - ref), ep = __expf(ref - lg[t]), er = __expf(lg[t] - ref), gm = __expf(lm1), ec = __expf(lgC - lg[t]);
          nK[t * CP_NAT + lane] = (unsigned short)f2bf(vkk[t] * em); nA[t * CP_NAT + lane] = (unsigned short)f2bf(vka[t] * ep);
          nk[t * CP_NAT + lane] = (unsigned short)f2bf(vk[t] * ep); nR[t * CP_NAT + lane] = (unsigned short)f2bf(vr[t] * er);
          a1[t] = (unsigned short)f2bf(vkk[t] * gm); a2[t] = (unsigned short)f2bf(-(vka[t] * ec)); a3[t] = (unsigned short)f2bf(vk[t] * ec); }
#pragma unroll
      for (int g4 = 0; g4 < 4; ++g4) { v2u w1, w2, w3;
          w1.x = a1[4 * g4] | ((unsigned)a1[4 * g4 + 1] << 16); w1.y = a1[4 * g4 + 2] | ((unsigned)a1[4 * g4 + 3] << 16);
          w2.x = a2[4 * g4] | ((unsigned)a2[4 * g4 + 1] << 16); w2.y = a2[4 * g4 + 2] | ((unsigned)a2[4 * g4 + 3] << 16);
          w3.x = a3[4 * g4] | ((unsigned)a3[4 * g4 + 1] << 16); w3.y = a3[4 * g4 + 2] | ((unsigned)a3[4 * g4 + 3] << 16);
          *(v2u*)(tK + lane * CP_TR + 4 * g4) = w1; *(v2u*)(tB + lane * CP_TR + 4 * g4) = w2; *(v2u*)(tD + lane * CP_TR + 4 * g4) = w3; } }
    asm volatile("s_waitcnt lgkmcnt(0)" ::: "memory");
    f32x4 Gt = {0.f, 0.f, 0.f, 0.f}, Ht = Gt, ETt = Gt, FTt = Gt;
#pragma unroll
    for (int ks = 0; ks < 2; ++ks) { const int off = l15 * CP_NAT + ks * 32 + q * 8;
        const bf16x8 fK = *(const bf16x8*)(nK + off), fA = *(const bf16x8*)(nA + off), fk = *(const bf16x8*)(nk + off), fR = *(const bf16x8*)(nR + off);
        Gt = mfma16(fK, fA, Gt); Ht = mfma16(fK, fk, Ht); ETt = mfma16(fA, fR, ETt); FTt = mfma16(fk, fR, FTt); }
#pragma unroll
    for (int jj = 0; jj < 4; ++jj) { const int rowi = 4 * q + jj;
        if (!(l15 < rowi)) { Gt[jj] = 0.f; Ht[jj] = 0.f; }
        if (!(rowi <= l15)) { ETt[jj] = 0.f; FTt[jj] = 0.f; }
        Gl[rowi * 16 + l15] = Gt[jj]; }
    asm volatile("s_waitcnt lgkmcnt(0)" ::: "memory");
    { float Tc[16]; const int c = l15;
#pragma unroll
      for (int j = 0; j < 16; ++j) { float acc = (j == c) ? 1.f : 0.f; const f32x4* gr = (const f32x4*)(Gl + j * 16);
#pragma unroll
          for (int s4 = 0; s4 < 4; ++s4) { if (4 * s4 < j) { const f32x4 g = gr[s4];
#pragma unroll
              for (int e = 0; e < 4; ++e) if (4 * s4 + e < j) acc -= g[e] * Tc[4 * s4 + e]; } }
          Tc[j] = acc; if (q == 0) Tl[j * CP_TT + c] = (unsigned short)f2bf(acc); } }
    asm volatile("s_waitcnt lgkmcnt(0)" ::: "memory");
    const bf16x8 Tf = frag_lo(*(const v2u*)(Tl + l15 * CP_TT + 4 * q));
    f32x4 A1T[4];
#pragma unroll
    for (int kt = 0; kt < 4; ++kt) { const bf16x8 af = frag_lo(*(const v2u*)(tK + (16 * kt + l15) * CP_TR + 4 * q)); A1T[kt] = mfma16(af, Tf, (f32x4){0.f, 0.f, 0.f, 0.f}); }
    const f32x4 A2T = mfma16(frag_lo(cvt4(Ht)), Tf, (f32x4){0.f, 0.f, 0.f, 0.f});
    asm volatile("" ::: "memory");
#pragma unroll
    for (int ks = 0; ks < 2; ++ks) {
        *(GAS bf16x8*)rec_addr(base0, sstep, RC_A1 + ks * 1024 + lane * 16) = frag2(A1T[2 * ks], A1T[2 * ks + 1]);
        const v2u r0 = *(const v2u*)(nR + l15 * CP_NAT + 32 * ks + 4 * q), r1 = *(const v2u*)(nR + l15 * CP_NAT + 32 * ks + 16 + 4 * q);
        const f32x4 e0 = *(const f32x4*)(eref + 32 * ks + 4 * q), e1 = *(const f32x4*)(eref + 32 * ks + 16 + 4 * q);
        v4u o; o.x = pk2(bflo(r0.x) * e0.x, bfhi(r0.x) * e0.y); o.y = pk2(bflo(r0.y) * e0.z, bfhi(r0.y) * e0.w); o.z = pk2(bflo(r1.x) * e1.x, bfhi(r1.x) * e1.y); o.w = pk2(bflo(r1.y) * e1.z, bfhi(r1.y) * e1.w);
        *(GAS v4u*)rec_addr(base0, sstep, RC_R + ks * 1024 + lane * 16) = o; }
#pragma unroll
    for (int kt = 0; kt < 4; ++kt) {
        *(GAS v2u*)rec_addr(base0, sstep, RC_KD + kt * 512 + lane * 8) = *(const v2u*)(tD + (16 * kt + l15) * CP_TR + 4 * q);
        *(GAS v2u*)rec_addr(base0, sstep, RC_NB + kt * 512 + lane * 8) = *(const v2u*)(tB + (16 * kt + l15) * CP_TR + 4 * q);
        *(GAS v2u*)rec_addr(base0, sstep, RC_V + kt * 512 + lane * 8) = vfr[kt]; }
    *(GAS v2u*)rec_addr(base0, sstep, RC_A2 + lane * 8) = cvt4(A2T);
    *(GAS v2u*)rec_addr(base0, sstep, RC_F + lane * 8) = cvt4(FTt);
    { f32x4 ne = {-ETt[0], -ETt[1], -ETt[2], -ETt[3]}; *(GAS v2u*)rec_addr(base0, sstep, RC_NE + lane * 8) = cvt4(ne); }
    *(GAS float*)rec_addr(base0, sstep, RC_GC + lane * 4) = gCv[lane];
    if (lane < 16) *(GAS float*)rec_addr(base0, sstep, RC_BON + lane * 4) = bonv;
    asm volatile("s_waitcnt lgkmcnt(0)" ::: "memory");
}

template <int VAR> __device__ __forceinline__ void rwkv_scan2(Frame& F, int chain, const unsigned* cp2, unsigned cp2_need) {
    const int d = chain >> 5, b = (chain >> 4) & 1, h = chain & 15;
    unsigned char* ring = F.lds; LAS unsigned char* ringl = (LAS unsigned char*)F.lds;
    unsigned short* YB = (unsigned short*)(F.ws + WS_YB) + (size_t)d * MROWS * 1024;
    const unsigned char* prep = F.ws + WS_PREP;
    const int lane = F.lane, l15 = lane & 15, q = lane >> 4, w = F.wave;
    const bool compute = w < 4; const int lt = F.tid - 256;
    constexpr int NT = (VAR == 2) ? 2 : 1;
    f32x4 ST[NT][4];
#pragma unroll
    for (int i = 0; i < NT; ++i)
#pragma unroll
        for (int k = 0; k < 4; ++k) ST[i][k] = (f32x4){0.f, 0.f, 0.f, 0.f};
    v4u rg[8][3];
#define RW_LOAD(set, cidx) do { const int row0_ = seq_row(b, d, 16 * (cidx)); const long ss_ = d ? -12288 : 12288; const unsigned char* b0_ = prep + (((size_t)d * MROWS + row0_) * 16 + h) * 768; \
        _Pragma("unroll") for (int i_ = 0; i_ < 3; ++i_) { const int p_ = lt + 256 * i_; rg[set][i_] = *(const GAS v4u*)(b0_ + (long)(p_ / 48) * ss_ + (p_ % 48) * 16); } } while (0)
#define RW_STORE(set, slot) do { _Pragma("unroll") for (int i_ = 0; i_ < 3; ++i_) *(LAS v4u*)(ringl + (slot) * RC_BYTES + (lt + 256 * i_) * 16) = rg[set][i_]; } while (0)
    if (!compute) {
        RW_LOAD(0, 0); RW_LOAD(1, 1); RW_LOAD(2, 2); RW_LOAD(3, 3); RW_LOAD(4, 4); RW_LOAD(5, 5); RW_LOAD(6, 6); RW_LOAD(7, 7); RW_STORE(0, 0); RW_LOAD(0, 8);
        LBAR();
        for (int cb = 0; cb < RW_NCH; cb += 8) {
#pragma unroll
            for (int u = 0; u < 8; ++u) { const int ci = cb + u;
                if (RW_NH < RW_NCH && ci + 9 == RW_NH) {
                    unsigned spins = 0; while ((unsigned)__builtin_amdgcn_readfirstlane((int)__hip_atomic_load(cp2, __ATOMIC_RELAXED, __HIP_MEMORY_SCOPE_AGENT)) < cp2_need && ++spins < (1u << 22)) __builtin_amdgcn_s_sleep(8);
                    __builtin_amdgcn_fence(__ATOMIC_ACQUIRE, "agent"); }
                if (ci + 1 < RW_NCH) { RW_STORE((u + 1) & 7, (ci + 1) & 1); if (ci + 9 < RW_NCH) RW_LOAD((u + 1) & 7, ci + 9); }
                LBAR(); }
        }
    } else if (w >= 4 / NT) {
        LBAR();
        for (int ci = 0; ci < RW_NCH; ++ci) LBAR();
    } else {
        __builtin_amdgcn_s_setprio(3);
        LBAR();
        for (int ci = 0; ci < RW_NCH; ++ci) {
                const unsigned char* rc = ring + (ci & 1) * RC_BYTES;
                const bf16x8 a10 = *(const bf16x8*)(rc + RC_A1 + lane * 16), a11 = *(const bf16x8*)(rc + RC_A1 + 1024 + lane * 16);
                const bf16x8 rr0 = *(const bf16x8*)(rc + RC_R + lane * 16), rr1 = *(const bf16x8*)(rc + RC_R + 1024 + lane * 16);
                const bf16x8 a2 = frag_lo(*(const v2u*)(rc + RC_A2 + lane * 8)), ff = frag_lo(*(const v2u*)(rc + RC_F + lane * 8)), ne = frag_lo(*(const v2u*)(rc + RC_NE + lane * 8));
                v2u vraw[NT]; bf16x8 Vf[NT], SAb[NT]; f32x4 Y[NT];
#pragma unroll
                for (int i = 0; i < NT; ++i) { vraw[i] = *(const v2u*)(rc + RC_V + (NT * w + i) * 512 + lane * 8); Vf[i] = frag_lo(vraw[i]); }
#pragma unroll
                for (int i = 0; i < NT; ++i) { const bf16x8 Bs0 = frag2(ST[i][0], ST[i][1]), Bs1 = frag2(ST[i][2], ST[i][3]);
                    f32x4 SA = mfma16(a10, Bs0, (f32x4){0.f, 0.f, 0.f, 0.f}); SA = mfma16(a11, Bs1, SA); SA = mfma16(a2, Vf[i], SA);
                    f32x4 y = {0.f, 0.f, 0.f, 0.f}; if (VAR != 1) { y = mfma16(rr0, Bs0, y); y = mfma16(rr1, Bs1, y); y = mfma16(ff, Vf[i], y); }
                    SAb[i] = frag_lo(cvt4(SA));
                    if (VAR != 1) y = mfma16(ne, SAb[i], y);
                    Y[i] = y; }
#pragma unroll
                for (int kt = 0; kt < 4; ++kt) { const f32x4 gc = *(const f32x4*)(rc + RC_GC + (16 * kt + 4 * q) * 4);
                    const bf16x8 kd = frag_lo(*(const v2u*)(rc + RC_KD + kt * 512 + lane * 8)), nb = frag_lo(*(const v2u*)(rc + RC_NB + kt * 512 + lane * 8));
#pragma unroll
                    for (int i = 0; i < NT; ++i) { f32x4 acc = ST[i][kt] * gc; acc = mfma16(kd, Vf[i], acc); acc = mfma16(nb, SAb[i], acc); ST[i][kt] = acc; } }
                const f32x4 bon = *(const f32x4*)(rc + RC_BON + 4 * q * 4);
                const int rowb = seq_row(b, d, 16 * ci + 4 * q); const int rs = d ? -1 : 1;
#pragma unroll
                for (int i = 0; i < NT; ++i) { const float v0 = bflo(vraw[i].x), v1 = bfhi(vraw[i].x), v2 = bflo(vraw[i].y), v3 = bfhi(vraw[i].y);
                    GAS unsigned short* yp = (GAS unsigned short*)(YB + (size_t)rowb * 1024 + h * 64 + 16 * (NT * w + i) + l15);
                    if (VAR != 1) { yp[0] = (unsigned short)f2bf(Y[i][0] + bon.x * v0); yp[(long)rs * 1024] = (unsigned short)f2bf(Y[i][1] + bon.y * v1);
                        yp[(long)rs * 2048] = (unsigned short)f2bf(Y[i][2] + bon.z * v2); yp[(long)rs * 3072] = (unsigned short)f2bf(Y[i][3] + bon.w * v3); } }
                LBAR();
        }
    }
    __builtin_amdgcn_s_setprio(0);
    __syncthreads();
#undef RW_LOAD
#undef RW_STORE
}

constexpr int RX_WAVE = 2560, RX_OFF = 3 * RC_BYTES;
__device__ __forceinline__ void rwkv_scan3(Frame& F, int chain) {
    const int d = chain >> 5, b = (chain >> 4) & 1, h = chain & 15;
    unsigned char* ring = F.lds; LAS unsigned char* ringl = (LAS unsigned char*)F.lds;
    unsigned short* YB = (unsigned short*)(F.ws + WS_YB) + (size_t)d * MROWS * 1024;
    const unsigned char* prep = F.ws + WS_PREP;
    const int lane = F.lane, l15 = lane & 15, q = lane >> 4, w = F.wave, j = w & 3;
    const bool compute = w < 4; const int lt = F.tid - 256;
#define RW_LOAD(set, cidx) do { const int row0_ = seq_row(b, d, 16 * (cidx)); const long ss_ = d ? -12288 : 12288; const unsigned char* b0_ = prep + (((size_t)d * MROWS + row0_) * 16 + h) * 768; \
        _Pragma("unroll") for (int i_ = 0; i_ < 3; ++i_) { const int p_ = lt + 256 * i_; rg[set][i_] = *(const GAS v4u*)(b0_ + (long)(p_ / 48) * ss_ + (p_ % 48) * 16); } } while (0)
#define RW_STORE(set, slot) do { _Pragma("unroll") for (int i_ = 0; i_ < 3; ++i_) *(LAS v4u*)(ringl + (slot) * RC_BYTES + (lt + 256 * i_) * 16) = rg[set][i_]; } while (0)
#define RW_OUT(c, s3) do { const unsigned char* rc_ = ring + (s3) * RC_BYTES; const unsigned char* x_ = ring + RX_OFF + ((((c) & 1) * 4 + j) * RX_WAVE); \
        const bf16x8 Bs0_ = *(const bf16x8*)(x_ + lane * 16), Bs1_ = *(const bf16x8*)(x_ + 1024 + lane * 16), SAb_ = frag_lo(*(const v2u*)(x_ + 2048 + lane * 8)); \
        const bf16x8 rr0_ = *(const bf16x8*)(rc_ + RC_R + lane * 16), rr1_ = *(const bf16x8*)(rc_ + RC_R + 1024 + lane * 16); const v2u vraw_ = *(const v2u*)(rc_ + RC_V + j * 512 + lane * 8); \
        const bf16x8 Vf_ = frag_lo(vraw_), ff_ = frag_lo(*(const v2u*)(rc_ + RC_F + lane * 8)), ne_ = frag_lo(*(const v2u*)(rc_ + RC_NE + lane * 8)); const f32x4 bon_ = *(const f32x4*)(rc_ + RC_BON + 4 * q * 4); \
        f32x4 Y_ = mfma16(rr0_, Bs0_, (f32x4){0.f, 0.f, 0.f, 0.f}); Y_ = mfma16(rr1_, Bs1_, Y_); Y_ = mfma16(ff_, Vf_, Y_); Y_ = mfma16(ne_, SAb_, Y_); \
        const int rowb_ = seq_row(b, d, 16 * (c) + 4 * q); const int rs_ = d ? -1 : 1; GAS unsigned short* yp_ = (GAS unsigned short*)(YB + (size_t)rowb_ * 1024 + h * 64 + 16 * j + l15); \
        yp_[0] = (unsigned short)f2bf(Y_[0] + bon_.x * bflo(vraw_.x)); yp_[(long)rs_ * 1024] = (unsigned short)f2bf(Y_[1] + bon_.y * bfhi(vraw_.x)); \
        yp_[(long)rs_ * 2048] = (unsigned short)f2bf(Y_[2] + bon_.z * bflo(vraw_.y)); yp_[(long)rs_ * 3072] = (unsigned short)f2bf(Y_[3] + bon_.w * bfhi(vraw_.y)); } while (0)
    if (!compute) {
        v4u rg[8][3];
        RW_LOAD(0, 0); RW_LOAD(1, 1); RW_LOAD(2, 2); RW_LOAD(3, 3); RW_LOAD(4, 4); RW_LOAD(5, 5); RW_LOAD(6, 6); RW_LOAD(7, 7); RW_STORE(0, 0); RW_LOAD(0, 8);
        LBAR();
        int s1 = 1, sm = 2;
        for (int cb = 0; cb < RW_NCH; cb += 8) {
#pragma unroll
            for (int u = 0; u < 8; ++u) { const int ci = cb + u;
                if (ci + 1 < RW_NCH) { RW_STORE((u + 1) & 7, s1); if (ci + 9 < RW_NCH) RW_LOAD((u + 1) & 7, ci + 9); }
                if (ci >= 1) RW_OUT(ci - 1, sm);
                s1 = s1 == 2 ? 0 : s1 + 1; sm = sm == 2 ? 0 : sm + 1;
                LBAR(); }
        }
        RW_OUT(RW_NCH - 1, sm);
    } else {
        f32x4 ST[4];
#pragma unroll
        for (int i = 0; i < 4; ++i) ST[i] = (f32x4){0.f, 0.f, 0.f, 0.f};
        LBAR();
        int s0 = 0;
        for (int ci = 0; ci < RW_NCH; ++ci) {
            const unsigned char* rc = ring + s0 * RC_BYTES; unsigned char* x = ring + RX_OFF + (((ci & 1) * 4 + j) * RX_WAVE);
            const bf16x8 a10 = *(const bf16x8*)(rc + RC_A1 + lane * 16), a11 = *(const bf16x8*)(rc + RC_A1 + 1024 + lane * 16);
            const v2u vraw = *(const v2u*)(rc + RC_V + j * 512 + lane * 8);
            const bf16x8 Vf = frag_lo(vraw), a2 = frag_lo(*(const v2u*)(rc + RC_A2 + lane * 8));
            const bf16x8 Bs0 = frag2(ST[0], ST[1]), Bs1 = frag2(ST[2], ST[3]);
            *(bf16x8*)(x + lane * 16) = Bs0; *(bf16x8*)(x + 1024 + lane * 16) = Bs1;
            f32x4 SA = mfma16(a2, Vf, (f32x4){0.f, 0.f, 0.f, 0.f}); SA = mfma16(a10, Bs0, SA); SA = mfma16(a11, Bs1, SA);
            f32x4 nst[4];
#pragma unroll
            for (int kt = 0; kt < 4; ++kt) { const f32x4 gc = *(const f32x4*)(rc + RC_GC + (16 * kt + 4 * q) * 4);
                nst[kt] = mfma16(frag_lo(*(const v2u*)(rc + RC_KD + kt * 512 + lane * 8)), Vf, ST[kt] * gc); }
            const v2u sab = cvt4(SA); *(v2u*)(x + 2048 + lane * 8) = sab; const bf16x8 SAb = frag_lo(sab);
#pragma unroll
            for (int kt = 0; kt < 4; ++kt) ST[kt] = mfma16(frag_lo(*(const v2u*)(rc + RC_NB + kt * 512 + lane * 8)), SAb, nst[kt]);
            s0 = s0 == 2 ? 0 : s0 + 1;
            LBAR();
        }
    }
    __syncthreads();
#undef RW_LOAD
#undef RW_STORE
#undef RW_OUT
}

constexpr int GOP_P = 0, GOP_QB = 8192, GOP_KD = 24576, GOP_DEC = 40960, GOP_SZ = 41472;
struct GlaGk { float gup[16]; float gbias; int key; };
struct GlaPre { v4u lq[2], lk[2], lv[4], gk; };
__device__ __forceinline__ void gla_prep_load(Frame& F, int unit, GlaPre& P) {
    const int ch = unit % NSC, r1 = unit / NSC, h = r1 & 3, b = (r1 >> 2) & 1, d = r1 >> 3, tid = F.tid;
    const GAS unsigned short* PROJ = (const GAS unsigned short*)(F.ws + WS_PROJ);
#pragma unroll
    for (int i = 0; i < 2; ++i) { const int p = tid + 512 * i, c = p >> 4, pc = p & 15; const GAS unsigned short* src = PROJ + (size_t)gla_row(b, d, ch * 64 + c) * INP + h * 128 + pc * 8;
        P.lq[i] = *(const GAS v4u*)(src + C_Q); P.lk[i] = *(const GAS v4u*)(src + C_K); }
#pragma unroll
    for (int i = 0; i < 4; ++i) { const int p = tid + 512 * i, c = p >> 5, pc = p & 31; P.lv[i] = *(const GAS v4u*)(PROJ + (size_t)gla_row(b, d, ch * 64 + c) * INP + C_V + h * 256 + pc * 8); }
    P.gk = (v4u){0u, 0u, 0u, 0u}; if (tid < 128) { const int c = tid >> 1, hf = tid & 1; P.gk = *(const GAS v4u*)(PROJ + (size_t)gla_row(b, d, ch * 64 + c) * INP + C_GK + hf * 8); }
}
__device__ __forceinline__ void gla_prep_unit(const Args& a, Frame& F, int l, int unit, GlaGk& G, GlaPre& P, int next_unit) {
    const int ch = unit % NSC, r1 = unit / NSC, h = r1 & 3, b = (r1 >> 2) & 1, d = r1 >> 3;
    const unsigned short* PROJ = (const unsigned short*)(F.ws + WS_PROJ);
    unsigned char* gop = F.ws + WS_GLA + (size_t)unit * GOP_SZ;
    unsigned short* gvt = (unsigned short*)(F.ws + WS_MB) + (size_t)unit * (256 * 64);
    unsigned short* qx = (unsigned short*)F.lds;
    unsigned short* kx = qx + 64 * 136;
    unsigned short* qb = kx + 64 * 136;
    unsigned short* kdT = qb + 64 * 136;
    unsigned short* Pm = kdT + 128 * 72;
    unsigned short* vTL = Pm + 64 * 72;
    float* tot = (float*)(vTL + 256 * 72);
    float* la32 = tot + 512; float* decv = la32 + 128; float* gkl = decv + 128;
    int* rowi = (int*)(gkl + 1024);
    const int tid = F.tid, lane = F.lane, w = F.wave, l15 = lane & 15, quad = lane >> 4;
    const int dk = tid & 127, cg = tid >> 7;
    if (G.key != d * 4 + h) { G.key = d * 4 + h;
      const GAS float* gp = (const GAS float*)kin<I_GLGKUP>() + ((size_t)(l * 2 + d) * 16) * 512 + h * 128 + dk;
#pragma unroll
      for (int j = 0; j < 16; ++j) G.gup[j] = gp[(size_t)j * 512];
      G.gbias = ((const GAS float*)kin<I_GLGKB>())[(l * 2 + d) * 512 + h * 128 + dk]; }
    const float (&gup)[16] = G.gup; const float gbias = G.gbias;
    const float scale = 0.08838834764831845f;
    if (tid < 128) { const int c = tid >> 1, hf = tid & 1; const v4u z = P.gk; float* o = gkl + c * 16 + hf * 8;
        o[0] = bflo(z.x); o[1] = bfhi(z.x); o[2] = bflo(z.y); o[3] = bfhi(z.y); o[4] = bflo(z.z); o[5] = bfhi(z.z); o[6] = bflo(z.w); o[7] = bfhi(z.w); }
    {
#pragma unroll
      for (int i = 0; i < 2; ++i) { const int p = tid + 512 * i, c = p >> 4, pc = p & 15; *(v4u*)(qx + c * 136 + pc * 8) = P.lq[i]; *(v4u*)(kx + c * 136 + pc * 8) = P.lk[i]; }
#pragma unroll
    for (int i = 0; i < 4; ++i) { const int p = tid + 512 * i, c = p >> 5, pc = p & 31; const v4u z = P.lv[i];
        unsigned short* o = vTL + (pc * 8) * 72 + c;
        o[0] = (unsigned short)(z.x & 0xffff); o[72] = (unsigned short)(z.x >> 16); o[144] = (unsigned short)(z.y & 0xffff); o[216] = (unsigned short)(z.y >> 16);
        o[288] = (unsigned short)(z.z & 0xffff); o[360] = (unsigned short)(z.z >> 16); o[432] = (unsigned short)(z.w & 0xffff); o[504] = (unsigned short)(z.w >> 16); } }
    if (next_unit >= 0) gla_prep_load(F, next_unit, P);
    __syncthreads();
    float bl[16]; float run = 0.f;
#pragma unroll
    for (int eb = 0; eb < 16; eb += 2) { f32x4 g4[2][4];
#pragma unroll
        for (int ee = 0; ee < 2; ++ee)
#pragma unroll
            for (int j = 0; j < 4; ++j) g4[ee][j] = *(const LAS f32x4*)((const LAS float*)gkl + (cg * 16 + eb + ee) * 16 + 4 * j);
#pragma unroll
        for (int ee = 0; ee < 2; ++ee) { const int e = eb + ee; float x = gbias;
#pragma unroll
            for (int j = 0; j < 4; ++j) x += g4[ee][j].x * gup[4 * j] + g4[ee][j].y * gup[4 * j + 1] + g4[ee][j].z * gup[4 * j + 2] + g4[ee][j].w * gup[4 * j + 3];
            const float la = (fminf(x, 0.f) - __logf(1.0f + __expf(-fabsf(x)))) * (1.0f / 16.0f);
            if (e == 0 && cg == 2) la32[dk] = la;
            run += la; bl[e] = run; } }
    tot[cg * 128 + dk] = run;
    __syncthreads();
    { const float t0 = tot[dk], t1 = tot[128 + dk], t2 = tot[256 + dk], t3 = tot[384 + dk];
      const float off = cg == 0 ? 0.f : (cg == 1 ? t0 : (cg == 2 ? t0 + t1 : t0 + t1 + t2));
      const float bref = t0 + t1 + la32[dk], blast = (t0 + t1) + (t2 + t3);
      unsigned short kdv[16];
#pragma unroll
      for (int e = 0; e < 16; ++e) { const int c = cg * 16 + e; const float bb = off + bl[e];
          const float q = bf2f(qx[c * 136 + dk]) * scale, k = bf2f(kx[c * 136 + dk]);
          qx[c * 136 + dk] = (unsigned short)f2bf(q * __expf(bb - bref)); kx[c * 136 + dk] = (unsigned short)f2bf(k * __expf(bref - bb));
          qb[c * 136 + dk] = (unsigned short)f2bf(q * __expf(bb)); kdv[e] = (unsigned short)f2bf(k * __expf(blast - bb)); }
      v4u o0, o1; o0.x = kdv[0] | ((unsigned)kdv[1] << 16); o0.y = kdv[2] | ((unsigned)kdv[3] << 16); o0.z = kdv[4] | ((unsigned)kdv[5] << 16); o0.w = kdv[6] | ((unsigned)kdv[7] << 16);
      o1.x = kdv[8] | ((unsigned)kdv[9] << 16); o1.y = kdv[10] | ((unsigned)kdv[11] << 16); o1.z = kdv[12] | ((unsigned)kdv[13] << 16); o1.w = kdv[14] | ((unsigned)kdv[15] << 16);
      *(v4u*)(kdT + dk * 72 + cg * 16) = o0; *(v4u*)(kdT + dk * 72 + cg * 16 + 8) = o1;
      if (cg == 0) decv[dk] = __expf(blast); }
    __syncthreads();
#pragma unroll
    for (int tt = 0; tt < 2; ++tt) { const int t = 2 * w + tt, ti = t >> 2, tj = t & 3; f32x4 acc = {0.f, 0.f, 0.f, 0.f};
        if (tj <= ti) {
#pragma unroll
            for (int kb = 0; kb < 4; ++kb) { const bf16x8 af = *(const bf16x8*)(qx + (16 * ti + l15) * 136 + kb * 32 + quad * 8), bfr = *(const bf16x8*)(kx + (16 * tj + l15) * 136 + kb * 32 + quad * 8);
                acc = mfma16(af, bfr, acc); } }
        const int m = 16 * tj + l15;
#pragma unroll
        for (int jj = 0; jj < 4; ++jj) { const int c = 16 * ti + quad * 4 + jj; Pm[c * 72 + m] = (m <= c) ? (unsigned short)f2bf(acc[jj]) : (unsigned short)0; } }
    __syncthreads();
    { const int c = tid >> 3, pc = tid & 7; *(v4u*)(gop + GOP_P + (c * 64 + pc * 8) * 2) = *(const v4u*)(Pm + c * 72 + pc * 8); }
#pragma unroll
    for (int i = 0; i < 2; ++i) { const int p = tid + 512 * i; { const int c = p >> 4, pc = p & 15; *(v4u*)(gop + GOP_QB + (c * 128 + pc * 8) * 2) = *(const v4u*)(qb + c * 136 + pc * 8); }
        { const int r = p >> 3, pc = p & 7; *(v4u*)(gop + GOP_KD + (r * 64 + pc * 8) * 2) = *(const v4u*)(kdT + r * 72 + pc * 8); } }
#pragma unroll
    for (int i = 0; i < 4; ++i) { const int p = tid + 512 * i, r = p >> 3, pc = p & 7; *(v4u*)(gvt + r * 64 + pc * 8) = *(const v4u*)(vTL + r * 72 + pc * 8); }
    if (tid < 32) *(f32x4*)(gop + GOP_DEC + tid * 16) = *(const f32x4*)(decv + tid * 4);
    __syncthreads();
}

constexpr int GS_P = 0, GS_QB = 9216, GS_KD = 26624, GS_VT = 45056, GS_DEC = 49664, GS_SLOT = 50176, GS_ST = 2 * GS_SLOT;
__device__ __forceinline__ void gla_scan_unit(Frame& F, int unit) {
    const int dvs = unit & 7, h = (unit >> 3) & 3, b = (unit >> 5) & 1, d = unit >> 6;
    const unsigned char* gop0 = F.ws + WS_GLA + (size_t)(((d * 2 + b) * 4 + h) * NSC) * GOP_SZ;
    const unsigned short* gvt0 = (const unsigned short*)(F.ws + WS_MB) + (size_t)(((d * 2 + b) * 4 + h) * NSC) * (256 * 64) + dvs * 32 * 64;
    unsigned short* OGp = (unsigned short*)(F.ws + WS_OG) + (size_t)d * MROWS * 1024 + h * 256 + dvs * 32;
    unsigned char* L = F.lds; unsigned short* ST16 = (unsigned short*)(L + GS_ST);
    const int tid = F.tid, lane = F.lane, w = F.wave, l15 = lane & 15, quad = lane >> 4;
    v4u rg[4][6];
#define GS_LOAD(set, chn) do { const unsigned char* g_ = gop0 + (size_t)(chn) * GOP_SZ; \
        rg[set][0] = *(const GAS v4u*)(g_ + GOP_P + tid * 16); rg[set][1] = *(const GAS v4u*)(g_ + GOP_QB + tid * 16); rg[set][2] = *(const GAS v4u*)(g_ + GOP_QB + (tid + 512) * 16); \
        rg[set][3] = *(const GAS v4u*)(g_ + GOP_KD + tid * 16); rg[set][4] = *(const GAS v4u*)(g_ + GOP_KD + (tid + 512) * 16); \
        if (tid < 256) rg[set][5] = *(const GAS v4u*)(gvt0 + (size_t)(chn) * (256 * 64) + tid * 8); else if (tid < 288) rg[set][5] = *(const GAS v4u*)(g_ + GOP_DEC + (tid - 256) * 16); } while (0)
#define GS_STORE(set, slot) do { unsigned char* s_ = L + (slot) * GS_SLOT; \
        *(v4u*)(s_ + GS_P + ((tid >> 3) * 72 + (tid & 7) * 8) * 2) = rg[set][0]; \
        *(v4u*)(s_ + GS_QB + ((tid >> 4) * 136 + (tid & 15) * 8) * 2) = rg[set][1]; *(v4u*)(s_ + GS_QB + (((tid + 512) >> 4) * 136 + (tid & 15) * 8) * 2) = rg[set][2]; \
        *(v4u*)(s_ + GS_KD + ((tid >> 3) * 72 + (tid & 7) * 8) * 2) = rg[set][3]; *(v4u*)(s_ + GS_KD + (((tid + 512) >> 3) * 72 + (tid & 7) * 8) * 2) = rg[set][4]; \
        if (tid < 256) *(v4u*)(s_ + GS_VT + ((tid >> 3) * 72 + (tid & 7) * 8) * 2) = rg[set][5]; else if (tid < 288) *(v4u*)(s_ + GS_DEC + (tid - 256) * 16) = rg[set][5]; } while (0)
    for (int i = tid; i < 32 * 136 / 2; i += 512) ((unsigned*)ST16)[i] = 0u;
    f32x4 sacc[2];
    sacc[0] = (f32x4){0.f, 0.f, 0.f, 0.f}; sacc[1] = sacc[0];
    GS_LOAD(0, 0); GS_STORE(0, 0); GS_LOAD(1, 1); GS_LOAD(2, 2); GS_LOAD(3, 3);
    LBAR();
    for (int cb = 0; cb < NSC; cb += 4) {
#pragma unroll
        for (int u = 0; u < 4; ++u) { const int ch = cb + u;
            if (ch + 4 < NSC) GS_LOAD(u, ch + 4);
            const unsigned char* S = L + (u & 1) * GS_SLOT; const unsigned short* STc = ST16 + (u & 1) * (32 * 136); unsigned short* STn = ST16 + ((u + 1) & 1) * (32 * 136);
            const unsigned short* Pm = (const unsigned short*)(S + GS_P); const unsigned short* qb = (const unsigned short*)(S + GS_QB);
            const unsigned short* kdT = (const unsigned short*)(S + GS_KD); const unsigned short* vT = (const unsigned short*)(S + GS_VT); const float* decv = (const float*)(S + GS_DEC);
            { const int tdv = w >> 2, tc = w & 3; f32x4 acc = {0.f, 0.f, 0.f, 0.f};
#pragma unroll
              for (int kb = 0; kb < 2; ++kb) { const bf16x8 af = *(const bf16x8*)(vT + (16 * tdv + l15) * 72 + kb * 32 + quad * 8), bfr = *(const bf16x8*)(Pm + (16 * tc + l15) * 72 + kb * 32 + quad * 8); acc = mfma16(af, bfr, acc); }
#pragma unroll
              for (int kb = 0; kb < 4; ++kb) { const bf16x8 af = *(const bf16x8*)(STc + (16 * tdv + l15) * 136 + kb * 32 + quad * 8), bfr = *(const bf16x8*)(qb + (16 * tc + l15) * 136 + kb * 32 + quad * 8); acc = mfma16(af, bfr, acc); }
              const int c = 16 * tc + l15; const int row = gla_row(b, d, ch * 64 + c);
              v2u o; o.x = pk2(acc[0], acc[1]); o.y = pk2(acc[2], acc[3]);
              *(GAS v2u*)(OGp + (size_t)row * 1024 + 16 * tdv + quad * 4) = o; }
            { const float dec = decv[16 * w + l15];
#pragma unroll
              for (int tdv = 0; tdv < 2; ++tdv) { f32x4 acc = sacc[tdv] * dec;
#pragma unroll
                  for (int kb = 0; kb < 2; ++kb) { const bf16x8 af = *(const bf16x8*)(vT + (16 * tdv + l15) * 72 + kb * 32 + quad * 8), bfr = *(const bf16x8*)(kdT + (16 * w + l15) * 72 + kb * 32 + quad * 8); acc = mfma16(af, bfr, acc); }
                  sacc[tdv] = acc;
#pragma unroll
                  for (int jj = 0; jj < 4; ++jj) STn[(16 * tdv + quad * 4 + jj) * 136 + 16 * w + l15] = (unsigned short)f2bf(acc[jj]); } }
            if (ch + 1 < NSC) GS_STORE((u + 1) & 3, (u + 1) & 1);
            LBAR();
        }
    }
    __syncthreads();
#undef GS_LOAD
#undef GS_STORE
}

constexpr int S5_KK = 0, S5_UT = 32768, S5_UPITCH = 2064, S5_HE = S5_UT + 16 * S5_UPITCH, S5_HI = S5_HE + 8192, S5_HPITCH = 136, S5_PARK = 81920;
struct Cx { float x, y; };
__device__ __forceinline__ Cx cmul(Cx a, Cx b) { Cx r; r.x = a.x * b.x - a.y * b.y; r.y = a.x * b.y + a.y * b.x; return r; }
__device__ __forceinline__ Cx cpow_lam(float xr, float xi, float n) { const float m = __expf(n * xr); const float s = __sinf(n * xi), c = __cosf(n * xi); Cx r; r.x = m * c; r.y = m * s; return r; }
__device__ __forceinline__ Cx s5_coef(float lre, float lim, float dt) {
    const float em1 = __expf(lre * dt) - 1.0f, th = lim * dt, sh = __sinf(0.5f * th), cm1 = -2.0f * sh * sh, sn = __sinf(th);
    const float nr = em1 * (1.0f + cm1) + cm1, ni = (1.0f + em1) * sn, den = lre * lre + lim * lim;
    Cx r; r.x = (nr * lre + ni * lim) / den; r.y = (ni * lre - nr * lim) / den; return r;
}
template <int VAR> __device__ __forceinline__ void s5_unit(Frame& F, int l, int unit) {
    const int g = unit & 63, b = (unit >> 6) & 1, d = unit >> 7, gi = (l * 2 + d) * 64 + g;
    const unsigned short* PROJ = (const unsigned short*)(F.ws + WS_PROJ);
    unsigned short* YS = (unsigned short*)(F.ws + (d ? WS_ZC : WS_YS0));
    unsigned char* L = F.lds;
    unsigned short* KK = (unsigned short*)(L + S5_KK); float* HE = (float*)(L + S5_HE); unsigned short* HI = (unsigned short*)(L + S5_HI);
    const int tid = F.tid, lane = F.lane, w = F.wave, l15 = lane & 15, q = lane >> 4;
    const float* are = kin<I_S5ARE>() + gi * 64; const float* aim = kin<I_S5AIM>() + gi * 64; const float dt = expf(kin<I_S5LDT>()[gi]);
    Cx l8[16], cpw[16];
    const float* cre = kin<I_S5CRE>() + ((size_t)gi * 16 + l15) * 64; const float* cim = kin<I_S5CIM>() + ((size_t)gi * 16 + l15) * 64;
#define S5_INIT(n0) do { _Pragma("unroll") for (int k_ = 0; k_ < 16; ++k_) { const int p_ = 32 * (k_ >> 3) + 8 * q + (k_ & 7); Cx c_; c_.x = cre[p_]; c_.y = cim[p_]; \
        const float xr_ = fminf(are[p_], -1e-4f) * dt, xi_ = aim[p_] * dt; cpw[k_] = cmul(c_, cpow_lam(xr_, xi_, (float)(n0))); } } while (0)
#define S5_L8() do { _Pragma("unroll") for (int k_ = 0; k_ < 16; ++k_) { const int p_ = 32 * (k_ >> 3) + 8 * q + (k_ & 7); l8[k_] = cpow_lam(fminf(are[p_], -1e-4f) * dt, aim[p_] * dt, 8.f); } } while (0)
    S5_L8(); S5_INIT(w);
    v4u Bm[4];
    { const float* bre = kin<I_S5BRE>() + (size_t)gi * 64 * 16; const float* bim = kin<I_S5BIM>() + (size_t)gi * 64 * 16; float vr[16], vi[16];
#pragma unroll
      for (int k = 0; k < 16; ++k) { const int p = 32 * (k >> 3) + 8 * q + (k & 7); const float lre = fminf(are[p], -1e-4f), lim = aim[p];
          const Cx cf_ = s5_coef(lre, lim, dt); const float cr = cf_.x, ci = cf_.y; const float br = bre[p * 16 + l15], bi = bim[p * 16 + l15];
          vr[k] = cr * br - ci * bi; vi[k] = cr * bi + ci * br; }
      Bm[0] = (v4u){pk2(vr[0], vr[1]), pk2(vr[2], vr[3]), pk2(vr[4], vr[5]), pk2(vr[6], vr[7])}; Bm[1] = (v4u){pk2(vr[8], vr[9]), pk2(vr[10], vr[11]), pk2(vr[12], vr[13]), pk2(vr[14], vr[15])};
      Bm[2] = (v4u){pk2(vi[0], vi[1]), pk2(vi[2], vi[3]), pk2(vi[4], vi[5]), pk2(vi[6], vi[7])}; Bm[3] = (v4u){pk2(vi[8], vi[9]), pk2(vi[10], vi[11]), pk2(vi[12], vi[13]), pk2(vi[14], vi[15])}; }
#define S5_CF(cf) do { \
        cf[0] = (v4u){pk2(cpw[0].x, cpw[1].x), pk2(cpw[2].x, cpw[3].x), pk2(cpw[4].x, cpw[5].x), pk2(cpw[6].x, cpw[7].x)}; cf[1] = (v4u){pk2(cpw[8].x, cpw[9].x), pk2(cpw[10].x, cpw[11].x), pk2(cpw[12].x, cpw[13].x), pk2(cpw[14].x, cpw[15].x)}; \
        cf[2] = (v4u){pk2(-cpw[0].y, -cpw[1].y), pk2(-cpw[2].y, -cpw[3].y), pk2(-cpw[4].y, -cpw[5].y), pk2(-cpw[6].y, -cpw[7].y)}; cf[3] = (v4u){pk2(-cpw[8].y, -cpw[9].y), pk2(-cpw[10].y, -cpw[11].y), pk2(-cpw[12].y, -cpw[13].y), pk2(-cpw[14].y, -cpw[15].y)}; } while (0)
#define S5_STEP8() do { _Pragma("unroll") for (int k_ = 0; k_ < 16; ++k_) cpw[k_] = cmul(cpw[k_], l8[k_]); } while (0)
#pragma unroll 1
    for (int k = 0; k < 8; ++k) { const int n = w + 8 * k; v4u cf[4]; S5_CF(cf);
        f32x4 acc = {0.f, 0.f, 0.f, 0.f};
#pragma unroll
        for (int ks = 0; ks < 4; ++ks) acc = mfma16b(cf[ks], Bm[ks], acc);
#pragma unroll
        for (int jj = 0; jj < 4; ++jj) KK[(n * 16 + 4 * q + jj) * 16 + l15] = (unsigned short)f2bf(acc[jj]);
        S5_STEP8(); }
    const int p2 = (16 * w + l15) & 63; const bool isim = w >= 4; const int j0 = 8 * (q & 1);
    Cx cur; cur.x = 0.f; cur.y = 0.f;
    LAS float* PS = (LAS float*)((LAS unsigned char*)L + S5_PARK) + tid;
    { Cx bb[8], lam2, pst, l64;
    { const float lre = fminf(are[p2], -1e-4f), lim = aim[p2]; const Cx cf_ = s5_coef(lre, lim, dt); const float cr = cf_.x, ci = cf_.y;
      const float* bre = kin<I_S5BRE>() + ((size_t)gi * 64 + p2) * 16 + j0; const float* bim = kin<I_S5BIM>() + ((size_t)gi * 64 + p2) * 16 + j0;
#pragma unroll
      for (int e = 0; e < 8; ++e) { bb[e].x = cr * bre[e] - ci * bim[e]; bb[e].y = cr * bim[e] + ci * bre[e]; }
      lam2 = cpow_lam(lre * dt, lim * dt, 2.f); pst = cpow_lam(lre * dt, lim * dt, (float)(1 - (q >> 1)));
      const int p3 = lane; const float lre3 = fminf(are[p3], -1e-4f) * dt, lim3 = aim[p3] * dt; l64 = cpow_lam(lre3, lim3, 64.f); }
#pragma unroll
    for (int e = 0; e < 8; ++e) { PS[(2 * e) * 512] = bb[e].x; PS[(2 * e + 1) * 512] = bb[e].y; }
    PS[16 * 512] = lam2.x; PS[17 * 512] = lam2.y; PS[18 * 512] = pst.x; PS[19 * 512] = pst.y; PS[20 * 512] = l64.x; PS[21 * 512] = l64.y; }
    v4u z4[4];
#define S5_ULOAD(mt_) do { _Pragma("unroll") for (int i_ = 0; i_ < 4; ++i_) { const int pc_ = tid + 512 * i_, mm_ = pc_ >> 7, s_ = (pc_ & 127) >> 1, hf_ = pc_ & 1, ch_ = 16 * (mt_) + mm_; \
        z4[i_] = (v4u){0u, 0u, 0u, 0u}; if (ch_ < NSC) z4[i_] = *(const GAS v4u*)((const GAS unsigned short*)PROJ + (size_t)seq_row(b, d, ch_ * 64 + s_) * INP + C_S5 + g * 16 + 8 * hf_); } } while (0)
    S5_ULOAD(0);
    __syncthreads();
#pragma unroll 1
    for (int mt = 0; mt < 5; ++mt) {
        {
#pragma unroll
          for (int i = 0; i < 4; ++i) { const int pc = tid + 512 * i, mm = pc >> 7, s = (pc & 127) >> 1, hf = pc & 1;
              *(LAS v4u*)((LAS unsigned char*)L + S5_UT + mm * S5_UPITCH + (s * 16 + 8 * hf) * 2) = z4[i]; } }
        __syncthreads();
        { f32x4 acc = {0.f, 0.f, 0.f, 0.f}; Cx bb[8], lam2, pp;
#pragma unroll
          for (int e = 0; e < 8; ++e) { bb[e].x = PS[(2 * e) * 512]; bb[e].y = PS[(2 * e + 1) * 512]; }
          lam2.x = PS[16 * 512]; lam2.y = PS[17 * 512]; pp.x = PS[18 * 512]; pp.y = PS[19 * 512];
#pragma unroll 4
          for (int ks = (VAR == 2 ? -1 : 31); ks >= 0; --ks) { float v[8];
#pragma unroll
              for (int e = 0; e < 8; ++e) v[e] = isim ? (pp.x * bb[e].y + pp.y * bb[e].x) : (pp.x * bb[e].x - pp.y * bb[e].y);
              const v4u bf = (v4u){pk2(v[0], v[1]), pk2(v[2], v[3]), pk2(v[4], v[5]), pk2(v[6], v[7])};
              const v4u af = *(const v4u*)(L + S5_UT + l15 * S5_UPITCH + (ks * 32 + 8 * q) * 2);
              acc = mfma16b(af, bf, acc); pp = cmul(pp, lam2); }
#pragma unroll
          for (int jj = 0; jj < 4; ++jj) HE[(4 * q + jj) * 128 + 16 * w + l15] = acc[jj]; }
        __syncthreads();
        if (w == 0) { Cx l64; l64.x = PS[20 * 512]; l64.y = PS[21 * 512];
#pragma unroll 4
            for (int mm = 0; mm < 16; ++mm) { HI[mm * S5_HPITCH + lane] = (unsigned short)f2bf(cur.x); HI[mm * S5_HPITCH + 64 + lane] = (unsigned short)f2bf(cur.y);
                Cx he; he.x = HE[mm * 128 + lane]; he.y = HE[mm * 128 + 64 + lane]; const Cx t = cmul(l64, cur); cur.x = t.x + he.x; cur.y = t.y + he.y; } }
        __syncthreads();
        { v4u hf4[4]; f32x4 acc[8];
#pragma unroll
          for (int ks = 0; ks < 4; ++ks) hf4[ks] = *(const v4u*)(HI + l15 * S5_HPITCH + 32 * ks + 8 * q);
          S5_INIT(w + 1);
#pragma unroll
          for (int k = 0; k < 8; ++k) { v4u cf[4]; S5_CF(cf); f32x4 a_ = {0.f, 0.f, 0.f, 0.f};
#pragma unroll
              for (int ks = 0; ks < 4; ++ks) a_ = mfma16b(hf4[ks], cf[ks], a_);
              acc[k] = a_; S5_STEP8(); }
          const LAS unsigned char* ua = (const LAS unsigned char*)L + S5_UT + l15 * S5_UPITCH + 16 * q; const LAS unsigned short* kq = (const LAS unsigned short*)KK + l15 * 16 + 8 * (q & 1);
          if (VAR != 1) {
#pragma unroll 1
          for (int r = 0; r < 4; ++r) { v4u kfw[8];
#pragma unroll
              for (int dl = 0; dl < 8; ++dl) { const int lag = w - 2 * r + 8 * dl - (q >> 1); kfw[dl] = (v4u){0u, 0u, 0u, 0u}; if (lag >= 0) kfw[dl] = *(const LAS v4u*)(kq + lag * 256); }
#pragma unroll
              for (int m = 0; m < 8; ++m) { const v4u af = *(const LAS v4u*)(ua + (r + 4 * m) * 64);
#pragma unroll
                  for (int k = m; k < 8; ++k) acc[k] = mfma16b(af, kfw[k - m], acc[k]); } } }
          if (mt + 1 < 5) S5_ULOAD(mt + 1);
#pragma unroll
          for (int k = 0; k < 8; ++k) { const int t = w + 8 * k;
#pragma unroll
              for (int jj = 0; jj < 4; ++jj) { const int ch = 16 * mt + 4 * q + jj; if (ch < NSC) ((GAS unsigned short*)YS)[(size_t)seq_row(b, d, ch * 64 + t) * 1024 + g * 16 + l15] = (unsigned short)f2bf(acc[k][jj]); } } }
        __syncthreads();
    }
#undef S5_CF
#undef S5_INIT
#undef S5_L8
#undef S5_STEP8
#undef S5_ULOAD
}
struct ZaIn { v2u a[4], bq[4], u[4]; };
__device__ __forceinline__ void za_load(Frame& F, int row, ZaIn& I) {
    const GAS unsigned short* y0 = (const GAS unsigned short*)(F.ws + WS_YS0) + (size_t)row * 1024 + 16 * F.lane; const GAS unsigned short* y1 = (const GAS unsigned short*)(F.ws + WS_ZC) + (size_t)row * 1024 + 16 * F.lane;
    const GAS unsigned short* up = (const GAS unsigned short*)(F.ws + WS_PROJ) + (size_t)row * INP + C_S5 + 16 * F.lane;
#pragma unroll
    for (int j = 0; j < 4; ++j) { I.a[j] = *(const GAS v2u*)(y0 + 4 * j); I.bq[j] = *(const GAS v2u*)(y1 + 4 * j); I.u[j] = *(const GAS v2u*)(up + 4 * j); }
}
struct ZaPar { f32x4 dv[4]; };
__device__ __forceinline__ void za_params(Frame& F, int l, ZaPar& P) { const GAS float* dp = (const GAS float*)kin<I_S5D>() + l * 1024 + 16 * F.lane;
#pragma unroll
    for (int j = 0; j < 4; ++j) P.dv[j] = *(const GAS f32x4*)(dp + 4 * j); }
__device__ __forceinline__ void za_finish(Frame& F, int l, int row, const ZaIn& I, const ZaPar& P) {
    GAS unsigned short* za = (GAS unsigned short*)(F.ws + WS_ZA) + (size_t)row * 1024 + 16 * F.lane;
#pragma unroll
    for (int j = 0; j < 4; ++j) { const f32x4 dv = P.dv[j];
        v2u o; o.x = pk2(gelu_tanh(bflo(I.a[j].x) + bflo(I.bq[j].x) + dv.x * bflo(I.u[j].x)), gelu_tanh(bfhi(I.a[j].x) + bfhi(I.bq[j].x) + dv.y * bfhi(I.u[j].x)));
        o.y = pk2(gelu_tanh(bflo(I.a[j].y) + bflo(I.bq[j].y) + dv.z * bflo(I.u[j].y)), gelu_tanh(bfhi(I.a[j].y) + bfhi(I.bq[j].y) + dv.w * bfhi(I.u[j].y)));
        *(GAS v2u*)(za + 4 * j) = o; }
}
__device__ __forceinline__ void za_row(Frame& F, int l, int row) { ZaIn I; ZaPar P; za_params(F, l, P); za_load(F, row, I); za_finish(F, l, row, I, P); }

template <int NCOLT> struct EpiStoreBf16 {
    static constexpr bool PERM = true, AFTER_DRAIN = false;
    unsigned short* O; int ldc;
    __device__ __forceinline__ void operator()(const pg8::f32x4 (&acc)[2][2][4][2], const pg8::Unit& u, int wr, int wc, int fr, int fq) const {
        const int row0 = u.pm * 256 + wr * 64 + fr, col0 = (NCOLT ? (u.pn % NCOLT) : u.pn) * 256 + wc * 32 + 8 * fq;
#pragma unroll
        for (int ai = 0; ai < 2; ++ai)
#pragma unroll
            for (int m = 0; m < 4; ++m) { unsigned short* rowp = O + (size_t)(row0 + ai * 128 + m * 16) * ldc + col0;
#pragma unroll
                for (int bj = 0; bj < 2; ++bj) { const pg8::f32x4 v0 = acc[ai][bj][m][0], v1 = acc[ai][bj][m][1];
                    v4u w; w.x = pg8::cvt_pk_bf16(v0[0], v0[1]); w.y = pg8::cvt_pk_bf16(v0[2], v0[3]); w.z = pg8::cvt_pk_bf16(v1[0], v1[1]); w.w = pg8::cvt_pk_bf16(v1[2], v1[3]);
                    *(v4u*)(rowp + bj * 128) = w; } }
    }
};
__device__ __forceinline__ f32x4 sig4_bf(const unsigned short* p) { const v2u g = *(const v2u*)p; f32x4 r; r.x = sigmoidf_(bflo(g.x)); r.y = sigmoidf_(bfhi(g.x)); r.z = sigmoidf_(bflo(g.y)); r.w = sigmoidf_(bfhi(g.y)); return r; }
__device__ __forceinline__ void epi_glu_body(const pg8::f32x4 (&acc)[2][2][4][2], float* __restrict__ MF, const unsigned short* __restrict__ PROJ, int row0, int oc0) {
#pragma unroll
    for (int ai = 0; ai < 2; ++ai)
#pragma unroll
        for (int m = 0; m < 4; ++m) { const int r = row0 + ai * 128 + m * 16;
#pragma unroll
            for (int n = 0; n < 2; ++n) { const int oc = oc0 + 16 * n; const f32x4 ga = sig4_bf(PROJ + (size_t)r * INP + C_GA + oc);
                const pg8::f32x4 val = acc[ai][0][m][n], gt = acc[ai][1][m][n]; f32x4 o;
                o.x = ga.x * val[0] * sigmoidf_(gt[0]); o.y = ga.y * val[1] * sigmoidf_(gt[1]); o.z = ga.z * val[2] * sigmoidf_(gt[2]); o.w = ga.w * val[3] * sigmoidf_(gt[3]);
                *(f32x4*)(MF + (size_t)r * DM + oc) = o; } }
}
struct EpiGlu {
    static constexpr bool PERM = false, AFTER_DRAIN = false;
    float* MF; const unsigned short* PROJ;
    __device__ __forceinline__ void operator()(const pg8::f32x4 (&acc)[2][2][4][2], const pg8::Unit& u, int wr, int wc, int fr, int fq) const {
        epi_glu_body(acc, MF, PROJ, u.pm * 256 + wr * 64 + fr, u.pn * 128 + wc * 32 + 4 * fq);
    }
};
template <int MODE> __device__ __forceinline__ void epi_acc_body(const pg8::f32x4 (&acc)[2][2][4][2], float* __restrict__ MF, unsigned short* __restrict__ MB, const unsigned short* __restrict__ PROJ, int gcol, const float* __restrict__ modg, int row0, int c0, const float* __restrict__ xs = nullptr) {
#pragma unroll
    for (int ai = 0; ai < 2; ++ai)
#pragma unroll
        for (int m = 0; m < 4; ++m) { const int r = row0 + ai * 128 + m * 16; f32x4 g[4], o[4];
#pragma unroll
            for (int i = 0; i < 4; ++i) { const int c = c0 + (i >> 1) * 128 + (i & 1) * 16;
                if (MODE >= 2) g[i] = *(const f32x4*)(modg + (size_t)row_modidx(r) * 12288 + c); else g[i] = sig4_bf(PROJ + (size_t)r * INP + gcol + c);
                if (MODE == 3) o[i] = *(const f32x4*)(xs + (size_t)r * DM + c); else o[i] = *(const f32x4*)(MF + (size_t)r * DM + c); }
#pragma unroll
            for (int i = 0; i < 4; ++i) { const int c = c0 + (i >> 1) * 128 + (i & 1) * 16; const pg8::f32x4 v = acc[ai][i >> 1][m][i & 1];
                o[i].x += g[i].x * v[0]; o[i].y += g[i].y * v[1]; o[i].z += g[i].z * v[2]; o[i].w += g[i].w * v[3];
                if (MODE == 1) { v2u w; w.x = pk2(o[i].x, o[i].y); w.y = pk2(o[i].z, o[i].w); *(v2u*)(MB + (size_t)r * DM + c) = w; } else *(f32x4*)(MF + (size_t)r * DM + c) = o[i]; } }
}
template <int MODE> struct EpiAcc {
    static constexpr bool PERM = false, AFTER_DRAIN = false;
    float* MF; unsigned short* MB; const unsigned short* PROJ; int gcol; const float* modg;
    __device__ __forceinline__ void operator()(const pg8::f32x4 (&acc)[2][2][4][2], const pg8::Unit& u, int wr, int wc, int fr, int fq) const {
        epi_acc_body<MODE>(acc, MF, MB, PROJ, gcol, modg, u.pm * 256 + wr * 64 + fr, u.pn * 256 + wc * 32 + 4 * fq);
    }
};
struct EpiAccX0 {
    static constexpr bool PERM = false, AFTER_DRAIN = false;
    float* X; const float* xlat; const float* xctx; const float* modg;
    __device__ __forceinline__ void operator()(const pg8::f32x4 (&acc)[2][2][4][2], const pg8::Unit& u, int wr, int wc, int fr, int fq) const {
        const float* xs = u.pm < MLAT / 256 ? xlat : xctx - (size_t)MLAT * DM;
        epi_acc_body<3>(acc, X, nullptr, nullptr, 0, modg, u.pm * 256 + wr * 64 + fr, u.pn * 256 + wc * 32 + 4 * fq, xs);
    }
};
struct EpiMoe1 {
    static constexpr bool PERM = false, AFTER_DRAIN = false;
    unsigned short* HID;
    __device__ __forceinline__ void operator()(const pg8::f32x4 (&acc)[2][2][4][2], const pg8::Unit& u, int wr, int wc, int fr, int fq) const {
        const int row0 = u.pm * 256 + wr * 64 + fr, hc0 = (u.pn & 1) * 128 + wc * 32 + 4 * fq;
#pragma unroll
        for (int ai = 0; ai < 2; ++ai)
#pragma unroll
            for (int m = 0; m < 4; ++m) { const int r = row0 + ai * 128 + m * 16;
#pragma unroll
                for (int n = 0; n < 2; ++n) { const pg8::f32x4 gt = acc[ai][0][m][n], up = acc[ai][1][m][n];
                    v2u w; w.x = pk2(siluf_(gt[0]) * up[0], siluf_(gt[1]) * up[1]); w.y = pk2(siluf_(gt[2]) * up[2], siluf_(gt[3]) * up[3]);
                    *(v2u*)(HID + (size_t)r * 256 + hc0 + 16 * n) = w; } }
    }
};

__device__ __forceinline__ void st_wt16(__amdgpu_buffer_rsrc_t rs, int off, f32x4 v) { __builtin_amdgcn_raw_buffer_store_b128(__builtin_bit_cast(v4u, v), rs, off, 0, 16); }
__device__ __forceinline__ void mrg_wait(unsigned* cnt, unsigned need, unsigned* tmo) {
    unsigned spins = 0;
    while ((unsigned)__builtin_amdgcn_readfirstlane((int)__hip_atomic_load((gu32*)cnt, RLX_AGENT)) < need) { __builtin_amdgcn_s_sleep(2);
        if (++spins > (1u << 20)) { __hip_atomic_store((gu32*)tmo, 0x4d5247u, RLX_AGENT); break; } }
    __builtin_amdgcn_fence(__ATOMIC_ACQUIRE, "agent"); asm volatile("s_waitcnt vmcnt(0)" ::: "memory");
}
__device__ __forceinline__ void mrg_publish(unsigned* cnt, bool leader) { asm volatile("s_waitcnt vmcnt(0)" ::: "memory"); if (leader) __hip_atomic_fetch_add((gu32*)cnt, 1u, RLX_AGENT); }
__device__ __forceinline__ void epi_glu_wt(const pg8::f32x4 (&acc)[2][2][4][2], __amdgpu_buffer_rsrc_t rs, const unsigned short* __restrict__ PROJ, int row0, int oc0) {
#pragma unroll
    for (int ai = 0; ai < 2; ++ai)
#pragma unroll
        for (int m = 0; m < 4; ++m) { const int r = row0 + ai * 128 + m * 16;
#pragma unroll
            for (int n = 0; n < 2; ++n) { const int oc = oc0 + 16 * n; const f32x4 ga = sig4_bf(PROJ + (size_t)r * INP + C_GA + oc);
                const pg8::f32x4 val = acc[ai][0][m][n], gt = acc[ai][1][m][n]; f32x4 o;
                o.x = ga.x * val[0] * sigmoidf_(gt[0]); o.y = ga.y * val[1] * sigmoidf_(gt[1]); o.z = ga.z * val[2] * sigmoidf_(gt[2]); o.w = ga.w * val[3] * sigmoidf_(gt[3]);
                st_wt16(rs, (r * DM + oc) * 4, o); } }
}
template <int MODE> __device__ __forceinline__ void epi_acc_wt(const pg8::f32x4 (&acc)[2][2][4][2], __amdgpu_buffer_rsrc_t rs, float* __restrict__ MF, unsigned short* __restrict__ MB, const unsigned short* __restrict__ PROJ, int gcol, int row0, int c0) {
#pragma unroll
    for (int ai = 0; ai < 2; ++ai)
#pragma unroll
        for (int m = 0; m < 4; ++m) { const int r = row0 + ai * 128 + m * 16; f32x4 g[4], o[4];
#pragma unroll
            for (int i = 0; i < 4; ++i) { const int c = c0 + (i >> 1) * 128 + (i & 1) * 16; g[i] = sig4_bf(PROJ + (size_t)r * INP + gcol + c); o[i] = *(const GAS f32x4*)(MF + (size_t)r * DM + c); }
#pragma unroll
            for (int i = 0; i < 4; ++i) { const int c = c0 + (i >> 1) * 128 + (i & 1) * 16; const pg8::f32x4 v = acc[ai][i >> 1][m][i & 1];
                o[i].x += g[i].x * v[0]; o[i].y += g[i].y * v[1]; o[i].z += g[i].z * v[2]; o[i].w += g[i].w * v[3];
                if (MODE == 1) { v2u w; w.x = pk2(o[i].x, o[i].y); w.y = pk2(o[i].z, o[i].w); *(v2u*)(MB + (size_t)r * DM + c) = w; } else st_wt16(rs, (r * DM + c) * 4, o[i]); } }
}
struct MergeOrder {
    int nM, G, c, lo, hi;
    __device__ __forceinline__ bool next(int i, pg8::Unit& u) const { const int L = lo + i * G + c; if (L >= hi) return false;
        if (L < nM * 16) { u.pm = L >> 4; u.pn = L & 15; } else if (L < nM * 24) { const int r = L - nM * 16; u.pm = 34 + (r >> 3); u.pn = 16 + (r & 7); } else { const int r = L - nM * 24; u.pm = 68 + (r >> 3); u.pn = 24 + (r & 7); }
        return true; }
    __device__ __forceinline__ void a_ready(const pg8::Unit&) const {}
    __device__ __forceinline__ void done(const pg8::Unit&) const {}
};
struct GluCtxOrder {
    int c;
    __device__ __forceinline__ bool next(int i, pg8::Unit& u) const {
        int q;
        if (i == 0) { if (c < 32) { u.pm = 32 + (c >> 4); u.pn = c & 15; return true; } q = c - 32; }
        else if (i == 1) { if (c < 16) { u.pm = 34 + 32 + (c >> 3); u.pn = 16 + (c & 7); return true; } q = 224 + c - 16; }
        else if (i == 2) { if (c < 16) { u.pm = 68 + 32 + (c >> 3); u.pn = 24 + (c & 7); return true; } q = 464 + c - 16; if (q >= 512) return false; }
        else return false;
        u.pm = q >> 4; u.pn = q & 15; return true; }
    __device__ __forceinline__ void a_ready(const pg8::Unit&) const {}
    __device__ __forceinline__ void done(const pg8::Unit&) const {}
};
struct EpiMergeCtx {
    static constexpr bool PERM = false, AFTER_DRAIN = false;
    float* MF; unsigned short* MB; const unsigned short* PROJ; unsigned* cnt; unsigned* tmo;
    __device__ __forceinline__ void operator()(const pg8::f32x4 (&acc)[2][2][4][2], const pg8::Unit& u, int wr, int wc, int fr, int fq) const {
        const int type = u.pm >= 68 ? 2 : (u.pm >= 34 ? 1 : 0), pm = u.pm - 34 * type; const bool leader = (fr == 0 && fq == 0);
        const int row0 = pm * 256 + wr * 64 + fr;
        if (type == 0 && pm < MLAT / 256) { epi_glu_body(acc, MF, PROJ, row0, u.pn * 128 + wc * 32 + 4 * fq); return; }
        const __amdgpu_buffer_rsrc_t rs = __builtin_amdgcn_make_buffer_rsrc((void*)MF, 0, MROWS * DM * 4, 0x00020000);
        if (type == 0) { unsigned* c = cnt + (pm * 8 + (u.pn >> 1)) * 16; epi_glu_wt(acc, rs, PROJ, row0, u.pn * 128 + wc * 32 + 4 * fq); mrg_publish(c, leader); }
        else if (type == 1) { const int pn = u.pn - 16; unsigned* c = cnt + (pm * 8 + pn) * 16; mrg_wait(c, 16u, tmo); epi_acc_wt<0>(acc, rs, MF, MB, PROJ, C_GB, row0, pn * 256 + wc * 32 + 4 * fq); mrg_publish(c, leader); }
        else { const int pn = u.pn - 24; unsigned* c = cnt + (pm * 8 + pn) * 16; mrg_wait(c, 24u, tmo); epi_acc_wt<1>(acc, rs, MF, MB, PROJ, C_GC, row0, pn * 256 + wc * 32 + 4 * fq); }
    }
};
struct EpiMerge {
    static constexpr bool PERM = false, AFTER_DRAIN = false;
    float* MF; unsigned short* MB; const unsigned short* PROJ; unsigned* cnt; unsigned* tmo;
    __device__ __forceinline__ void operator()(const pg8::f32x4 (&acc)[2][2][4][2], const pg8::Unit& u, int wr, int wc, int fr, int fq) const {
        const int type = u.pm >= 68 ? 2 : (u.pm >= 34 ? 1 : 0), pm = u.pm - 34 * type; const bool leader = (fr == 0 && fq == 0);
        const int row0 = pm * 256 + wr * 64 + fr;
        const __amdgpu_buffer_rsrc_t rs = __builtin_amdgcn_make_buffer_rsrc((void*)MF, 0, MROWS * DM * 4, 0x00020000);
        if (type == 0) { unsigned* c = cnt + (pm * 8 + (u.pn >> 1)) * 16; epi_glu_wt(acc, rs, PROJ, row0, u.pn * 128 + wc * 32 + 4 * fq); mrg_publish(c, leader); }
        else if (type == 1) { const int pn = u.pn - 16; unsigned* c = cnt + (pm * 8 + pn) * 16; mrg_wait(c, 16u, tmo); epi_acc_wt<0>(acc, rs, MF, MB, PROJ, C_GB, row0, pn * 256 + wc * 32 + 4 * fq); mrg_publish(c, leader); }
        else { const int pn = u.pn - 24; unsigned* c = cnt + (pm * 8 + pn) * 16; mrg_wait(c, 24u, tmo); epi_acc_wt<1>(acc, rs, MF, MB, PROJ, C_GC, row0, pn * 256 + wc * 32 + 4 * fq); }
    }
};
template <int NN> struct DenseOrder {
    int nM, G, c;
    __device__ __forceinline__ bool next(int i, pg8::Unit& u) const { const int L = i * G + c; if (L >= nM * NN) return false; u.pm = L / NN; u.pn = L % NN; return true; }
    __device__ __forceinline__ void a_ready(const pg8::Unit&) const {}
    __device__ __forceinline__ void done(const pg8::Unit&) const {}
};
struct InProjOrder {
    int npc, G, c;
    __device__ __forceinline__ bool next(int i, pg8::Unit& u) const { const int L = i * G + c; if (L >= 32 * 54 + 2 * npc) return false;
        if (L < 32 * 54) { u.pm = L / 54; u.pn = L % 54; } else { const int r = L - 32 * 54; u.pm = 32 + r / npc; u.pn = r % npc; } return true; }
    __device__ __forceinline__ void a_ready(const pg8::Unit&) const {}
    __device__ __forceinline__ void done(const pg8::Unit&) const {}
};
struct InProjXcdOrder {
    int npc, c;
    __device__ __forceinline__ bool next(int i, pg8::Unit& u) const { const int x = c & 7, e = i * 32 + (c >> 3);
        if (e < 216) { u.pm = 4 * x + (e & 3); u.pn = e >> 2; return true; }
        const int j = (e - 216) * 8 + x; if (j >= 2 * npc) return false;
        u.pm = 32 + j / npc; u.pn = j % npc; return true; }
    __device__ __forceinline__ void a_ready(const pg8::Unit&) const {}
    __device__ __forceinline__ void done(const pg8::Unit&) const {}
};
struct InProjDeferOrder {
    int G, c;
    __device__ __forceinline__ bool next(int i, pg8::Unit& u) const { const int L = i * G + c; if (L >= 50) return false; u.pm = 32 + L / 25; u.pn = 29 + L % 25; return true; }
    __device__ __forceinline__ void a_ready(const pg8::Unit&) const {}
    __device__ __forceinline__ void done(const pg8::Unit&) const {}
};
template <int NPN> struct MoeOrder {
    const int* tile_e; int ntiles, G, c;
    __device__ __forceinline__ bool next(int i, pg8::Unit& u) const { const int cx = (G & 7) ? c : ((c & 7) * (G >> 3) + (c >> 3));
        const int L = i * G + cx; if (L >= ntiles * NPN) return false; const int t = L / NPN, j = L % NPN;
        u.pm = t; u.pn = __builtin_amdgcn_readfirstlane(tile_e[t]) * NPN + j; return true; }
    __device__ __forceinline__ void a_ready(const pg8::Unit&) const {}
    __device__ __forceinline__ void done(const pg8::Unit&) const {}
};

template <int NPN> struct MoeGatherOrder {
    static constexpr bool GATHER = true;
    const LAS int* tile_e; const LAS int* seg; const GAS int* postab; int ntiles, G, c;
    __device__ __forceinline__ bool next(int i, pg8::Unit& u) const { const int cx = (G & 7) ? c : ((c & 7) * (G >> 3) + (c >> 3));
        const int L = i * G + cx; if (L >= ntiles * NPN) return false; const int t = L / NPN, j = L % NPN;
        u.pm = t; u.pn = __builtin_amdgcn_readfirstlane(tile_e[t]) * NPN + j; return true; }
    __device__ __forceinline__ int src_row(const pg8::Unit& u, int r) const { const int e = tile_e[u.pm], p = u.pm * 256 + r - seg[e]; return p < seg[33 + e] ? postab[e * POSTAB_CAP + p] : 0; }
    __device__ __forceinline__ void a_ready(const pg8::Unit&) const {}
    __device__ __forceinline__ void done(const pg8::Unit&) const {}
};
constexpr size_t TB_WGH = 512 * 1024, TB_WGL = 768 * 1024;
__device__ __forceinline__ void ph_wg_split(const Args& a, Frame& F, int l) {
    unsigned short* WGH = (unsigned short*)(F.ws + WS_TAB + TB_WGH); unsigned short* WGL = (unsigned short*)(F.ws + WS_TAB + TB_WGL);
    const float* wg1 = kin<I_MWG1>() + (size_t)l * DM * 4; const float* wg2 = kin<I_MWG2>() + (size_t)l * DM * 32;
    for (int i = F.bid * 512 + F.tid; i < 48 * DM; i += F.G * 512) { const int n = i / DM, k = i % DM;
        const float w = n < 4 ? wg1[(size_t)k * 4 + n] : (n < 36 ? wg2[(size_t)k * 32 + (n - 4)] : 0.f);
        const int fo = ((((k >> 5) * 3 + (n >> 4)) * 64) + ((k >> 3) & 3) * 16 + (n & 15)) * 8 + (k & 7);
        const unsigned hi = f2bf(w); WGH[fo] = (unsigned short)hi; WGL[fo] = (unsigned short)f2bf(w - __builtin_bit_cast(float, hi << 16)); }
}
__device__ __forceinline__ void router_kloop(const float* __restrict__ xr, const float* __restrict__ g2, const float* __restrict__ sh, const float* __restrict__ sc, unsigned short* __restrict__ ur,
                                             const unsigned short* __restrict__ bh, const unsigned short* __restrict__ bl, float rs, f32x4 (&acc)[3]) {
#pragma unroll 2
        for (int ks = 0; ks < 64; ++ks) { const int ko = 32 * ks;
            const f32x4 x0 = *(const f32x4*)(xr + ko), x1 = *(const f32x4*)(xr + ko + 4), g0 = *(const f32x4*)(g2 + ko), g1 = *(const f32x4*)(g2 + ko + 4);
            const f32x4 s0 = *(const f32x4*)(sh + ko), s1 = *(const f32x4*)(sh + ko + 4), c0 = *(const f32x4*)(sc + ko), c1 = *(const f32x4*)(sc + ko + 4);
            const f32x4 y0 = (x0 * rs * g0) * (1.0f + c0) + s0, y1 = (x1 * rs * g1) * (1.0f + c1) + s1;
            const float yy[8] = {y0.x, y0.y, y0.z, y0.w, y1.x, y1.y, y1.z, y1.w};
            unsigned hb[8], lb[8];
#pragma unroll
            for (int e = 0; e < 8; ++e) { hb[e] = f2bf(yy[e]); lb[e] = f2bf(yy[e] - __builtin_bit_cast(float, hb[e] << 16)); }
            v4u hv, lv; hv.x = hb[0] | (hb[1] << 16); hv.y = hb[2] | (hb[3] << 16); hv.z = hb[4] | (hb[5] << 16); hv.w = hb[6] | (hb[7] << 16);
            lv.x = lb[0] | (lb[1] << 16); lv.y = lb[2] | (lb[3] << 16); lv.z = lb[4] | (lb[5] << 16); lv.w = lb[6] | (lb[7] << 16);
            *(v4u*)(ur + ko) = hv;
            const bf16x8 ah = __builtin_bit_cast(bf16x8, hv), al = __builtin_bit_cast(bf16x8, lv);
#pragma unroll
            for (int ct = 0; ct < 3; ++ct) { const bf16x8 wh = *(const bf16x8*)(bh + (size_t)ct * 16 * DM + ko), wl = *(const bf16x8*)(bl + (size_t)ct * 16 * DM + ko);
                acc[ct] = mfma16(ah, wh, acc[ct]); acc[ct] = mfma16(ah, wl, acc[ct]); acc[ct] = mfma16(al, wh, acc[ct]); } }
}
__device__ __forceinline__ void router_tile_pass2(const f32x4 (&x)[8][2], float rs, const float* __restrict__ Ar, const float* __restrict__ Br, GAS unsigned short* __restrict__ ur,
                                                  const GAS unsigned short* __restrict__ bh, const GAS unsigned short* __restrict__ bl, f32x4 (&acc)[3]) {
    bf16x8 W[2][6];
#pragma unroll
    for (int ct = 0; ct < 3; ++ct) { W[0][2 * ct] = *(const GAS bf16x8*)(bh + ct * 512); W[0][2 * ct + 1] = *(const GAS bf16x8*)(bl + ct * 512); }
#pragma unroll
    for (int s = 0; s < 8; ++s) { const int ko = 32 * s;
        if (s + 1 < 8) {
#pragma unroll
            for (int ct = 0; ct < 3; ++ct) { W[(s + 1) & 1][2 * ct] = *(const GAS bf16x8*)(bh + ((s + 1) * 3 + ct) * 512); W[(s + 1) & 1][2 * ct + 1] = *(const GAS bf16x8*)(bl + ((s + 1) * 3 + ct) * 512); } }
        __builtin_amdgcn_sched_barrier(0);
        const f32x4 a0 = *(const f32x4*)(Ar + ko), a1 = *(const f32x4*)(Ar + ko + 4), b0 = *(const f32x4*)(Br + ko), b1 = *(const f32x4*)(Br + ko + 4);
        const f32x4 y0 = (x[s][0] * rs) * a0 + b0, y1 = (x[s][1] * rs) * a1 + b1;
        const float yy[8] = {y0.x, y0.y, y0.z, y0.w, y1.x, y1.y, y1.z, y1.w};
        unsigned hb[8], lb[8];
#pragma unroll
        for (int e = 0; e < 8; ++e) { hb[e] = f2bf(yy[e]); lb[e] = f2bf(yy[e] - __builtin_bit_cast(float, hb[e] << 16)); }
        v4u hv, lv; hv.x = hb[0] | (hb[1] << 16); hv.y = hb[2] | (hb[3] << 16); hv.z = hb[4] | (hb[5] << 16); hv.w = hb[6] | (hb[7] << 16);
        lv.x = lb[0] | (lb[1] << 16); lv.y = lb[2] | (lb[3] << 16); lv.z = lb[4] | (lb[5] << 16); lv.w = lb[6] | (lb[7] << 16);
        *(GAS v4u*)(ur + ko) = hv;
        const bf16x8 ah = __builtin_bit_cast(bf16x8, hv), al = __builtin_bit_cast(bf16x8, lv);
#pragma unroll
        for (int ct = 0; ct < 3; ++ct) { const bf16x8 wh = W[s & 1][2 * ct], wl = W[s & 1][2 * ct + 1];
            acc[ct] = mfma16(ah, wh, acc[ct]); acc[ct] = mfma16(ah, wl, acc[ct]); acc[ct] = mfma16(al, wh, acc[ct]); } }
}
__device__ __forceinline__ void ph_router(const Args& a, Frame& F, int l, int nrows, bool count) {
    const GAS float* X = (const GAS float*)(F.ws + WS_X); GAS unsigned short* U = (GAS unsigned short*)(F.ws + WS_U);
    const GAS float* MOD = (const GAS float*)(F.ws + WS_MOD);
    const GAS unsigned short* WGH = (const GAS unsigned short*)(F.ws + WS_TAB + TB_WGH); const GAS unsigned short* WGL = (const GAS unsigned short*)(F.ws + WS_TAB + TB_WGL);
    int* EXPERT = (int*)(F.ws + WS_TAB + TB_EXPERT); float* RWT = (float*)(F.ws + WS_TAB + TB_RWT);
    const GAS float* g2base = (const GAS float*)kin<I_G2>() + l * DM; const float* bg1 = kin<I_MBG1>() + l * 4; const float* bg2 = kin<I_MBG2>() + l * 32;
    float* Am = (float*)F.lds; float* Bm = Am + 3 * DM; float* ssP = Bm + 3 * DM; float* red = ssP + 128; float* lgs = red + 8 * 16 * 48;
    const int lane = F.lane, l15 = lane & 15, q = lane >> 4, w = F.wave;
    { float gg[12], s1[12], s0[12];
#pragma unroll
      for (int j = 0; j < 12; ++j) { const int i = F.tid + j * NWAVES * 64, mr = i / DM, c = i % DM; const GAS float* sh = MOD + ((size_t)(l * 3 + mr)) * 12288 + 3 * DM; gg[j] = g2base[c]; s1[j] = sh[DM + c]; s0[j] = sh[c]; }
#pragma unroll
      for (int j = 0; j < 12; ++j) { const int i = F.tid + j * NWAVES * 64; Am[i] = gg[j] * (1.0f + s1[j]); Bm[i] = s0[j]; } }
    float* bias = lgs + 16 * 48;
    if (F.tid < 48) bias[F.tid] = F.tid < 4 ? ((const GAS float*)bg1)[F.tid] : (F.tid < 36 ? ((const GAS float*)bg2)[F.tid - 4] : 0.f);
    int pend_row = -1, pend_e0 = 0, pend_e1 = 0; unsigned pend_p0 = 0u, pend_p1 = 0u;
    __syncthreads();
    for (int tile = F.bid; tile < nrows / 16; tile += F.G) {
        const int row = tile * 16 + l15, mr = row_modidx(tile * 16);
        const GAS float* xr = X + (size_t)row * DM + 256 * w + 8 * q;
        f32x4 x[8][2];
#pragma unroll
        for (int s = 0; s < 8; ++s) { x[s][0] = *(const GAS f32x4*)(xr + 32 * s); x[s][1] = *(const GAS f32x4*)(xr + 32 * s + 4); }
        float ss = 0.f;
#pragma unroll
        for (int s = 0; s < 8; ++s) ss += (x[s][0].x * x[s][0].x + x[s][0].y * x[s][0].y) + (x[s][0].z * x[s][0].z + x[s][0].w * x[s][0].w) + (x[s][1].x * x[s][1].x + x[s][1].y * x[s][1].y) + (x[s][1].z * x[s][1].z + x[s][1].w * x[s][1].w);
        ss += __shfl_xor(ss, 16); ss += __shfl_xor(ss, 32);
        if (q == 0) ssP[w * 16 + l15] = ss;
        __syncthreads();
        float tot = 0.f;
#pragma unroll
        for (int ww = 0; ww < 8; ++ww) tot += ssP[ww * 16 + l15];
        const float rs = 1.0f / sqrtf(tot * (1.0f / DM) + 1e-6f);
        GAS unsigned short* ur = U + (size_t)row * LDU + 256 * w + 8 * q;
        const GAS unsigned short* bh = WGH + (size_t)(24 * w) * 512 + lane * 8; const GAS unsigned short* bl = WGL + (size_t)(24 * w) * 512 + lane * 8;
        const float* Ar = Am + mr * DM + 256 * w + 8 * q; const float* Br = Bm + mr * DM + 256 * w + 8 * q;
        f32x4 acc[3];
#pragma unroll
        for (int i = 0; i < 3; ++i) acc[i] = (f32x4){0.f, 0.f, 0.f, 0.f};
        router_tile_pass2(x, rs, Ar, Br, ur, bh, bl, acc);
#pragma unroll
        for (int ct = 0; ct < 3; ++ct)
#pragma unroll
            for (int jj = 0; jj < 4; ++jj) red[(w * 16 + 4 * q + jj) * 48 + 16 * ct + l15] = acc[ct][jj];
        __syncthreads();
        for (int o = F.tid; o < 16 * 48; o += NWAVES * 64) { float s_ = 0.f;
#pragma unroll
            for (int ww = 0; ww < 8; ++ww) s_ += red[ww * 768 + o];
            lgs[o] = s_ + bias[o % 48]; }
        __syncthreads();
        if (F.tid < 16) { const float* lg = lgs + F.tid * 48; const int orow = tile * 16 + F.tid;
            float mx = -3.0e38f; int grp = 0; float l1[4];
#pragma unroll
            for (int e = 0; e < 4; ++e) { l1[e] = lg[e]; if (l1[e] > mx) { mx = l1[e]; grp = e; } }
            float den = 0.f;
#pragma unroll
            for (int e = 0; e < 4; ++e) den += expf(l1[e] - mx);
            const float ptop = 1.0f / den;
            float v0 = -3.0e38f, v1 = -3.0e38f; int i0 = 0, i1 = 0;
            for (int e = 0; e < 8; ++e) { const float x = lg[4 + grp * 8 + e];
                if (x > v0) { v1 = v0; i1 = i0; v0 = x; i0 = e; } else if (x > v1) { v1 = x; i1 = e; } }
            const float w0 = ptop / (1.0f + expf(v1 - v0)), w1 = ptop - w0;
            const int e0 = grp * 8 + i0, e1 = grp * 8 + i1; EXPERT[orow * 2] = e0; EXPERT[orow * 2 + 1] = e1; RWT[orow * 2] = w0; RWT[orow * 2 + 1] = w1;
            if (count) { int* SLOT = (int*)(F.ws + WS_TAB + TB_SLOT);
                int* POSTAB = (int*)(F.ws + WS_POSTAB);
                if (pend_row >= 0) { SLOT[pend_row * 2] = (int)pend_p0; SLOT[pend_row * 2 + 1] = (int)pend_p1; POSTAB[pend_e0 * POSTAB_CAP + (int)pend_p0] = pend_row; POSTAB[pend_e1 * POSTAB_CAP + (int)pend_p1] = pend_row; }
                pend_p0 = __hip_atomic_fetch_add((unsigned*)(F.ctl + CW_CNT + l * 64 + e0), 1u, RLX_AGENT); pend_p1 = __hip_atomic_fetch_add((unsigned*)(F.ctl + CW_CNT + l * 64 + e1), 1u, RLX_AGENT); pend_row = orow; pend_e0 = e0; pend_e1 = e1; } }
    }
    if (F.tid < 16 && pend_row >= 0) { int* SLOT = (int*)(F.ws + WS_TAB + TB_SLOT); int* POSTAB = (int*)(F.ws + WS_POSTAB); SLOT[pend_row * 2] = (int)pend_p0; SLOT[pend_row * 2 + 1] = (int)pend_p1;
        POSTAB[pend_e0 * POSTAB_CAP + (int)pend_p0] = pend_row; POSTAB[pend_e1 * POSTAB_CAP + (int)pend_p1] = pend_row; }
    __syncthreads();
}
__device__ __forceinline__ void ph_scatter(const Args& a, Frame& F, int l, int nrows) {
    int* seg = (int*)F.lds;
    if (F.tid < 64) {
        const int e = F.tid & 31; const int c = (int)__hip_atomic_load((unsigned*)(F.ctl + CW_CNT + l * 64 + e), RLX_AGENT); const int pad = (c + 255) & ~255; int s = pad;
#pragma unroll
        for (int off = 1; off < 32; off <<= 1) { const int t = __shfl_up(s, off, 32); if (e >= off) s += t; }
        if (F.tid < 32) { seg[e] = s - pad; seg[33 + e] = c; if (e == 31) seg[32] = s; } }
    __syncthreads();
    int* SEG = (int*)(F.ws + WS_TAB + TB_SEG) + l * 40; int* TILEE = (int*)(F.ws + WS_TAB + TB_TILEE) + l * 128;
    if (F.bid == 0) { if (F.tid <= 32) SEG[F.tid] = seg[F.tid]; if (F.tid == 0) SEG[36] = seg[32] >> 8;
        if (F.tid < 128) { const int t = F.tid; int e = 0; for (int q = 0; q < 32; ++q) if (t * 256 >= seg[q]) e = q; TILEE[t] = e; } }
    const int gw = F.bid * NWAVES + F.wave, NGW = F.G * NWAVES;
    const int* EXPERT = (const int*)(F.ws + WS_TAB + TB_EXPERT); int* SLOT = (int*)(F.ws + WS_TAB + TB_SLOT);
    const unsigned short* U = (const unsigned short*)(F.ws + WS_U); unsigned short* VG = (unsigned short*)(F.ws + WS_VG);
    int* ROWIDX = (int*)(F.ws + WS_TAB + TB_ROWIDX);
    for (int q = F.bid * (NWAVES * 64) + F.tid; q < nrows * 2; q += F.G * NWAVES * 64) { const int slot = seg[EXPERT[q]] + SLOT[q]; SLOT[q] = slot; ROWIDX[slot] = q >> 1; }
    for (int idx = F.bid * (NWAVES * 64) + F.tid; idx < 32 * 256; idx += F.G * NWAVES * 64) { const int e = idx >> 8, i = idx & 255, c = seg[33 + e]; if (c + i < ((c + 255) & ~255)) ROWIDX[seg[e] + c + i] = 0; }
    (void)gw; (void)NGW; (void)U; (void)VG;
}

#ifndef MK_PER_PHASE
#define MK_PER_PHASE 0
#endif
#ifndef CTX_FOLD
#define CTX_FOLD 1
#endif
#ifndef RW_SCAN_VAR
#define RW_SCAN_VAR 0
#endif
#ifndef S5_PREP_UNITS_LAST
#define S5_PREP_UNITS_LAST 64
#endif
#ifndef S5_PREP_UNITS
#define S5_PREP_UNITS 64
#endif
constexpr int PH_PER_LAYER = 14, PH_TOTAL = 2 + NLAY * PH_PER_LAYER + 1;

#ifdef DBG_ONLY
#define LSEL(j) ((j) == DBG_ONLY)
#else
#define LSEL(j) true
#endif
#ifndef CV_EARLY
#define CV_EARLY 1
#endif
#define CVQ_DRAIN(word, lo_, hi_) do { for (;;) { if (F.tid == 0) F.MISC[0] = __hip_atomic_fetch_add((unsigned*)(F.ctl + (word)), 1u, RLX_AGENT); __syncthreads(); const int t_ = (int)F.MISC[0]; __syncthreads(); \
        if ((lo_) + 64 * t_ >= (hi_)) break; ph_convert_range(args, F, l + 1, (lo_) + 64 * t_, ((lo_) + 64 * t_ + 64) < (hi_) ? ((lo_) + 64 * t_ + 64) : (hi_), F.wave, NWAVES); } } while (0)
#define LAUNDER() do { int t_ = threadIdx.x; asm volatile("" : "+v"(t_)); F.tid = t_; F.lane = t_ & 63; GAS unsigned char* w_ = (GAS unsigned char*)args.ws; asm volatile("" : "+s"(w_)); F.ws = (unsigned char*)w_; F.ctl = (gu32*)(w_ + WS_CTL); GAS float* o_ = (GAS float*)args.out; asm volatile("" : "+s"(o_)); F.out = (float*)o_; } while (0)
#ifndef DUP_MASK
#define DUP_MASK 0
#endif
#define REP(j) for (int rep_ = 0; rep_ < (((DUP_MASK) >> (j)) & 1) + 1; ++rep_)
#define IN(k) (lo <= (k) && (k) < hi)
#define BOTH(k) (IN(k) && IN((k) + 1))
#define GRID_BAR() do { if (MK_PER_PHASE) { if (F.tid == 0) __hip_atomic_store(F.ctl + CW_TMO, 0xBADBA0u, RLX_AGENT); } else { xcd_barrier(bar); } } while (0)
template <int l> __device__ __forceinline__ void layer_phases(const Args& args, Frame& F, const XcdBarrier& bar, const int lo, const int hi, unsigned char* lds, LAS unsigned char* ldsl) {
    const int gw = F.bid * NWAVES + F.wave, NGW = F.G * NWAVES;
        const int pb = 2 + l * PH_PER_LAYER;
        const bool lastl = (l == NLAY - 1);
        const int mrows = lastl ? MLAT : MROWS;
        if (LSEL(0) && IN(pb + 0)) { LAUNDER(); ph_convert(args, F, l, (CV_EARLY && l > 0) ? CV_MOE0 : 0); ph_wg_split(args, F, l); ph_lora_split(F, l); ph_gate_split(F, l); __syncthreads(); if ((DUP_MASK) & 1) { ph_convert(args, F, l); __syncthreads(); } ph_rowpass(args, F, l, 0, l > 0 ? 1 : 0, MROWS, MROWS); if (BOTH(pb + 0)) GRID_BAR(); }
        REP(1) if (LSEL(1) && IN(pb + 1)) { LAUNDER();
            pg8::Gemm g{(const pg8::bf16_t*)(F.ws + WS_U), (const pg8::bf16_t*)(F.ws + WS_WIN), MROWS, INP, DM, LDU, LDU};
            EpiStoreBf16<0> E{(unsigned short*)(F.ws + WS_PROJ), INP};
#ifdef INPROJ_XCD
            if (F.G == 256) { InProjXcdOrder S{lastl ? 26 : 29, F.bid}; pg8::gemm_phase<EpiStoreBf16<0>, InProjXcdOrder, true, true>(ldsl + RING_OFF, g, S, E); } else
#endif
            { InProjOrder S{lastl ? 26 : 29, F.G, F.bid};
            pg8::gemm_phase<EpiStoreBf16<0>, InProjOrder, true, true>(ldsl + RING_OFF, g, S, E); }
            if (BOTH(pb + 1)) GRID_BAR();
        }
        REP(2) if (LSEL(2) && IN(pb + 2)) { LAUNDER();
            {
                constexpr int NS5A = (l == NLAY - 1 ? S5_PREP_UNITS_LAST : S5_PREP_UNITS), NRW = 4 * (MROWS / 32), NGL = 16 * NSC;
#define QNEXT(word) ({ if (F.tid == 0) F.MISC[0] = __hip_atomic_fetch_add((unsigned*)(F.ctl + (word)), 1u, RLX_AGENT); __syncthreads(); const int t_ = (int)F.MISC[0]; __syncthreads(); t_; })
#define QLOOP_BEGIN(word, N) { int t_ = QNEXT(word); while (t_ < (N)) { unsigned nx_ = 0u; const bool pf_ = t_ + 2 * F.G < (N); if (pf_ && F.tid == 0) nx_ = __hip_atomic_fetch_add((unsigned*)(F.ctl + (word)), 1u, RLX_AGENT); const int t = t_;
#define QLOOP_END(word) if (pf_) { if (F.tid == 0) F.MISC[0] = nx_; __syncthreads(); t_ = (int)F.MISC[0]; __syncthreads(); } else t_ = QNEXT(word); } }
                for (;;) { const int t = QNEXT(CW_Q2 + l * 64 + 32 * rep_); if (t >= NS5A) break; s5_unit<0>(F, l, t); }
                {
                  QLOOP_BEGIN(CW_Q2 + l * 64 + 32 * rep_ + 1, NRW) const int dc = t / (MROWS / 32), tb = t % (MROWS / 32);
                      LAUNDER();
                      { RwLora B; rwkv_lora_frags(F, l, dc >> 1, dc & 1, B); rwkv_prep_unit<0>(F, l, dc >> 1, dc & 1, tb, B); }
                      LAUNDER();
#ifndef CP_SEPARATE
                      {
                          const int d_ = dc >> 1, R0 = tb * 32; const bool lat = R0 < MLAT;
                          const int b_ = lat ? (R0 >> 12) : ((R0 - MLAT) >> 8), c0 = lat ? ((R0 & (SEQL - 1)) >> 4) : (((R0 - MLAT) & (CTXL - 1)) >> 4);
                          const int chain = d_ * 32 + b_ * 16 + (dc & 1) * 8 + F.wave;
#pragma unroll 1
                          for (int rt = 0; rt < 2; ++rt) { const int cn = c0 + rt, ci = lat ? CTXL / 16 + (d_ ? SEQL / 16 - 1 - cn : cn) : (d_ ? CTXL / 16 - 1 - cn : cn);
                              rwkv_chunk_prep(F, chain * RW_NCH + ci, lds + F.wave * CP_BYTES); }
                          __syncthreads(); }
#endif
                  QLOOP_END(CW_Q2 + l * 64 + 32 * rep_ + 1) }
                { GlaGk Gk; Gk.key = -1; GlaPre P; QLOOP_BEGIN(CW_Q2 + l * 64 + 32 * rep_ + 2, NGL) gla_prep_load(F, t, P); gla_prep_unit(args, F, l, t, Gk, P, -1); QLOOP_END(CW_Q2 + l * 64 + 32 * rep_ + 2) }

            }
            if (BOTH(pb + 2)) GRID_BAR();
        }
        REP(3) if (LSEL(3) && IN(pb + 3)) { LAUNDER();
#ifdef CP_SEPARATE
            for (int wu = gw; wu < 64 * RW_NCH; wu += NGW) rwkv_chunk_prep(F, wu, lds + F.wave * CP_BYTES);
            if (BOTH(pb + 3)) GRID_BAR();
#endif
        }
        REP(4) if (LSEL(4) && IN(pb + 4)) { LAUNDER();
            const int nrw = F.G / 4, ngl = F.G / 2;
            unsigned* cp2 = (unsigned*)(F.ctl + CW_CP2 + l * 64 + 32 * rep_);
#ifdef RW_SCAN3
            if (F.bid < nrw) { for (int ci = F.bid; ci < 64; ci += nrw) rwkv_scan3(F, ci); }
#else
            if (F.bid < nrw) { for (int ci = F.bid; ci < 64; ci += nrw) rwkv_scan2<RW_SCAN_VAR>(F, ci, cp2, (unsigned)ngl); }
#endif
            if (F.bid >= nrw && F.bid < nrw + ngl) { for (int j = F.bid - nrw; j < 128; j += ngl) {
                const int u = (ngl == 128 && (nrw & 7) == 0) ? (((j & 7) + 8 * (j >> 6)) * 8 + ((j >> 3) & 7)) : j; gla_scan_unit(F, u); } }
            else if (F.bid >= nrw + ngl) { if (!lastl) {
                pg8::Gemm g{(const pg8::bf16_t*)(F.ws + WS_U), (const pg8::bf16_t*)(F.ws + WS_WIN), MROWS, INP, DM, LDU, LDU};
                InProjDeferOrder S{F.G - nrw - ngl, F.bid - nrw - ngl};
                EpiStoreBf16<0> E{(unsigned short*)(F.ws + WS_PROJ), INP};
                pg8::gemm_phase<EpiStoreBf16<0>, InProjDeferOrder, true, true>(ldsl + RING_OFF, g, S, E); }
            }
            if (F.bid >= nrw) { constexpr int NS5A = (l == NLAY - 1 ? S5_PREP_UNITS_LAST : S5_PREP_UNITS); const int cap = F.bid < nrw + ngl ? 1 : 256;
                for (int n = 0; n < cap; ++n) { const int t = QNEXT(CW_Q4 + l * 64 + 32 * rep_); if (t >= 256 - NS5A) break; s5_unit<0>(F, l, NS5A + t); } }
            __syncthreads();
#ifdef EXTRA_ROLE
            GRID_BAR();
            if (EXTRA_ROLE == 1) { if (F.bid < F.G / 4) { for (int ci = F.bid; ci < 64; ci += F.G / 4) rwkv_scan2<0>(F, ci, cp2, 0u); } }
            if (EXTRA_ROLE == 11) { if (F.bid < F.G / 4) { for (int ci = F.bid; ci < 64; ci += F.G / 4) rwkv_scan2<1>(F, ci, cp2, 0u); } }
            if (EXTRA_ROLE == 2) { if (F.bid >= F.G / 4 && F.bid < F.G / 4 + F.G / 2) { for (int u = F.bid - F.G / 4; u < 128; u += F.G / 2) gla_scan_unit(F, u); } }
            if (EXTRA_ROLE == 3) { unsigned short* Hb = (unsigned short*)(lds + F.wave * 12800); float* Ul = (float*)(lds + F.wave * 12800 + 8704);
              for (;;) { int t = 0; if (F.lane == 0) t = (int)__hip_atomic_fetch_add((unsigned*)(F.ctl + CW_S5Q + l * 64 + 48), 1u, RLX_AGENT);
                  t = __builtin_amdgcn_readfirstlane(t); if (t >= 2 * 64 * NSC) break; s5_final(args, F, l, t, Hb, Ul); } }
            if (EXTRA_ROLE == 7) { for (int u = F.bid; u < 256; u += F.G) s5_unit<0>(F, l, u); }
            if (EXTRA_ROLE == 9) { for (int u = F.bid; u < 256; u += F.G) s5_unit<1>(F, l, u); }
            if (EXTRA_ROLE == 10) { for (int u = F.bid; u < 256; u += F.G) s5_unit<2>(F, l, u); }
            if (EXTRA_ROLE == 5) { GlaGk Gk; Gk.key = -1; GlaPre P; if (F.bid < 16 * NSC) gla_prep_load(F, F.bid, P); for (int u = F.bid; u < 16 * NSC; u += F.G) gla_prep_unit(args, F, l, u, Gk, P, u + F.G < 16 * NSC ? u + F.G : -1); }
            __syncthreads();
#endif
            if (BOTH(pb + 4)) GRID_BAR();
        }
        if (LSEL(5) && IN(pb + 5)) { LAUNDER();
            for (int rp = 0; rp < 1 + (((DUP_MASK) >> 5) & 1); ++rp)
            { const int ntb = mrows / 32;
              { ZbGate B; zb_gate_frags(F, l, 0, B); for (int v = F.bid; v < ntb; v += F.G) zb_unit(F, l, 0, v, B); }
              { ZbGate B; zb_gate_frags(F, l, 1, B); for (int v = F.bid; v < 2 * ntb; v += F.G) if (v >= ntb) zb_unit(F, l, 1, v - ntb, B); } }
            if (((DUP_MASK) >> 20) & 1) for (int row = gw; row < mrows; row += NGW) za_row(F, l, row);
            { ZaPar ZP; za_params(F, l, ZP);
            for (int r0 = gw; r0 < mrows; r0 += 5 * NGW) { ZaIn I[5];
#pragma unroll
                for (int k = 0; k < 5; ++k) if (r0 + k * NGW < mrows) za_load(F, r0 + k * NGW, I[k]);
#pragma unroll
                for (int k = 0; k < 5; ++k) if (r0 + k * NGW < mrows) za_finish(F, l, r0 + k * NGW, I[k], ZP); } }
            asm volatile("s_waitcnt vmcnt(0)" ::: "memory");
            { ZcPar ZP; zc_params(F, l, ZP);
            for (int r0 = gw; r0 < mrows; r0 += 5 * NGW) { ZcIn I[5];
#pragma unroll
                for (int k = 0; k < 5; ++k) if (r0 + k * NGW < mrows) zc_load(F, r0 + k * NGW, I[k]);
#pragma unroll
                for (int k = 0; k < 5; ++k) if (r0 + k * NGW < mrows) zc_finish(F, l, r0 + k * NGW, I[k], ZP); } }
            if (((DUP_MASK) >> 21) & 1) { asm volatile("s_waitcnt vmcnt(0)" ::: "memory"); for (int row = gw; row < mrows; row += NGW) zc_row(args, F, l, row); }
            if (BOTH(pb + 5)) GRID_BAR();
        }
#ifdef MIX_A
        REP(6) if (LSEL(6) && IN(pb + 6)) { LAUNDER();
            pg8::Gemm g{(const pg8::bf16_t*)(F.ws + WS_ZA), (const pg8::bf16_t*)(F.ws + WS_WGLU), 3 * MROWS, 8192, 1024, 1024, 1024};
            const int nM_ = mrows / 256; MergeOrder S{nM_, F.G, F.bid, 0, nM_ * 16};
            EpiMerge E{(float*)(F.ws + WS_MF), (unsigned short*)(F.ws + WS_MB), (const unsigned short*)(F.ws + WS_PROJ), (unsigned*)(F.ctl + CW_MRG + l * MRG_LSTRIDE), (unsigned*)(F.ctl + CW_TMO)};
            pg8::gemm_phase<EpiMerge, MergeOrder, true, true>(ldsl + RING_OFF, g, S, E);
            GRID_BAR();
        }
        REP(7) if (LSEL(7) && IN(pb + 7)) { LAUNDER();
            pg8::Gemm g{(const pg8::bf16_t*)(F.ws + WS_ZB), (const pg8::bf16_t*)(F.ws + WS_WRW), mrows, DM, 1024, 1024, 1024};
            pg8::StaticOrder S; S.init(mrows, DM, F.G, F.bid);
            EpiAcc<0> E{(float*)(F.ws + WS_MF), nullptr, (const unsigned short*)(F.ws + WS_PROJ), C_GB, nullptr};
            pg8::gemm_phase<EpiAcc<0>, pg8::StaticOrder, true, true>(ldsl + RING_OFF, g, S, E);
            if (BOTH(pb + 7)) GRID_BAR();
        }
        REP(8) if (LSEL(8) && IN(pb + 8)) { LAUNDER();
            pg8::Gemm g{(const pg8::bf16_t*)(F.ws + WS_ZC), (const pg8::bf16_t*)(F.ws + WS_WGL), mrows, DM, 1024, 1024, 1024};
            pg8::StaticOrder S; S.init(mrows, DM, F.G, F.bid);
            EpiAcc<1> E{(float*)(F.ws + WS_MF), (unsigned short*)(F.ws + WS_MB), (const unsigned short*)(F.ws + WS_PROJ), C_GC, nullptr};
            pg8::gemm_phase<EpiAcc<1>, pg8::StaticOrder, true, true>(ldsl + RING_OFF, g, S, E);
            if (BOTH(pb + 8)) GRID_BAR();
        }
#elif defined(MIX_B)
        REP(6) if (LSEL(6) && IN(pb + 6)) { LAUNDER();
            pg8::Gemm g{(const pg8::bf16_t*)(F.ws + WS_ZA), (const pg8::bf16_t*)(F.ws + WS_WGLU), mrows, 4096, 1024, 1024, 1024};
            pg8::StaticOrder S; S.init(mrows, 4096, F.G, F.bid);
            EpiGlu E{(float*)(F.ws + WS_MF), (const unsigned short*)(F.ws + WS_PROJ)};
            pg8::gemm_phase<EpiGlu, pg8::StaticOrder, true, true>(ldsl + RING_OFF, g, S, E);
            if (BOTH(pb + 6)) GRID_BAR();
        }
        REP(7) if (LSEL(7) && IN(pb + 7)) { LAUNDER();
            pg8::Gemm g{(const pg8::bf16_t*)(F.ws + WS_ZA), (const pg8::bf16_t*)(F.ws + WS_WGLU), 3 * MROWS, 8192, 1024, 1024, 1024};
            const int nM_ = mrows / 256;
            for (int part = 1; part < 3; ++part) { MergeOrder S{nM_, F.G, F.bid, part == 1 ? nM_ * 16 : nM_ * 24, part == 1 ? nM_ * 24 : nM_ * 32};
            EpiMerge E{(float*)(F.ws + WS_MF), (unsigned short*)(F.ws + WS_MB), (const unsigned short*)(F.ws + WS_PROJ), (unsigned*)(F.ctl + CW_MRG + l * MRG_LSTRIDE), (unsigned*)(F.ctl + CW_TMO)};
            pg8::gemm_phase<EpiMerge, MergeOrder, true, true>(ldsl + RING_OFF, g, S, E); GRID_BAR(); }
        }
#elif defined(OLD_MERGE)
        const bool ctxfold = CTX_FOLD && !lastl && F.G == 256;
        const int mrows_rg = ctxfold ? MLAT : mrows;
        REP(6) if (LSEL(6) && IN(pb + 6)) { LAUNDER();
            if (ctxfold) {
                pg8::Gemm g{(const pg8::bf16_t*)(F.ws + WS_ZA), (const pg8::bf16_t*)(F.ws + WS_WGLU), 3 * MROWS, 8192, 1024, 1024, 1024};
                GluCtxOrder S{F.bid};
                EpiMergeCtx E{(float*)(F.ws + WS_MF), (unsigned short*)(F.ws + WS_MB), (const unsigned short*)(F.ws + WS_PROJ), (unsigned*)(F.ctl + CW_MRG + l * MRG_LSTRIDE), (unsigned*)(F.ctl + CW_TMO)};
                pg8::gemm_phase<EpiMergeCtx, GluCtxOrder, true, true>(ldsl + RING_OFF, g, S, E);
            } else {
            pg8::Gemm g{(const pg8::bf16_t*)(F.ws + WS_ZA), (const pg8::bf16_t*)(F.ws + WS_WGLU), mrows, 4096, 1024, 1024, 1024};
            pg8::StaticOrder S; S.init(mrows, 4096, F.G, F.bid);
            EpiGlu E{(float*)(F.ws + WS_MF), (const unsigned short*)(F.ws + WS_PROJ)};
            pg8::gemm_phase<EpiGlu, pg8::StaticOrder, true, true>(ldsl + RING_OFF, g, S, E); }
            if constexpr (CV_EARLY && l + 1 < NLAY) { LAUNDER(); CVQ_DRAIN(CW_CVQ + l * 64, 0, CV_MRG0); }
            if (BOTH(pb + 6)) GRID_BAR();
        }
        REP(7) if (LSEL(7) && IN(pb + 7)) { LAUNDER();
            pg8::Gemm g{(const pg8::bf16_t*)(F.ws + WS_ZB), (const pg8::bf16_t*)(F.ws + WS_WRW), mrows_rg, DM, 1024, 1024, 1024};
            pg8::StaticOrder S; S.init(mrows_rg, DM, F.G, F.bid);
            EpiAcc<0> E{(float*)(F.ws + WS_MF), nullptr, (const unsigned short*)(F.ws + WS_PROJ), C_GB, nullptr};
            pg8::gemm_phase<EpiAcc<0>, pg8::StaticOrder, true, true>(ldsl + RING_OFF, g, S, E);
            if (BOTH(pb + 7)) GRID_BAR();
        }
        REP(8) if (LSEL(8) && IN(pb + 8)) { LAUNDER();
            pg8::Gemm g{(const pg8::bf16_t*)(F.ws + WS_ZC), (const pg8::bf16_t*)(F.ws + WS_WGL), mrows_rg, DM, 1024, 1024, 1024};
            pg8::StaticOrder S; S.init(mrows_rg, DM, F.G, F.bid);
            EpiAcc<1> E{(float*)(F.ws + WS_MF), (unsigned short*)(F.ws + WS_MB), (const unsigned short*)(F.ws + WS_PROJ), C_GC, nullptr};
            pg8::gemm_phase<EpiAcc<1>, pg8::StaticOrder, true, true>(ldsl + RING_OFF, g, S, E);
            if (BOTH(pb + 8)) GRID_BAR();
        }
#else
        REP(6) if (LSEL(6) && IN(pb + 6)) { LAUNDER();
            pg8::Gemm g{(const pg8::bf16_t*)(F.ws + WS_ZA), (const pg8::bf16_t*)(F.ws + WS_WGLU), 3 * MROWS, 8192, 1024, 1024, 1024};
#ifdef MRG_SPLIT
            const int nM_ = mrows / 256;
            for (int part = 0; part < 3; ++part) { MergeOrder S{nM_, F.G, F.bid, part == 0 ? 0 : (part == 1 ? nM_ * 16 : nM_ * 24), part == 0 ? nM_ * 16 : (part == 1 ? nM_ * 24 : nM_ * 32)};
            EpiMerge E{(float*)(F.ws + WS_MF), (unsigned short*)(F.ws + WS_MB), (const unsigned short*)(F.ws + WS_PROJ), (unsigned*)(F.ctl + CW_MRG + l * MRG_LSTRIDE), (unsigned*)(F.ctl + CW_TMO)};
            pg8::gemm_phase<EpiMerge, MergeOrder, true, true>(ldsl + RING_OFF, g, S, E); GRID_BAR(); }
#else
            MergeOrder S{mrows / 256, F.G, F.bid, 0, (mrows / 256) * 32};
            EpiMerge E{(float*)(F.ws + WS_MF), (unsigned short*)(F.ws + WS_MB), (const unsigned short*)(F.ws + WS_PROJ), (unsigned*)(F.ctl + CW_MRG + l * MRG_LSTRIDE), (unsigned*)(F.ctl + CW_TMO)};
            pg8::gemm_phase<EpiMerge, MergeOrder, true, true>(ldsl + RING_OFF, g, S, E);
            if (BOTH(pb + 6)) GRID_BAR();
#endif
        }
#endif
        REP(9) if (LSEL(9) && IN(pb + 9)) { LAUNDER();
            pg8::Gemm g{(const pg8::bf16_t*)(F.ws + WS_MB), (const pg8::bf16_t*)(F.ws + WS_WOUT), mrows, DM, DM, DM, DM};
            pg8::StaticOrder S; S.init(mrows, DM, F.G, F.bid);
            if constexpr (l == 0) {
                EpiAccX0 E{(float*)(F.ws + WS_X), kin<I_X>(), kin<I_CTX>(), (const float*)(F.ws + WS_MOD) + (size_t)(l * 3) * 12288 + 2 * DM};
                pg8::gemm_phase<EpiAccX0, pg8::StaticOrder, true, true>(ldsl + RING_OFF, g, S, E);
            } else {
                EpiAcc<2> E{(float*)(F.ws + WS_X), nullptr, nullptr, 0, (const float*)(F.ws + WS_MOD) + (size_t)(l * 3) * 12288 + 2 * DM};
                pg8::gemm_phase<EpiAcc<2>, pg8::StaticOrder, true, true>(ldsl + RING_OFF, g, S, E); }
            if (BOTH(pb + 9)) GRID_BAR();
        }
        REP(10) if (LSEL(10) && IN(pb + 10)) { LAUNDER(); ph_router(args, F, l, mrows, rep_ == 0); if (BOTH(pb + 10)) GRID_BAR(); }
        REP(12) if (LSEL(12) && IN(pb + 12)) { LAUNDER();
            LAS int* segL = (LAS int*)(ldsl + RING_BYTES); LAS int* tileL = segL + 96;
            if (F.tid < 64) { const int e = F.tid & 31; const int c = (int)__hip_atomic_load((unsigned*)(F.ctl + CW_CNT + l * 64 + e), RLX_AGENT); const int pad = (c + 255) & ~255; int s = pad;
#pragma unroll
                for (int off = 1; off < 32; off <<= 1) { const int t = __shfl_up(s, off, 32); if (e >= off) s += t; }
                if (F.tid < 32) { segL[e] = s - pad; segL[33 + e] = c; if (e == 31) segL[32] = s; } }
            __syncthreads();
            { int* SEGw = (int*)(F.ws + WS_TAB + TB_SEG) + l * 40; int* TILEEw = (int*)(F.ws + WS_TAB + TB_TILEE) + l * 128;
              if (F.tid < 128) { const int t = F.tid; int e = 0; for (int q = 0; q < 32; ++q) if (t * 256 >= segL[q]) e = q; tileL[t] = e; if (F.bid == 0) TILEEw[t] = e; }
              if (F.bid == 0) { if (F.tid <= 32) SEGw[F.tid] = segL[F.tid]; if (F.tid == 0) SEGw[36] = segL[32] >> 8; } }
            __syncthreads();
            const int nt = __builtin_amdgcn_readfirstlane(segL[32] >> 8);
            pg8::Gemm g{(const pg8::bf16_t*)(F.ws + WS_U), (const pg8::bf16_t*)(F.ws + WS_WGU), MOE_ROWS, 32 * 512, DM, LDU, DM};
            MoeGatherOrder<2> S{tileL, segL, (const GAS int*)(F.ws + WS_POSTAB), nt, F.G, F.bid};
            EpiMoe1 E{(unsigned short*)(F.ws + WS_HID)};
            pg8::gemm_phase<EpiMoe1, MoeGatherOrder<2>, true, true>(ldsl + RING_OFF, g, S, E);
            if constexpr (CV_EARLY && l + 1 < NLAY) { LAUNDER(); CVQ_DRAIN(CW_CVQ + l * 64 + 32, CV_MRG0, CV_MOE0); }
            if (BOTH(pb + 12)) GRID_BAR();
        }
        REP(13) if (LSEL(13) && IN(pb + 13)) { LAUNDER();
            const int* SEG = (const int*)(F.ws + WS_TAB + TB_SEG) + l * 40; const int nt = __builtin_amdgcn_readfirstlane(SEG[36]);
            int kdn = 256; asm volatile("" : "+s"(kdn));
            pg8::Gemm g{(const pg8::bf16_t*)(F.ws + WS_HID), (const pg8::bf16_t*)(F.ws + WS_WDN), MOE_ROWS, 32 * DM, kdn, 256, 256};
            MoeOrder<8> S{(const int*)(F.ws + WS_TAB + TB_TILEE) + l * 128, nt, F.G, F.bid};
            EpiStoreBf16<8> E{(unsigned short*)(F.ws + WS_EO), DM};
            pg8::gemm_phase<EpiStoreBf16<8>, MoeOrder<8>, true, true>(ldsl + RING_OFF, g, S, E);
            if (BOTH(pb + 13)) GRID_BAR();
        }
    }

__global__ void __launch_bounds__(NWAVES * 64, 2) mega_fwd(Args args) {
    extern __shared__ __attribute__((aligned(16))) unsigned char lds[];
    Frame F;
    F.lds = lds; F.MISC = (volatile LAS unsigned*)((LAS unsigned char*)lds + MISC_OFF);
    F.tid = threadIdx.x; F.lane = F.tid & 63; F.wave = __builtin_amdgcn_readfirstlane(F.tid >> 6);
    F.G = gridDim.x; F.bid = blockIdx.x;
    F.ctl = (gu32*)(args.ws + WS_CTL); F.ws = args.ws; F.out = args.out;
    for (int u = F.tid; u < (LDS_BYTES - LDSCTL_OFF) / 4; u += NWAVES * 64) ((LAS unsigned*)((LAS unsigned char*)lds + LDSCTL_OFF))[u] = 0u;
    __syncthreads();
    XcdBarrier bar; bar.bar = (unsigned*)(F.ctl + CW_BAR); bar.x = 0; bar.st = nullptr;
    if (!MK_PER_PHASE) bar = xcd_barrier_post((unsigned*)(F.ctl + CW_BAR), F.MISC + 8);
    const int lo = args.ph_lo, hi = args.ph_hi;
    LAS unsigned char* ldsl = (LAS unsigned char*)lds;
    const int gw = F.bid * NWAVES + F.wave, NGW = F.G * NWAVES;

    if (LSEL(100) && IN(0)) { LAUNDER(); ph_mod_partial(args, F); if (BOTH(0)) GRID_BAR(); }
    if (LSEL(101) && IN(1)) { LAUNDER(); ph_mod_reduce(args, F); if (BOTH(1)) GRID_BAR(); }

    layer_phases<0>(args, F, bar, lo, hi, lds, ldsl);
    layer_phases<1>(args, F, bar, lo, hi, lds, ldsl);
    if (LSEL(102) && IN(PH_TOTAL - 1)) { LAUNDER(); ph_rowpass(args, F, NLAY, 2, 1, MLAT, MLAT); }
}

extern "C" void kernel_launch(void* const* d_in, const int* in_sizes, int n_in, void* d_out, int out_size, void* d_ws, size_t ws_size, hipStream_t stream) {
    static int grid = 0;
    if (grid == 0) {
        if (n_in != N_INPUTS || out_size != MLAT * DM || ws_size < WS_END) { fprintf(stderr, "kernel_launch: unexpected shapes (n_in %d out %d ws %zu)\n", n_in, out_size, ws_size); grid = -1; return; }
        int dev = 0, cus = 0;
        if (hipGetDevice(&dev) != hipSuccess || hipDeviceGetAttribute(&cus, hipDeviceAttributeMultiprocessorCount, dev) != hipSuccess) { grid = -1; return; }
        if (hipFuncSetAttribute((const void*)mega_fwd, hipFuncAttributeMaxDynamicSharedMemorySize, LDS_BYTES) != hipSuccess) { fprintf(stderr, "kernel_launch: hipFuncSetAttribute failed\n"); grid = -1; return; }
        int per_cu = 0;
        if (hipOccupancyMaxActiveBlocksPerMultiprocessor(&per_cu, (const void*)mega_fwd, NWAVES * 64, LDS_BYTES) != hipSuccess || per_cu < 1) fprintf(stderr, "kernel_launch: occupancy query reports %d\n", per_cu);
        (void)hipGetLastError();
        grid = cus;
    }
    if (grid < 0) return;
    if (hipMemsetAsync((char*)d_ws + WS_CTL, 0, CTL_ZERO_BYTES, stream) != hipSuccess) return;
    Args a{};
    for (int i = 0; i < N_INPUTS; ++i) a.in[i] = (const float*)d_in[i];
    a.out = (float*)d_out; a.ws = (unsigned char*)d_ws;
#if MK_PER_PHASE
    for (int p = 0; p < PH_TOTAL; ++p) { a.ph_lo = p; a.ph_hi = p + 1; hipLaunchKernelGGL(mega_fwd, dim3(grid), dim3(NWAVES * 64), LDS_BYTES, stream, a); }
#else
    a.ph_lo = 0; a.ph_hi = PH_TOTAL; hipLaunchKernelGGL(mega_fwd, dim3(grid), dim3(NWAVES * 64), LDS_BYTES, stream, a);
#endif
}
```

```cpp
#include <hip/hip_runtime.h>
#include <cstdio>
#define OLD_MERGE
#define INPROJ_XCD
#define LDU_PAD 0
namespace pg8 {
#define PG8_LAS __attribute__((address_space(3)))
typedef unsigned short bf16_t;
typedef short bf16x8 __attribute__((ext_vector_type(8)));
typedef float f32x4 __attribute__((ext_vector_type(4)));
typedef unsigned u32x4 __attribute__((ext_vector_type(4)));
constexpr int BM = 256, BK = 64, HALF = 128, HTB = HALF * BK * 2  , STAGE_BYTES = 8 * HTB, NXCD = 8, WGM = 8;

__host__ __device__ __forceinline__ int lds_byte(int r, int c) { const int st = (r >> 4) * 2 + (c >> 5), rr = r & 15, cc = c & 31, ob = rr * 64 + cc * 2; return st * 1024 + (ob ^ (((ob >> 9) & 1) << 5)); }
__host__ __device__ __forceinline__ void stage_rc(int b, int& R, int& C) { const int st = b / 1024, sb = b % 1024, swz = sb ^ (((sb >> 9) & 1) << 5); R = (st >> 1) * 16 + swz / 64; C = (st & 1) * 32 + (swz % 64) / 2; }
__host__ __device__ __forceinline__ int perm32(int rho) { const int n = rho >> 4, i = rho & 15; return 8 * (i >> 2) + 4 * n + (i & 3); }

struct Unit { int pm, pn; };
struct Gemm { const bf16_t* A; const bf16_t* Bt; int M, N, K, lda, ldb; };

struct StaticOrder {
    int nM, nN, nwg, G, c;
    __host__ __device__ void init(int M, int N, int G_, int c_) { nM = M / BM; nN = N / BM; nwg = nM * nN; G = G_; c = c_; }
    __host__ __device__ bool next(int i, Unit& u) const {
        const long L = (long)i * G + c; if (L >= nwg) return false;
        int wgid = (int)L; { const int q = nwg / NXCD, r = nwg % NXCD, xcd = wgid % NXCD, off = wgid / NXCD; wgid = (xcd < r ? xcd * (q + 1) : r * (q + 1) + (xcd - r) * q) + off; }
        const int nig = WGM * nN, gid = wgid / nig, fm = gid * WGM, gsz = (nM - fm) < WGM ? (nM - fm) : WGM;
        u.pm = fm + ((wgid % nig) % gsz); u.pn = (wgid % nig) / gsz; return true;
    }
    __device__ __forceinline__ void a_ready(const Unit&) const {}
    __device__ __forceinline__ void done(const Unit&) const {}
};

typedef __bf16 bf16x2_cv __attribute__((ext_vector_type(2))); typedef float f32x2_cv __attribute__((ext_vector_type(2)));
__device__ __forceinline__ unsigned cvt_pk_bf16(float lo, float hi) { const f32x2_cv v = {lo, hi}; return __builtin_bit_cast(unsigned, __builtin_convertvector(v, bf16x2_cv)); }
template <class T, class = void> struct sched_gather { static constexpr bool value = false; };
template <class T> struct sched_gather<T, decltype((void)T::GATHER)> { static constexpr bool value = T::GATHER; };
template <class Epi, class Sched, bool ALIGN_EPI = false, bool SP2 = false>
__device__ __forceinline__ void gemm_phase(PG8_LAS unsigned char* lds, const Gemm g, const Sched& S, const Epi& E) {
    static_assert(SP2 || !sched_gather<Sched>::value, "gather staging is wired into the SP2 K-loop only");
    int tid_l = threadIdx.x; asm volatile("" : "+v"(tid_l));
    const int tid = tid_l, wid = __builtin_amdgcn_readfirstlane(tid >> 6), lane = tid & 63, wr = wid >> 2, wc = wid & 3, fr = lane & 15, fq = lane >> 4;
    const int K = g.K, nt = K / BK;
    unsigned voffA[2], voffB[2]; int stR[2], stC[2];
#pragma unroll
    for (int i = 0; i < 2; ++i) { int R, C; stage_rc(tid * 16 + i * 8192, R, C); const int Rb = Epi::PERM ? ((R & ~31) + perm32(R & 31)) : R; stR[i] = R; stC[i] = C;
        voffA[i] = (unsigned)(R * g.lda + C) * 2u; voffB[i] = (unsigned)(Rb * g.ldb + C) * 2u; }
    constexpr bool GATHER = sched_gather<Sched>::value;
    unsigned vgC[2][2] = {{0u, 0u}, {0u, 0u}}, vgN[2][2] = {{0u, 0u}, {0u, 0u}};
#define PG8_GLOAD(dst, unit) do { if constexpr (GATHER) { _Pragma("unroll") for (int h_ = 0; h_ < 2; ++h_) _Pragma("unroll") for (int i_ = 0; i_ < 2; ++i_) \
        dst[h_][i_] = (unsigned)(S.src_row((unit), h_ * HALF + stR[i_]) * g.lda + stC[i_]) * 2u; } } while (0)
    const size_t kstep = (size_t)(BK * 2);
    const size_t hstepA = (size_t)HALF * g.lda * 2, hstepB = (size_t)HALF * g.ldb * 2;
    const size_t tstepA = 2 * hstepA, tstepB = 2 * hstepB;
    const unsigned ldsw = (unsigned)wid * 1024u;
    const int aoff = lds_byte(wr * 64 + fr, fq * 8), boff = lds_byte(wc * 32 + fr, fq * 8);
#define PG8_SA(b, h) (((b) * 2 + (h)) * HTB)
#define PG8_SB(b, h) ((4 + (b) * 2 + (h)) * HTB)
#define PG8_STAGE(bufoff, gbase, voff) do { _Pragma("unroll") for (int _i = 0; _i < 2; ++_i) \
        __builtin_amdgcn_global_load_lds((const unsigned*)((const char*)(gbase) + (voff)[_i]), (PG8_LAS unsigned*)(lds + (bufoff) + ldsw + _i * 8192), 16, 0, 0); } while (0)
#define PG8_STAGE_A(bufoff, p, h, nx) do { if constexpr (GATHER) { const unsigned vv_[2] = {(nx) ? vgN[h][0] : vgC[h][0], (nx) ? vgN[h][1] : vgC[h][1]}; PG8_STAGE(bufoff, p, vv_); } else PG8_STAGE(bufoff, (p) + (h) * hstepA, voffA); } while (0)
#define PG8_LDA(dst, b, h) do { _Pragma("unroll") for (int m = 0; m < 4; ++m) _Pragma("unroll") for (int k = 0; k < 2; ++k) dst[m][k] = *(const PG8_LAS bf16x8*)(lds + PG8_SA(b, h) + aoff + m * 2048 + k * 1024); } while (0)
#define PG8_LDB(dst, b, h) do { _Pragma("unroll") for (int n = 0; n < 2; ++n) _Pragma("unroll") for (int k = 0; k < 2; ++k) dst[n][k] = *(const PG8_LAS bf16x8*)(lds + PG8_SB(b, h) + boff + n * 2048 + k * 1024); } while (0)
#define PG8_MMA(ai, bj, At, Bt) do { __builtin_amdgcn_s_setprio(1); _Pragma("unroll") for (int m = 0; m < 4; ++m) _Pragma("unroll") for (int n = 0; n < 2; ++n) _Pragma("unroll") for (int k = 0; k < 2; ++k) \
        acc[ai][bj][m][n] = __builtin_amdgcn_mfma_f32_16x16x32_bf16(Bt[n][k], At[m][k], acc[ai][bj][m][n], 0, 0, 0); __builtin_amdgcn_s_setprio(0); } while (0)
#define PG8_WAIT_V(n) asm volatile("s_waitcnt vmcnt(" #n ")" ::: "memory")
#define PG8_WAIT_L(n) asm volatile("s_waitcnt lgkmcnt(" #n ")" ::: "memory")
#define PG8_BAR __builtin_amdgcn_s_barrier()
#define PG8_SCHED __builtin_amdgcn_sched_barrier(0)
    Unit cur, nxt; int ui = 0;
    if (!S.next(0, cur)) return;
    f32x4 acc[2][2][4][2];
#pragma unroll
    for (int a = 0; a < 2; ++a)
#pragma unroll
        for (int b = 0; b < 2; ++b)
#pragma unroll
            for (int m = 0; m < 4; ++m)
#pragma unroll
                for (int n = 0; n < 2; ++n) acc[a][b][m][n] = (f32x4){0.f, 0.f, 0.f, 0.f};
    bf16x8 At[4][2], B0[2][2], B1[2][2];
    const char* cA = (const char*)g.A + (GATHER ? (size_t)0 : (size_t)cur.pm * tstepA); const char* cB = (const char*)g.Bt + (size_t)cur.pn * tstepB;
    PG8_GLOAD(vgC, cur);
    S.a_ready(cur);
    if constexpr (SP2) {
        PG8_STAGE(PG8_SB(0, 0), cB, voffB); PG8_STAGE(PG8_SB(0, 1), cB + hstepB, voffB); PG8_STAGE_A(PG8_SA(0, 0), cA, 0, false); PG8_STAGE_A(PG8_SA(0, 1), cA, 1, false);
        if (wr == 1) PG8_BAR;
        PG8_WAIT_V(2); PG8_BAR;
        PG8_STAGE(PG8_SB(1, 0), cB + kstep, voffB); PG8_STAGE_A(PG8_SA(1, 0), cA + kstep, 0, false); PG8_STAGE(PG8_SB(1, 1), cB + hstepB + kstep, voffB);
        PG8_WAIT_V(6); PG8_BAR;
    } else {
        PG8_STAGE(PG8_SB(0, 0), cB, voffB); PG8_STAGE(PG8_SA(0, 0), cA, voffA); PG8_STAGE(PG8_SB(0, 1), cB + hstepB, voffB); PG8_STAGE(PG8_SA(0, 1), cA + hstepA, voffA);
        if (wr == 1) PG8_BAR;
        PG8_WAIT_V(4); PG8_BAR;
        PG8_STAGE(PG8_SB(1, 0), cB + kstep, voffB); PG8_STAGE(PG8_SA(1, 0), cA + kstep, voffA); PG8_STAGE(PG8_SB(1, 1), cB + hstepB + kstep, voffB);
        PG8_WAIT_V(6); PG8_BAR;
    }
    for (;;) {
        const bool has_next = S.next(ui + 1, nxt);
        const char* nA = (has_next && !GATHER) ? (const char*)g.A + (size_t)nxt.pm * tstepA : cA;
        if constexpr (GATHER) { if (has_next) PG8_GLOAD(vgN, nxt); else {
#pragma unroll
            for (int h_ = 0; h_ < 2; ++h_) { vgN[h_][0] = vgC[h_][0]; vgN[h_][1] = vgC[h_][1]; } } } const char* nB = has_next ? (const char*)g.Bt + (size_t)nxt.pn * tstepB : cB;
        for (int t = 0; t < nt; t += 2) {
            const bool last = (t == nt - 2);
            const char* a1 = cA + (size_t)(t + 1) * kstep;
            const char* a2 = last ? nA : cA + (size_t)(t + 2) * kstep; const char* b2 = last ? nB : cB + (size_t)(t + 2) * kstep;
            const char* a3 = a2 + kstep; const char* b3 = b2 + kstep;
            if (last && has_next) S.a_ready(nxt);
            if constexpr (SP2) {
            PG8_LDB(B0, 0, 0); PG8_LDB(B1, 0, 1); PG8_SCHED; PG8_LDA(At, 0, 0); PG8_STAGE_A(PG8_SA(1, 1), a1, 1, false);
            PG8_WAIT_V(8); PG8_WAIT_L(0); PG8_BAR; PG8_MMA(0, 0, At, B0); PG8_MMA(0, 1, At, B1); PG8_BAR; PG8_SCHED;
            PG8_LDA(At, 0, 1); PG8_STAGE(PG8_SB(0, 0), b2, voffB); PG8_STAGE(PG8_SB(0, 1), b2 + hstepB, voffB); PG8_STAGE_A(PG8_SA(0, 0), a2, 0, last);
            PG8_WAIT_V(8); PG8_WAIT_L(0); PG8_BAR; PG8_MMA(1, 0, At, B0); PG8_MMA(1, 1, At, B1); PG8_BAR; PG8_SCHED;
            PG8_LDB(B0, 1, 0); PG8_LDB(B1, 1, 1); PG8_SCHED; PG8_LDA(At, 1, 0); PG8_STAGE_A(PG8_SA(0, 1), a2, 1, last);
            PG8_WAIT_V(8); PG8_WAIT_L(0); PG8_BAR; PG8_MMA(0, 0, At, B0); PG8_MMA(0, 1, At, B1); PG8_BAR; PG8_SCHED;
            PG8_LDA(At, 1, 1); PG8_STAGE(PG8_SB(1, 0), b3, voffB); PG8_STAGE(PG8_SB(1, 1), b3 + hstepB, voffB); PG8_STAGE_A(PG8_SA(1, 0), a3, 0, last);
            PG8_WAIT_V(8); PG8_WAIT_L(0); PG8_BAR; PG8_MMA(1, 0, At, B0); PG8_MMA(1, 1, At, B1); PG8_BAR; PG8_SCHED;
            } else {
            PG8_LDB(B0, 0, 0); PG8_SCHED; PG8_LDA(At, 0, 0); PG8_STAGE(PG8_SA(1, 1), a1 + hstepA, voffA);
            PG8_WAIT_L(8); PG8_BAR; PG8_WAIT_L(0); PG8_MMA(0, 0, At, B0); PG8_BAR; PG8_SCHED;
            PG8_LDB(B1, 0, 1); PG8_STAGE(PG8_SB(0, 0), b2, voffB);
            PG8_BAR; PG8_WAIT_L(0); PG8_MMA(0, 1, At, B1); PG8_BAR;
            PG8_LDA(At, 0, 1); PG8_STAGE(PG8_SA(0, 0), a2, voffA);
            PG8_BAR; PG8_WAIT_L(0); PG8_MMA(1, 0, At, B0); PG8_BAR; PG8_SCHED;
            PG8_STAGE(PG8_SB(0, 1), b2 + hstepB, voffB);
            PG8_WAIT_V(6); PG8_BAR; PG8_MMA(1, 1, At, B1); PG8_BAR;
            PG8_LDB(B0, 1, 0); PG8_SCHED; PG8_LDA(At, 1, 0); PG8_STAGE(PG8_SA(0, 1), a2 + hstepA, voffA);
            PG8_WAIT_L(8); PG8_BAR; PG8_WAIT_L(0); PG8_MMA(0, 0, At, B0); PG8_BAR; PG8_SCHED;
            PG8_LDB(B1, 1, 1); PG8_STAGE(PG8_SB(1, 0), b3, voffB);
            PG8_BAR; PG8_WAIT_L(0); PG8_MMA(0, 1, At, B1); PG8_BAR;
            PG8_LDA(At, 1, 1); PG8_STAGE(PG8_SA(1, 0), a3, voffA);
            PG8_BAR; PG8_WAIT_L(0); PG8_MMA(1, 0, At, B0); PG8_BAR; PG8_SCHED;
            PG8_STAGE(PG8_SB(1, 1), b3 + hstepB, voffB);
            PG8_WAIT_V(6); PG8_BAR; PG8_MMA(1, 1, At, B1); PG8_BAR;
            }
        }
        if constexpr (ALIGN_EPI) { if (wr == 0) PG8_BAR; }
        if constexpr (!Epi::AFTER_DRAIN) { E(acc, cur, wr, wc, fr, fq); S.done(cur); }
        if (!has_next) break;
#pragma unroll
        for (int a = 0; a < 2; ++a)
#pragma unroll
            for (int b = 0; b < 2; ++b)
#pragma unroll
                for (int m = 0; m < 4; ++m)
#pragma unroll
                    for (int n = 0; n < 2; ++n) acc[a][b][m][n] = (f32x4){0.f, 0.f, 0.f, 0.f};
        cur = nxt; cA = nA; cB = nB; ++ui;
        if constexpr (GATHER) {
#pragma unroll
            for (int h_ = 0; h_ < 2; ++h_) { vgC[h_][0] = vgN[h_][0]; vgC[h_][1] = vgN[h_][1]; } }
        if constexpr (ALIGN_EPI) { if (wr == 1) PG8_BAR; }
    }
    PG8_WAIT_V(0);
    if constexpr (!ALIGN_EPI) { if (wr == 0) PG8_BAR; }
    PG8_BAR;
    if constexpr (Epi::AFTER_DRAIN) { E.fused(acc, cur, wr, wc, fr, fq, lds, wid, lane); S.done(cur); }
#undef PG8_SA
#undef PG8_SB
#undef PG8_STAGE
#undef PG8_STAGE_A
#undef PG8_GLOAD
#undef PG8_LDA
#undef PG8_LDB
#undef PG8_MMA
#undef PG8_WAIT_V
#undef PG8_WAIT_L
#undef PG8_BAR
#undef PG8_SCHED
}
}

constexpr int NWAVES = 8;
constexpr int DM = 2048, NBATCH = 2, SEQL = 4096, CTXL = 256, NLAY = 2;
constexpr int MLAT = NBATCH * SEQL, MCTX = NBATCH * CTXL, MROWS = MLAT + MCTX;
constexpr int INW = 13584, INP = 13824;
constexpr int C_S5 = 0, C_RW = 1024, C_GLO = 4224, C_Q = 4352, C_K = 4864, C_V = 5376, C_GK = 6400, C_OG = 6416, C_GA = 7440, C_GB = 9488, C_GC = 11536;
constexpr int LDU = DM + LDU_PAD;
constexpr int NSC = 68;
constexpr int MOE_ROWS = 25600;

enum { I_X = 0, I_C, I_CTX, I_CCTX, I_WMOD, I_BMOD, I_G1, I_G2, I_WIN, I_S5ARE, I_S5AIM, I_S5LDT, I_S5BRE, I_S5BIM, I_S5CRE, I_S5CIM, I_S5D, I_S5GLU,
       I_RWMU, I_RWW0, I_RWWUP, I_RWA0, I_RWAUP, I_RWKK, I_RWKA, I_RWRK, I_RWGUP, I_RWLNW, I_RWLNB, I_RWPROJ, I_GLGKUP, I_GLGKB, I_GLNG, I_GLPROJ, I_WOUT,
       I_MWG1, I_MBG1, I_MWG2, I_MBG2, I_MWGATE, I_MWUP, I_MWDOWN, I_GFINAL, N_INPUTS };

constexpr size_t MiB = 1u << 20;
constexpr size_t WS_CTL = 0, CTL_ZERO_BYTES = 256 * 1024;
constexpr size_t WS_MOD = 1 * MiB;
constexpr size_t WS_POSTAB = 2 * MiB;
constexpr int POSTAB_CAP = 2 * MROWS;
constexpr size_t WS_MODP = 2 * MiB;
constexpr size_t WS_TAB = 12 * MiB;
constexpr size_t WS_X = 14 * MiB;
constexpr size_t WS_U = 82 * MiB;
constexpr size_t WS_WIN = 118 * MiB;
constexpr size_t WS_WGLU = 174 * MiB;
constexpr size_t WS_WRW = 182 * MiB;
constexpr size_t WS_WGL = 186 * MiB;
constexpr size_t WS_WOUT = 190 * MiB;
constexpr size_t WS_WGU = 198 * MiB;
constexpr size_t WS_WDN = 262 * MiB;
constexpr size_t WS_PROJ = 294 * MiB;
constexpr size_t WS_MODP2 = WS_PROJ;
constexpr size_t WS_VG = WS_PROJ;
constexpr size_t WS_HID = WS_PROJ + 100 * MiB;
constexpr size_t WS_EO = WS_PROJ + 113 * MiB;
constexpr size_t WS_PREP = 524 * MiB;
constexpr size_t WS_MF = WS_PREP;
constexpr size_t WS_BONUS = 728 * MiB;
constexpr size_t WS_S5END = 730 * MiB;
constexpr size_t WS_YB = 739 * MiB;
constexpr size_t WS_OG = 773 * MiB;
constexpr size_t WS_ZA = 807 * MiB;
constexpr size_t WS_ZB = 824 * MiB;
constexpr size_t WS_ZC = 841 * MiB;
constexpr size_t WS_MB = 858 * MiB;
constexpr size_t WS_GLA = 892 * MiB;
constexpr size_t WS_YS0 = 936 * MiB;
constexpr size_t WS_END = 953 * MiB;
static_assert(WS_PROJ + (size_t)MROWS * INP * 2 <= WS_PREP && WS_EO + (size_t)MOE_ROWS * DM * 2 <= WS_PREP && WS_PREP + (size_t)2 * MROWS * 6144 * 2 <= WS_BONUS, "ws map");
constexpr size_t TB_EXPERT = 0;
constexpr size_t TB_RWT = 128 * 1024;
constexpr size_t TB_SLOT = 256 * 1024;
constexpr size_t TB_TILEE = 384 * 1024;
constexpr size_t TB_ROWIDX = 1024 * 1024;
constexpr size_t TB_SEG = 392 * 1024;
constexpr int CW_TMO = 0, CW_CODE = 1;
constexpr int CW_BAR = 4096;
constexpr int CW_CNT = 16384;
constexpr int CW_FILL = 16384 + 256;
constexpr int CW_Q2 = 16384 + 768, CW_Q4 = 16384 + 1024;
constexpr int CW_CP2 = 16384 + 1280;
constexpr int CW_MRG = 32768, MRG_LSTRIDE = 8192;
constexpr int CW_CVQ = 16384 + 1536;
constexpr int CW_S5Q = 16384 + 512;

constexpr int RING_OFF = 0, RING_BYTES = 131072;
constexpr int LDS_BYTES = 147456;
constexpr int LDSCTL_OFF = LDS_BYTES - 512, MISC_OFF = LDSCTL_OFF + 320;
#define GAS __attribute__((address_space(1)))
#define LAS __attribute__((address_space(3)))
typedef unsigned short bf16;
typedef unsigned v4u __attribute__((ext_vector_type(4)));
typedef float f32x4 __attribute__((ext_vector_type(4)));
typedef short bf16x8 __attribute__((ext_vector_type(8)));
typedef GAS unsigned gu32;
typedef GAS unsigned long long gu64;
#define RLX_AGENT __ATOMIC_RELAXED, __HIP_MEMORY_SCOPE_AGENT
#define LDS_WAIT() asm volatile("s_waitcnt lgkmcnt(0)" ::: "memory")
#define VM_WAIT() asm volatile("s_waitcnt vmcnt(0)" ::: "memory")
__device__ __forceinline__ unsigned long long rt() { return __builtin_amdgcn_s_memrealtime(); }
typedef __bf16 bf16x2_hw __attribute__((ext_vector_type(2))); typedef float f32x2_hw __attribute__((ext_vector_type(2)));
__device__ __forceinline__ unsigned pk2(float lo, float hi) { const f32x2_hw v = {lo, hi}; return __builtin_bit_cast(unsigned, __builtin_convertvector(v, bf16x2_hw)); }
__device__ __forceinline__ unsigned f2bf(float f) { return (unsigned)__builtin_bit_cast(unsigned short, (__bf16)f); }

#define XB_TMO      128
#define XB_XCNT(j)  (256  + 64 * (j))
#define XB_XSUB(j)  (1280 + 64 * (j))
#define XB_XGEN(j)  (2304 + 64 * (j))
#define XB_TOP      3328
#define XB_TOPGEN   3392
#define XCD_BAR_WORDS 3456
#define XB_SPIN_CAP (1u << 18)

__device__ __forceinline__ unsigned xb_ld(unsigned* p)              { return __hip_atomic_load(p, __ATOMIC_RELAXED, __HIP_MEMORY_SCOPE_AGENT); }
__device__ __forceinline__ unsigned xb_add(unsigned* p, unsigned v) { return __hip_atomic_fetch_add(p, v, __ATOMIC_RELAXED, __HIP_MEMORY_SCOPE_AGENT); }
__device__ __forceinline__ unsigned xb_xcc_id() { return (unsigned)__builtin_amdgcn_s_getreg((3 << 11) | 20) & 0xFu; }
#define XB_SPIN(cond, bar) do { unsigned _sp = 0; while (cond) { __builtin_amdgcn_s_sleep(1); \
    if ((++_sp & 255u) == 0u) { if (xb_ld(&(bar)[XB_TMO])) break; if (_sp > XB_SPIN_CAP) { atomicAdd(&(bar)[XB_TMO], 1u); break; } } } } while (0)

struct XcdBarrier {
    unsigned* bar; unsigned x;
    volatile LAS unsigned* st;
};

__device__ __forceinline__ XcdBarrier xcd_barrier_post(unsigned* bar, volatile LAS unsigned* st) {
    XcdBarrier b; b.bar = bar; b.x = xb_xcc_id(); b.st = st;
    if (threadIdx.x == 0) (void)xb_add(&bar[XB_XCNT(b.x)], 1u);
    return b;
}
__device__ __forceinline__ void xcd_barrier_complete(unsigned* bar, unsigned x, unsigned& nloc, unsigned& nx) {
    const unsigned G = gridDim.x * gridDim.y * gridDim.z;
    unsigned sum, cnt, mine, sp = 0u;
    for (;;) {
        sum = 0u; cnt = 0u; mine = 0u;
#pragma unroll
        for (unsigned j = 0; j < 16; ++j) { const unsigned c = xb_ld(&bar[XB_XCNT(j)]); sum += c; cnt += (c > 0u) ? 1u : 0u; mine = (j == x) ? c : mine; }
        if (sum == G) break;
        __builtin_amdgcn_s_sleep(1);
        if ((++sp & 255u) == 0u) { if (xb_ld(&bar[XB_TMO])) break; if (sp > XB_SPIN_CAP) { atomicAdd(&bar[XB_TMO], 1u); break; } }
    }
    nloc = mine > 0u ? mine : 1u; nx = cnt > 0u ? cnt : 1u;
}

__device__ __forceinline__ void xcd_barrier(const XcdBarrier& b) {
    asm volatile("s_waitcnt vmcnt(0)" ::: "memory");
    __syncthreads();
    if (threadIdx.x == 0) {
        unsigned* bar = b.bar;
        __builtin_amdgcn_s_waitcnt(0);
        unsigned nloc = b.st[0], nx = b.st[1];
        if (nloc == 0u) { xcd_barrier_complete(bar, b.x, nloc, nx); b.st[0] = nloc; b.st[1] = nx; }
        const unsigned old = xb_add(&bar[XB_XSUB(b.x)], 1u);
        const unsigned gen = old / nloc;
        if (old + 1u == (gen + 1u) * nloc) {
            __builtin_amdgcn_fence(__ATOMIC_RELEASE, "agent");
            asm volatile("s_waitcnt vmcnt(0)" ::: "memory");
            const unsigned og = xb_add(&bar[XB_TOP], 1u);
            const unsigned tg = og / nx;
            if (og + 1u == (tg + 1u) * nx) xb_add(&bar[XB_TOPGEN], 1u);
            else XB_SPIN(xb_ld(&bar[XB_TOPGEN]) == tg, bar);
            __builtin_amdgcn_fence(__ATOMIC_ACQUIRE, "agent");
            xb_add(&bar[XB_XGEN(b.x)], 1u);
            asm volatile("s_waitcnt vmcnt(0)" ::: "memory");
        } else {
            XB_SPIN(xb_ld(&bar[XB_XGEN(b.x)]) == gen, bar);
            __builtin_amdgcn_fence(__ATOMIC_ACQUIRE, "agent");
            asm volatile("s_waitcnt vmcnt(0)" ::: "memory");
        }
    }
    __syncthreads();
}


typedef float f32x2 __attribute__((ext_vector_type(2)));
typedef unsigned v2u __attribute__((ext_vector_type(2)));
struct Args { const float* in[N_INPUTS]; float* out; unsigned char* ws; int ph_lo, ph_hi; };
struct Frame { unsigned char* lds; volatile LAS unsigned* MISC; gu32* ctl; unsigned char* ws; float* out; int tid, lane, wave, G, bid; };


template <int I> __device__ __forceinline__ const float* kin() {
    const GAS float* p; auto ka = __builtin_amdgcn_kernarg_segment_ptr();
    asm volatile("s_load_dwordx2 %0, %1, %2\n\ts_waitcnt lgkmcnt(0)" : "=s"(p) : "s"(ka), "n"(I * 8));
    return (const float*)p;
}
__device__ __forceinline__ float bf2f(unsigned short b) { return __builtin_bit_cast(float, ((unsigned)b) << 16); }
__device__ __forceinline__ float bflo(unsigned w) { return __builtin_bit_cast(float, w << 16); }
__device__ __forceinline__ float bfhi(unsigned w) { return __builtin_bit_cast(float, w & 0xffff0000u); }
__device__ __forceinline__ unsigned short f2h(float f) { return __builtin_bit_cast(unsigned short, (_Float16)f); }
__device__ __forceinline__ float h2f(unsigned short h) { return (float)__builtin_bit_cast(_Float16, h); }
__device__ __forceinline__ float sigmoidf_(float x) { return __builtin_amdgcn_rcpf(1.0f + __expf(-x)); }
__device__ __forceinline__ float siluf_(float x) { return x * __builtin_amdgcn_rcpf(1.0f + __expf(-x)); }
__device__ __forceinline__ float wave_sum(float v) {
#pragma unroll
    for (int o = 1; o < 64; o <<= 1) v += __shfl_xor(v, o);
    return v;
}
__device__ __forceinline__ float quad_sum(float v) {
    v += __builtin_bit_cast(float, __builtin_amdgcn_mov_dpp(__builtin_bit_cast(int, v), 0xB1, 0xF, 0xF, true));
    v += __builtin_bit_cast(float, __builtin_amdgcn_mov_dpp(__builtin_bit_cast(int, v), 0x4E, 0xF, 0xF, true));
    return v;
}
__device__ __forceinline__ int row_modidx(int row) { return row < MLAT ? (row >> 12) : 2; }
__device__ __forceinline__ int seq_row(int b, int dir, int sc) {
    if (sc < CTXL) { const int j = dir ? (CTXL - 1 - sc) : sc; return MLAT + b * CTXL + j; }
    const int p = sc - CTXL; const int n = dir ? (SEQL - 1 - p) : p; return b * SEQL + n;
}
__device__ __forceinline__ int gla_row(int b, int dir, int sc) {
    if (sc < CTXL) { const int j = dir ? (CTXL - 1 - sc) : sc; return MLAT + b * CTXL + j; }
    int p = sc - CTXL; if (dir) p = SEQL - 1 - p; const int n = (p & 63) * 64 + (p >> 6); return b * SEQL + n;
}
__device__ __forceinline__ int prev_row(int row, int dir) {
    if (row < MLAT) { const int t = row & (SEQL - 1); return dir ? (t == SEQL - 1 ? -1 : row + 1) : (t == 0 ? -1 : row - 1); }
    const int t = (row - MLAT) & (CTXL - 1); return dir ? (t == CTXL - 1 ? -1 : row + 1) : (t == 0 ? -1 : row - 1);
}

__device__ __forceinline__ void ph_mod_partial(const Args& a, Frame& F) {
    float* sv = (float*)F.lds;
    float* MODP = (float*)(F.ws + WS_MODP2);
    const float* cptr = kin<I_C>(); const float* ccptr = kin<I_CCTX>(); const float* wmod = kin<I_WMOD>();
    for (int u = F.bid; u < 768; u += F.G) {
        const int l = u / 384, r = u % 384, kc = r / 6, jb = r % 6;
        if (F.tid < 192) { const int r3 = F.tid >> 6, k = kc * 32 + (F.tid & 31); const float cv = r3 < 2 ? cptr[r3 * DM + k] : ccptr[k]; sv[F.tid] = siluf_(cv); }
        __syncthreads();
        const int j = jb * 2048 + F.tid * 4;
        f32x4 acc0 = {0, 0, 0, 0}, acc1 = {0, 0, 0, 0}, acc2 = {0, 0, 0, 0};
        const GAS float* wp = (const GAS float*)wmod + ((size_t)l * DM + kc * 32) * 12288 + j;
#pragma unroll 8
        for (int kk = 0; kk < 32; ++kk) { const f32x4 w = *(const GAS f32x4*)(wp + (size_t)kk * 12288); acc0 += sv[kk] * w; acc1 += sv[64 + kk] * w; acc2 += sv[128 + kk] * w; }
        float* o = MODP + ((size_t)(l * 64 + kc) * 3) * 12288 + j;
        *(f32x4*)(o) = acc0; *(f32x4*)(o + 12288) = acc1; *(f32x4*)(o + 2 * 12288) = acc2;
        __syncthreads();
    }
}
__device__ __forceinline__ void ph_mod_reduce(const Args& a, Frame& F) {
    const GAS float* MODP = (const GAS float*)(F.ws + WS_MODP2); float* MOD = (float*)(F.ws + WS_MOD);
    const float* bmod = kin<I_BMOD>();
    for (int i = F.bid * 512 + F.tid; i < 2 * 3 * 12288; i += F.G * 512) {
        const int l = i / 36864, r = (i / 12288) % 3, j = i % 12288;
        float s = bmod[l * 12288 + j];
#pragma unroll 16
        for (int kc = 0; kc < 64; ++kc) s += MODP[((size_t)(l * 64 + kc) * 3 + r) * 12288 + j];
        MOD[i] = s;
    }
}

__device__ __forceinline__ void cvt_item(const float* S, size_t P, int k0, int c0, int ncol_valid, unsigned short* D, int K, int n0, float* scr_, int lane) {
    LAS float* scr = (LAS float*)scr_;
    { const int col = c0 + (lane & 31); const bool ok = col < ncol_valid; const GAS float* sp = (const GAS float*)(S + (size_t)(k0 + (lane >> 5)) * P + col); float v[32];
#pragma unroll
      for (int i = 0; i < 32; ++i) v[i] = ok ? sp[(size_t)(2 * i) * P] : 0.f;
#pragma unroll
      for (int i = 0; i < 32; ++i) scr[(2 * i + (lane >> 5)) * 33 + (lane & 31)] = v[i]; }
    LDS_WAIT(); asm volatile("" ::: "memory");
    const int c = lane & 7;
#pragma unroll
    for (int j = 0; j < 4; ++j) { const int n = (lane >> 3) + 8 * j; const LAS float* s = scr + (8 * c) * 33 + n;
        v4u o; o.x = pk2(s[0 * 33], s[1 * 33]); o.y = pk2(s[2 * 33], s[3 * 33]); o.z = pk2(s[4 * 33], s[5 * 33]); o.w = pk2(s[6 * 33], s[7 * 33]);
        *(GAS v4u*)(D + (size_t)(n0 + n) * K + k0 + 8 * c) = o; }
    LDS_WAIT(); asm volatile("" ::: "memory");
}
constexpr int CV_I0 = 32 * 432, CV_I1 = 16 * 128, CV_I2 = 16 * 64, CV_I3 = 16 * 64, CV_I4 = 32 * 64, CV_I5 = 32 * 32 * 16, CV_I6 = 32 * 4 * 64;
constexpr int CV_MRG0 = CV_I0, CV_MOE0 = CV_I0 + CV_I1 + CV_I2 + CV_I3 + CV_I4, CV_NIT = CV_MOE0 + CV_I5 + CV_I6;
__device__ __forceinline__ void ph_convert_range(const Args& a, Frame& F, int l, int it0, int it1, int wi, int nw) {
    float* scr = (float*)(F.lds + F.wave * 16384);
    constexpr int I0 = CV_I0, I1 = CV_I1, I2 = CV_I2, I3 = CV_I3, I4 = CV_I4, I5 = CV_I5;
    unsigned short* ws16 = (unsigned short*)F.ws;
    for (int it = it0 + wi; it < it1; it += nw) {
        int r = it;
        if (r < I0) { const int kb = r / 432, nb = r % 432; cvt_item(kin<I_WIN>() + (size_t)l * DM * INW, INW, kb * 64, nb * 32, INW, (unsigned short*)(F.ws + WS_WIN), LDU, nb * 32, scr, F.lane); continue; } r -= I0;
        if (r < I1) { const int kb = r / 128, nb = r % 128, n0 = nb * 32, pn = n0 >> 8, h = (n0 & 255) >> 7, i0 = n0 & 127;
            cvt_item(kin<I_S5GLU>() + (size_t)l * 1024 * 4096, 4096, kb * 64, h * 2048 + pn * 128 + i0, 4096, (unsigned short*)(F.ws + WS_WGLU), 1024, n0, scr, F.lane); continue; } r -= I1;
        if (r < I2) { const int kb = r / 64, nb = r % 64; cvt_item(kin<I_RWPROJ>() + (size_t)l * 1024 * DM, DM, kb * 64, nb * 32, DM, (unsigned short*)(F.ws + WS_WRW), 1024, nb * 32, scr, F.lane); continue; } r -= I2;
        if (r < I3) { const int kb = r / 64, nb = r % 64; cvt_item(kin<I_GLPROJ>() + (size_t)l * 1024 * DM, DM, kb * 64, nb * 32, DM, (unsigned short*)(F.ws + WS_WGL), 1024, nb * 32, scr, F.lane); continue; } r -= I3;
        if (r < I4) { const int kb = r / 64, nb = r % 64; cvt_item(kin<I_WOUT>() + (size_t)l * DM * DM, DM, kb * 64, nb * 32, DM, (unsigned short*)(F.ws + WS_WOUT), DM, nb * 32, scr, F.lane); continue; } r -= I4;
        if (r < I5) { const int e = r / 512, q = r % 512, kb = q / 16, nb = q % 16, n0 = nb * 32, j = n0 >> 8, h = (n0 & 255) >> 7, i0 = n0 & 127;
            const float* S = (h ? kin<I_MWUP>() : kin<I_MWGATE>()) + (size_t)(l * 32 + e) * DM * 256;
            cvt_item(S, 256, kb * 64, j * 128 + i0, 256, (unsigned short*)(F.ws + WS_WGU) + (size_t)e * 512 * DM, DM, n0, scr, F.lane); continue; } r -= I5;
        { const int e = r / 256, q = r % 256, kb = q / 64, nb = q % 64;
            cvt_item(kin<I_MWDOWN>() + (size_t)(l * 32 + e) * 256 * DM, DM, kb * 64, nb * 32, DM, (unsigned short*)(F.ws + WS_WDN) + (size_t)e * DM * 256, 256, nb * 32, scr, F.lane); }
    }
    (void)ws16;
}
__device__ __forceinline__ void ph_convert(const Args& a, Frame& F, int l, int it0 = 0) { ph_convert_range(a, F, l, it0, CV_NIT, F.bid * NWAVES + F.wave, F.G * NWAVES); }

__device__ __forceinline__ void ph_rowpass(const Args& a, Frame& F, int l, int mode, int combine, int nrows, int nrows_comb) {
    const int gw = F.bid * NWAVES + F.wave, NGW = F.G * NWAVES;
    float* X = (float*)(F.ws + WS_X); unsigned short* U = (unsigned short*)(F.ws + WS_U);
    const float* MOD = (const float*)(F.ws + WS_MOD);
    const unsigned short* EO = (const unsigned short*)(F.ws + WS_EO);
    const int* SLOT = (const int*)(F.ws + WS_TAB + TB_SLOT); const float* RWT = (const float*)(F.ws + WS_TAB + TB_RWT);
    const float* g1base = kin<I_G1>(); const float* gfbase = kin<I_GFINAL>();
    for (int row = gw; row < nrows; row += NGW) {
        const int mr = row_modidx(row);
        f32x4 v[8]; float* xr = X + (size_t)row * DM + 4 * F.lane;
        const float* xin = (l == 0 && mode == 0) ? (row < MLAT ? kin<I_X>() + (size_t)row * DM : kin<I_CTX>() + (size_t)(row - MLAT) * DM) + 4 * F.lane : xr;
#pragma unroll
        for (int j = 0; j < 8; ++j) v[j] = *(const f32x4*)(xin + 256 * j);
        if (combine && row < nrows_comb) {
            const int* SEGp = (const int*)(F.ws + WS_TAB + TB_SEG) + (l - 1) * 40; const int* EXPERT = (const int*)(F.ws + WS_TAB + TB_EXPERT);
            const int s0 = SEGp[EXPERT[row * 2]] + SLOT[row * 2], s1 = SEGp[EXPERT[row * 2 + 1]] + SLOT[row * 2 + 1]; const float w0 = RWT[row * 2], w1 = RWT[row * 2 + 1];
            const float* g2 = MOD + ((size_t)((l - 1) * 3 + mr)) * 12288 + 5 * DM + 4 * F.lane;
            const unsigned short* e0 = EO + (size_t)s0 * DM + 4 * F.lane; const unsigned short* e1 = EO + (size_t)s1 * DM + 4 * F.lane;
            v2u p0[8], p1[8]; f32x4 gq[8];
#pragma unroll
            for (int j = 0; j < 8; ++j) { p0[j] = *(const GAS v2u*)((const GAS unsigned short*)e0 + 256 * j); p1[j] = *(const GAS v2u*)((const GAS unsigned short*)e1 + 256 * j); gq[j] = *(const GAS f32x4*)((const GAS float*)g2 + 256 * j); }
#pragma unroll
            for (int j = 0; j < 8; ++j) { const f32x4 g = gq[j];
                f32x4 m; m.x = w0 * bflo(p0[j].x) + w1 * bflo(p1[j].x); m.y = w0 * bfhi(p0[j].x) + w1 * bfhi(p1[j].x); m.z = w0 * bflo(p0[j].y) + w1 * bflo(p1[j].y); m.w = w0 * bfhi(p0[j].y) + w1 * bfhi(p1[j].y);
                v[j] += g * m; }
#pragma unroll
            for (int j = 0; j < 8; ++j) *(GAS f32x4*)((GAS float*)xr + 256 * j) = v[j];
        }
        float ss = 0.f;
#pragma unroll
        for (int j = 0; j < 8; ++j) ss += (v[j].x * v[j].x + v[j].y * v[j].y) + (v[j].z * v[j].z + v[j].w * v[j].w);
        ss = wave_sum(ss);
        const float rs = 1.0f / sqrtf(ss * (1.0f / DM) + 1e-6f);
        if (mode == 0) {
            const float* g1 = g1base + l * DM + 4 * F.lane;
            const float* sh = MOD + ((size_t)(l * 3 + mr)) * 12288 + 4 * F.lane; const float* sc = sh + DM;
            unsigned short* ur = U + (size_t)row * LDU + 4 * F.lane;
            f32x4 gg[8], ssv[8], ccv[8];
#pragma unroll
            for (int j = 0; j < 8; ++j) { gg[j] = *(const GAS f32x4*)((const GAS float*)g1 + 256 * j); ssv[j] = *(const GAS f32x4*)((const GAS float*)sh + 256 * j); ccv[j] = *(const GAS f32x4*)((const GAS float*)sc + 256 * j); }
#pragma unroll
            for (int j = 0; j < 8; ++j) { const f32x4 y = (v[j] * rs * gg[j]) * (1.0f + ccv[j]) + ssv[j]; v2u o; o.x = pk2(y.x, y.y); o.y = pk2(y.z, y.w); *(GAS v2u*)((GAS unsigned short*)ur + 256 * j) = o; }
        } else {
            if (row < MLAT) { const float* gf = gfbase + 4 * F.lane; float* o = F.out + (size_t)row * DM + 4 * F.lane;
                f32x4 gg[8];
#pragma unroll
                for (int j = 0; j < 8; ++j) gg[j] = *(const GAS f32x4*)((const GAS float*)gf + 256 * j);
#pragma unroll
                for (int j = 0; j < 8; ++j) *(GAS f32x4*)((GAS float*)o + 256 * j) = v[j] * rs * gg[j]; }
        }
    }
}

struct S5P { f32x2 lb; f32x2 bb[16]; };
__device__ __forceinline__ void s5_params(const Args& a, int l, int d, int g, int p, S5P& P) {
    const int gi = (l * 2 + d) * 64 + g;
    const float are = kin<I_S5ARE>()[gi * 64 + p], aim = kin<I_S5AIM>()[gi * 64 + p], ldt = kin<I_S5LDT>()[gi];
    const float lre = fminf(are, -1e-4f), dt = expf(ldt);
    const float mag = expf(lre * dt), ang = aim * dt;
    float sn, cs; sincosf(ang, &sn, &cs);
    P.lb.x = mag * cs; P.lb.y = mag * sn;
    const float nr = P.lb.x - 1.0f, ni = P.lb.y, den = lre * lre + aim * aim;
    const float cr = (nr * lre + ni * aim) / den, ci = (ni * lre - nr * aim) / den;
    const float* bre = kin<I_S5BRE>() + ((size_t)gi * 64 + p) * 16; const float* bim = kin<I_S5BIM>() + ((size_t)gi * 64 + p) * 16;
#pragma unroll
    for (int i = 0; i < 16; ++i) { const float br = bre[i], bi = bim[i]; P.bb[i].x = cr * br - ci * bi; P.bb[i].y = cr * bi + ci * br; }
}
__device__ __forceinline__ void s5_load_u(const unsigned short* PROJ, int row, int g, float (&u)[16]) {
    const v4u* p = (const v4u*)(PROJ + (size_t)row * INP + C_S5 + g * 16);
    const v4u q0 = p[0], q1 = p[1];
    u[0] = bflo(q0.x); u[1] = bfhi(q0.x); u[2] = bflo(q0.y); u[3] = bfhi(q0.y); u[4] = bflo(q0.z); u[5] = bfhi(q0.z); u[6] = bflo(q0.w); u[7] = bfhi(q0.w);
    u[8] = bflo(q1.x); u[9] = bfhi(q1.x); u[10] = bflo(q1.y); u[11] = bfhi(q1.y); u[12] = bflo(q1.z); u[13] = bfhi(q1.z); u[14] = bflo(q1.w); u[15] = bfhi(q1.w);
}
__device__ __forceinline__ f32x2 s5_step(const S5P& P, f32x2 h, const float (&u)[16]) {
    float br = 0.f, bi = 0.f;
#pragma unroll
    for (int i = 0; i < 16; ++i) { br += P.bb[i].x * u[i]; bi += P.bb[i].y * u[i]; }
    f32x2 o; o.x = P.lb.x * h.x - P.lb.y * h.y + br; o.y = P.lb.x * h.y + P.lb.y * h.x + bi; return o;
}
__device__ __forceinline__ void s5_stage_u(const unsigned short* PROJ, int b, int d, int sc, int g, int lane, float* Ul) {
    float u[16]; s5_load_u(PROJ, seq_row(b, d, sc * 64 + lane), g, u);
    f32x4* o = (f32x4*)(Ul + lane * 16);
    o[0] = (f32x4){u[0], u[1], u[2], u[3]}; o[1] = (f32x4){u[4], u[5], u[6], u[7]}; o[2] = (f32x4){u[8], u[9], u[10], u[11]}; o[3] = (f32x4){u[12], u[13], u[14], u[15]};
    asm volatile("s_waitcnt lgkmcnt(0)" ::: "memory");
}
__device__ __forceinline__ void s5_read_u(const float* Ul, int i, float (&u)[16]) {
    const f32x4* p = (const f32x4*)(Ul + i * 16); const f32x4 a = p[0], b = p[1], c = p[2], d = p[3];
    u[0] = a.x; u[1] = a.y; u[2] = a.z; u[3] = a.w; u[4] = b.x; u[5] = b.y; u[6] = b.z; u[7] = b.w; u[8] = c.x; u[9] = c.y; u[10] = c.z; u[11] = c.w; u[12] = d.x; u[13] = d.y; u[14] = d.z; u[15] = d.w;
}
__device__ __forceinline__ void s5_local(const Args& a, Frame& F, int l, int wu, float* Ul) {
    const int d = wu / (2 * 64 * NSC), r1 = wu % (2 * 64 * NSC), b = r1 / (64 * NSC), r2 = r1 % (64 * NSC), g = r2 / NSC, sc = r2 % NSC;
    const unsigned short* PROJ = (const unsigned short*)(F.ws + WS_PROJ);
    S5P P; s5_params(a, l, d, g, F.lane, P);
    s5_stage_u(PROJ, b, d, sc, g, F.lane, Ul);
    f32x2 h = {0.f, 0.f};
#pragma unroll 4
    for (int i = 0; i < 64; ++i) { float u[16]; s5_read_u(Ul, i, u); h = s5_step(P, h, u); }
    f32x2* END = (f32x2*)(F.ws + WS_S5END);
    END[((size_t)((d * 2 + b) * 64 + g) * NSC + sc) * 64 + F.lane] = h;
    asm volatile("s_waitcnt lgkmcnt(0)" ::: "memory");
}

__device__ __forceinline__ float row16_sum(float v) { v += __shfl_xor(v, 1); v += __shfl_xor(v, 2); v += __shfl_xor(v, 4); v += __shfl_xor(v, 8); return v; }
__device__ __forceinline__ f32x4 mfma16b(v4u a_, v4u b_, f32x4 c_) { typedef short s8 __attribute__((ext_vector_type(8))); return __builtin_amdgcn_mfma_f32_16x16x32_bf16(__builtin_bit_cast(s8, a_), __builtin_bit_cast(s8, b_), c_, 0, 0, 0); }
struct RwLora { v4u w[4][2], a[4][2]; };
constexpr size_t TB_LORAW = 1280 * 1024, TB_LORAA = 1536 * 1024;
__device__ __forceinline__ void ph_lora_split(Frame& F, int l) {
    GAS unsigned short* FW = (GAS unsigned short*)(F.ws + WS_TAB + TB_LORAW); GAS unsigned short* FA = (GAS unsigned short*)(F.ws + WS_TAB + TB_LORAA);
    const GAS float* wp = (const GAS float*)kin<I_RWWUP>() + (size_t)(l * 2) * 64 * 1024; const GAS float* ap = (const GAS float*)kin<I_RWAUP>() + (size_t)(l * 2) * 64 * 1024;
    for (int i = F.bid * (NWAVES * 64) + F.tid; i < 2 * 64 * 1024; i += F.G * NWAVES * 64) { const int d = i >> 16, k = (i >> 10) & 63, c = i & 1023;
        const int head = c >> 6, ct = (c >> 4) & 3, l15 = c & 15, ks = k >> 5, q = (k >> 3) & 3, e = k & 7;
        const int fo = (((((d * 16 + head) * 4 + ct) * 2 + ks) * 64) + q * 16 + l15) * 8 + e;
        FW[fo] = (unsigned short)f2bf(wp[i]); FA[fo] = (unsigned short)f2bf(ap[i]); }
}
__device__ __forceinline__ void rwkv_lora_frags(Frame& F, int l, int d, int ch, RwLora& B) {
    const GAS unsigned short* FW = (const GAS unsigned short*)(F.ws + WS_TAB + TB_LORAW) + (size_t)((d * 16 + ch * 8 + F.wave) * 8) * 512 + F.lane * 8;
    const GAS unsigned short* FA = (const GAS unsigned short*)(F.ws + WS_TAB + TB_LORAA) + (size_t)((d * 16 + ch * 8 + F.wave) * 8) * 512 + F.lane * 8;
#pragma unroll
    for (int ct = 0; ct < 4; ++ct)
#pragma unroll
        for (int ks = 0; ks < 2; ++ks) { B.w[ct][ks] = *(const GAS v4u*)(FW + (ct * 2 + ks) * 512); B.a[ct][ks] = *(const GAS v4u*)(FA + (ct * 2 + ks) * 512); }
}
template <int VAR> __device__ __forceinline__ void rwkv_prep_unit(Frame& F, int l, int d, int ch, int tb, const RwLora& B) {
    const unsigned short* PROJ = (const unsigned short*)(F.ws + WS_PROJ);
    unsigned short* PREP = (unsigned short*)(F.ws + WS_PREP); float* BON = (float*)(F.ws + WS_BONUS);
    unsigned short* lora = (unsigned short*)F.lds;
    unsigned short* zs = (unsigned short*)(F.lds + 16384);
    const float* mu = kin<I_RWMU>() + (size_t)(l * 2 + d) * 3200;
    const int row0 = tb * 32;
#pragma unroll 1
    for (int i = 0; i < 13; ++i) { const int p = F.tid + 512 * i; if (p < 34 * 3 * 64) { const int rr = p / 192, qq = p % 192, seg = qq >> 6, pc = qq & 63; int row = row0 - 1 + rr; row = row < 0 ? 0 : (row >= MROWS ? MROWS - 1 : row);
        __builtin_amdgcn_global_load_lds((const GAS unsigned*)(PROJ + (size_t)row * INP + C_RW + seg * 1024 + ch * 512 + pc * 8), (LAS unsigned*)((LAS unsigned char*)zs + (size_t)(p - F.lane) * 16), 16, 0, 0); } }
    {   const int rr = F.tid >> 4, j0 = (F.tid & 15) * 8, row = row0 + rr, pr = prev_row(row, d);
        const v4u z = *(const v4u*)(PROJ + (size_t)row * INP + C_RW + 3072 + j0);
        v4u zp = {0u, 0u, 0u, 0u}; if (pr >= 0) zp = *(const v4u*)(PROJ + (size_t)pr * INP + C_RW + 3072 + j0);
        const unsigned zw[4] = {z.x, z.y, z.z, z.w}, pw[4] = {zp.x, zp.y, zp.z, zp.w}; float o[8];
#pragma unroll
        for (int e = 0; e < 8; ++e) { const float zv = (e & 1) ? bfhi(zw[e >> 1]) : bflo(zw[e >> 1]), pv = (e & 1) ? bfhi(pw[e >> 1]) : bflo(pw[e >> 1]);
            float zz = zv + (pv - zv) * mu[3072 + j0 + e]; if (j0 + e < 64) zz = 1.0f - 2.0f * __builtin_amdgcn_rcpf(1.0f + __expf(2.0f * zz)); o[e] = zz; }
        *(v4u*)(lora + rr * 136 + j0) = (v4u){pk2(o[0], o[1]), pk2(o[2], o[3]), pk2(o[4], o[5]), pk2(o[6], o[7])}; }
    const int lane = F.lane, l15 = lane & 15, q = lane >> 4, h = ch * 8 + F.wave;
    float w0[4], a0[4], mur[4], muk[4], muv[4], kkw[4], kaw[4], rkw[4];
#pragma unroll
    for (int ct = 0; ct < 4; ++ct) { const int c = h * 64 + 16 * ct + l15;
        w0[ct] = ((const GAS float*)kin<I_RWW0>())[(l * 2 + d) * 1024 + c]; a0[ct] = ((const GAS float*)kin<I_RWA0>())[(l * 2 + d) * 1024 + c]; mur[ct] = ((const GAS float*)mu)[c]; muk[ct] = ((const GAS float*)mu)[1024 + c]; muv[ct] = ((const GAS float*)mu)[2048 + c];
        kkw[ct] = ((const GAS float*)kin<I_RWKK>())[l * 1024 + c]; kaw[ct] = ((const GAS float*)kin<I_RWKA>())[l * 1024 + c]; rkw[ct] = ((const GAS float*)kin<I_RWRK>())[l * 1024 + c]; }
    __syncthreads();
#pragma unroll 1
    for (int rt = 0; rt < 2; ++rt) {
        f32x4 accw[4], acca[4];
        { v4u af[4];
#pragma unroll
          for (int ks = 0; ks < 4; ++ks) af[ks] = *(const v4u*)(lora + (16 * rt + l15) * 136 + 32 * ks + 8 * q);
#pragma unroll
          for (int ct = 0; ct < 4; ++ct) { f32x4 w_ = {0.f, 0.f, 0.f, 0.f}, a_ = w_;
              w_ = mfma16b(af[0], B.w[ct][0], w_); w_ = mfma16b(af[1], B.w[ct][1], w_); a_ = mfma16b(af[2], B.a[ct][0], a_); a_ = mfma16b(af[3], B.a[ct][1], a_);
              accw[ct] = w_; acca[ct] = a_; } }
#pragma unroll
        for (int jj = 0; jj < 4; ++jj) { asm volatile("" ::: "memory"); const int rr = 16 * rt + 4 * q + jj, row = row0 + rr, pr = prev_row(row, d);
            float r[4], k[4], v[4], lw[4], av[4], kkc[4], ss = 0.f;
#pragma unroll
            for (int ct = 0; ct < 4; ++ct) { const int cl = F.wave * 64 + 16 * ct + l15; const unsigned short* zr = zs + ((rr + 1) * 3) * 512 + cl;
                float r_ = bf2f(zr[0]), k_ = bf2f(zr[512]), v_ = bf2f(zr[1024]), rp = 0.f, kp = 0.f, vp = 0.f;
                if (pr >= 0) { const unsigned short* zq = zs + ((pr - row0 + 1) * 3) * 512 + cl; rp = bf2f(zq[0]); kp = bf2f(zq[512]); vp = bf2f(zq[1024]); }
                r[ct] = r_ + (rp - r_) * mur[ct]; k[ct] = k_ + (kp - k_) * muk[ct]; v[ct] = v_ + (vp - v_) * muv[ct];
                lw[ct] = -0.606531f * sigmoidf_(w0[ct] + accw[ct][jj]); av[ct] = sigmoidf_(a0[ct] + acca[ct][jj]);
                kkc[ct] = k[ct] * kkw[ct]; ss += kkc[ct] * kkc[ct]; }
            ss = row16_sum(ss); const float inv = 1.0f / fmaxf(sqrtf(ss), 1e-12f);
            float bon = 0.f; unsigned short hr[4], hk[4], hw[4], hkk[4], hka[4], hv[4];
#pragma unroll
            for (int ct = 0; ct < 4; ++ct) { const float kk = kkc[ct] * inv, kq = k[ct] * (1.0f + (av[ct] - 1.0f) * kaw[ct]); bon += r[ct] * kq * rkw[ct];
                hr[ct] = f2h(r[ct]); hk[ct] = f2h(kq); hw[ct] = f2h(lw[ct]); hkk[ct] = f2h(kk); hka[ct] = f2h(kk * av[ct]); hv[ct] = f2h(v[ct]); }
#define PK4(hh) ((v2u){(unsigned)hh[0] | ((unsigned)hh[1] << 16), (unsigned)hh[2] | ((unsigned)hh[3] << 16)})
            { GAS v2u* o8 = (GAS v2u*)(PREP + (((size_t)d * MROWS + row) * 16 + h) * 384) + l15; o8[0] = PK4(hr); o8[16] = PK4(hk); o8[32] = PK4(hw); o8[48] = PK4(hkk); o8[64] = PK4(hka); o8[80] = PK4(hv); }
#undef PK4
            bon = row16_sum(bon);
            if (l15 == 0) BON[((size_t)d * MROWS + row) * 16 + h] = bon; } }
    __syncthreads();
}

constexpr int RW_SB = 32, RW_SP = 392, RW_NBT = (CTXL + SEQL) / RW_SB;
__device__ __forceinline__ void rwkv_stage(const unsigned short* PREP, const float* BON, float* buf, int b, int d, int h, int bt, int slot, int j) {
#pragma unroll
    for (int i = 0; i < 12; ++i) {
        const int q = j + 256 * i, s = q / 96, e4 = q % 96, sc = bt * RW_SB + s, row = seq_row(b, d, sc);
        const v2u w = *(const v2u*)(PREP + (((size_t)d * MROWS + row) * 16 + h) * 384 + e4 * 4);
        f32x4 o; o.x = h2f((unsigned short)(w.x & 0xffff)); o.y = h2f((unsigned short)(w.x >> 16)); o.z = h2f((unsigned short)(w.y & 0xffff)); o.w = h2f((unsigned short)(w.y >> 16));
        *(f32x4*)(buf + (size_t)(slot * RW_SB + s) * RW_SP + e4 * 4) = o;
    }
    if (j < RW_SB) { const int row = seq_row(b, d, bt * RW_SB + j); buf[(size_t)(slot * RW_SB + j) * RW_SP + 384] = BON[((size_t)d * MROWS + row) * 16 + h]; }
}
__device__ __forceinline__ void rwkv_scan_chain(const Args& a, Frame& F, int ci) {
    const int d = ci >> 5, b = (ci >> 4) & 1, h = ci & 15;
    float* buf = (float*)F.lds;
    const unsigned short* PREP = (const unsigned short*)(F.ws + WS_PREP); const float* BON = (const float*)(F.ws + WS_BONUS);
    unsigned short* YB = (unsigned short*)(F.ws + WS_YB);
    const bool scanner = F.tid < 256; const int r = F.tid >> 2, part = F.tid & 3, j = F.tid - 256;
    f32x4 st[4];
#pragma unroll
    for (int i = 0; i < 4; ++i) st[i] = (f32x4){0.f, 0.f, 0.f, 0.f};
    if (!scanner) rwkv_stage(PREP, BON, buf, b, d, h, 0, 0, j);
    __syncthreads();
    for (int bt = 0; bt < RW_NBT; ++bt) {
        const int slot = bt & 1;
        if (!scanner) { if (bt + 1 < RW_NBT) rwkv_stage(PREP, BON, buf, b, d, h, bt + 1, slot ^ 1, j); }
        else {
            for (int s = 0; s < RW_SB; ++s) {
                const float* base = buf + (size_t)(slot * RW_SB + s) * RW_SP;
                const f32x4* rv = (const f32x4*)(base + part * 16); const f32x4* kp = (const f32x4*)(base + 64 + part * 16); const f32x4* wv = (const f32x4*)(base + 128 + part * 16);
                const f32x4* kk = (const f32x4*)(base + 192 + part * 16); const f32x4* ka = (const f32x4*)(base + 256 + part * 16);
                const float v = base[320 + r], bon = base[384];
                f32x4 t = st[0] * kk[0]; t += st[1] * kk[1]; t += st[2] * kk[2]; t += st[3] * kk[3];
                float sa = (t.x + t.y) + (t.z + t.w); sa = quad_sum(sa);
                f32x4 y4 = {0.f, 0.f, 0.f, 0.f};
#pragma unroll
                for (int i = 0; i < 4; ++i) { st[i] = st[i] * wv[i] + (v * kp[i] - sa * ka[i]); y4 += st[i] * rv[i]; }
                float y = (y4.x + y4.y) + (y4.z + y4.w); y = quad_sum(y);
                if (part == 0) { const int row = seq_row(b, d, bt * RW_SB + s); YB[((size_t)d * MROWS + row) * 1024 + h * 64 + r] = (unsigned short)f2bf(y + bon * v); }
            }
        }
        __syncthreads();
    }
}

__device__ __forceinline__ f32x4 mfma16(bf16x8 a_, bf16x8 b_, f32x4 c_) { return __builtin_amdgcn_mfma_f32_16x16x32_bf16(a_, b_, c_, 0, 0, 0); }
__device__ __forceinline__ void gla_unit(const Args& a, Frame& F, int l, int unit) {
    const int d = unit >> 5, b = (unit >> 4) & 1, h = (unit >> 2) & 3, dvs = unit & 3;
    const unsigned short* PROJ = (const unsigned short*)(F.ws + WS_PROJ);
    unsigned short* OG = (unsigned short*)(F.ws + WS_OG) + (size_t)d * MROWS * 1024;
    unsigned short* qe = (unsigned short*)F.lds;
    unsigned short* ke = qe + 64 * 136;
    unsigned short* qb = ke + 64 * 136;
    unsigned short* kdT = qb + 64 * 136;
    unsigned short* vT = kdT + 128 * 72;
    unsigned short* Pm = vT + 64 * 72;
    unsigned short* ST16 = Pm + 64 * 72;
    float* tot = (float*)(ST16 + 64 * 136);
    float* la32 = tot + 512;
    float* decv = la32 + 128;
    float* gkl = decv + 128;
    int* rowi = (int*)(gkl + 1024);
    const int tid = F.tid, lane = F.lane, w = F.wave, l15 = lane & 15, quad = lane >> 4;
    const int dk = tid & 127, cg = tid >> 7;
    float gup[16];
#pragma unroll
    for (int j = 0; j < 16; ++j) gup[j] = kin<I_GLGKUP>()[((size_t)(l * 2 + d) * 16 + j) * 512 + h * 128 + dk];
    const float gbias = kin<I_GLGKB>()[(l * 2 + d) * 512 + h * 128 + dk];
    const float scale = 0.08838834764831845f;
    for (int i = tid; i < 64 * 136 / 2; i += 512) ((unsigned*)ST16)[i] = 0u;
    f32x4 sacc[4];
#pragma unroll
    for (int i = 0; i < 4; ++i) sacc[i] = (f32x4){0.f, 0.f, 0.f, 0.f};
    for (int ch = 0; ch < NSC; ++ch) {
        if (tid < 64) rowi[tid] = gla_row(b, d, ch * 64 + tid);
        __syncthreads();
        if (tid < 128) { const int c = tid >> 1, hf = tid & 1; const v4u z = *(const v4u*)(PROJ + (size_t)rowi[c] * INP + C_GK + hf * 8); float* o = gkl + c * 16 + hf * 8;
            o[0] = bflo(z.x); o[1] = bfhi(z.x); o[2] = bflo(z.y); o[3] = bfhi(z.y); o[4] = bflo(z.z); o[5] = bfhi(z.z); o[6] = bflo(z.w); o[7] = bfhi(z.w); }
        { const int dv = tid & 63, cgv = tid >> 6; unsigned short vv[8];
#pragma unroll
          for (int e = 0; e < 8; ++e) vv[e] = PROJ[(size_t)rowi[cgv * 8 + e] * INP + C_V + h * 256 + dvs * 64 + dv];
          v4u o; o.x = vv[0] | ((unsigned)vv[1] << 16); o.y = vv[2] | ((unsigned)vv[3] << 16); o.z = vv[4] | ((unsigned)vv[5] << 16); o.w = vv[6] | ((unsigned)vv[7] << 16);
          *(v4u*)(vT + dv * 72 + cgv * 8) = o; }
        __syncthreads();
        float bl[16]; float run = 0.f;
#pragma unroll
        for (int e = 0; e < 16; ++e) { const f32x4* gp = (const f32x4*)(gkl + (cg * 16 + e) * 16); float x = gbias;
#pragma unroll
            for (int j = 0; j < 4; ++j) { const f32x4 g4 = gp[j]; x += g4.x * gup[4 * j] + g4.y * gup[4 * j + 1] + g4.z * gup[4 * j + 2] + g4.w * gup[4 * j + 3]; }
            const float la = (fminf(x, 0.f) - log1pf(expf(-fabsf(x)))) * (1.0f / 16.0f);
            if (e == 0 && cg == 2) la32[dk] = la;
            run += la; bl[e] = run; }
        tot[cg * 128 + dk] = run;
        __syncthreads();
        { const float t0 = tot[dk], t1 = tot[128 + dk], t2 = tot[256 + dk], t3 = tot[384 + dk];
          const float off = cg == 0 ? 0.f : (cg == 1 ? t0 : (cg == 2 ? t0 + t1 : t0 + t1 + t2));
          const float bref = t0 + t1 + la32[dk], blast = (t0 + t1) + (t2 + t3);
          unsigned short kdv[16];
#pragma unroll
          for (int e = 0; e < 16; ++e) { const int c = cg * 16 + e; const float bb = off + bl[e];
              const unsigned short* pr = PROJ + (size_t)rowi[c] * INP + h * 128 + dk;
              const float q = bf2f(pr[C_Q]) * scale, k = bf2f(pr[C_K]);
              qe[c * 136 + dk] = (unsigned short)f2bf(q * expf(bb - bref)); ke[c * 136 + dk] = (unsigned short)f2bf(k * expf(bref - bb));
              qb[c * 136 + dk] = (unsigned short)f2bf(q * expf(bb)); kdv[e] = (unsigned short)f2bf(k * expf(blast - bb)); }
          v4u o0, o1; o0.x = kdv[0] | ((unsigned)kdv[1] << 16); o0.y = kdv[2] | ((unsigned)kdv[3] << 16); o0.z = kdv[4] | ((unsigned)kdv[5] << 16); o0.w = kdv[6] | ((unsigned)kdv[7] << 16);
          o1.x = kdv[8] | ((unsigned)kdv[9] << 16); o1.y = kdv[10] | ((unsigned)kdv[11] << 16); o1.z = kdv[12] | ((unsigned)kdv[13] << 16); o1.w = kdv[14] | ((unsigned)kdv[15] << 16);
          *(v4u*)(kdT + dk * 72 + cg * 16) = o0; *(v4u*)(kdT + dk * 72 + cg * 16 + 8) = o1;
          if (cg == 0) decv[dk] = expf(blast); }
        __syncthreads();
#pragma unroll
        for (int tt = 0; tt < 2; ++tt) { const int t = 2 * w + tt, ti = t >> 2, tj = t & 3; f32x4 acc = {0.f, 0.f, 0.f, 0.f};
            if (tj <= ti) {
#pragma unroll
                for (int kb = 0; kb < 4; ++kb) { const bf16x8 af = *(const bf16x8*)(qe + (16 * ti + l15) * 136 + kb * 32 + quad * 8), bfr = *(const bf16x8*)(ke + (16 * tj + l15) * 136 + kb * 32 + quad * 8);
                    acc = mfma16(af, bfr, acc); } }
            const int m = 16 * tj + l15;
#pragma unroll
            for (int jj = 0; jj < 4; ++jj) { const int c = 16 * ti + quad * 4 + jj; Pm[c * 72 + m] = (m <= c) ? (unsigned short)f2bf(acc[jj]) : (unsigned short)0; } }
        __syncthreads();
#pragma unroll
        for (int tt = 0; tt < 2; ++tt) { const int t = 2 * w + tt, tdv = t >> 2, tc = t & 3; f32x4 acc = {0.f, 0.f, 0.f, 0.f};
#pragma unroll
            for (int kb = 0; kb < 2; ++kb) { const bf16x8 af = *(const bf16x8*)(vT + (16 * tdv + l15) * 72 + kb * 32 + quad * 8), bfr = *(const bf16x8*)(Pm + (16 * tc + l15) * 72 + kb * 32 + quad * 8); acc = mfma16(af, bfr, acc); }
#pragma unroll
            for (int kb = 0; kb < 4; ++kb) { const bf16x8 af = *(const bf16x8*)(ST16 + (16 * tdv + l15) * 136 + kb * 32 + quad * 8), bfr = *(const bf16x8*)(qb + (16 * tc + l15) * 136 + kb * 32 + quad * 8); acc = mfma16(af, bfr, acc); }
            const int c = 16 * tc + l15, dv0 = 16 * tdv + quad * 4;
            v2u o; o.x = pk2(acc[0], acc[1]); o.y = pk2(acc[2], acc[3]);
            *(v2u*)(OG + (size_t)rowi[c] * 1024 + h * 256 + dvs * 64 + dv0) = o; }
        __syncthreads();
        { const float dec = decv[16 * w + l15];
#pragma unroll
          for (int tdv = 0; tdv < 4; ++tdv) { f32x4 acc = sacc[tdv] * dec;
#pragma unroll
              for (int kb = 0; kb < 2; ++kb) { const bf16x8 af = *(const bf16x8*)(vT + (16 * tdv + l15) * 72 + kb * 32 + quad * 8), bfr = *(const bf16x8*)(kdT + (16 * w + l15) * 72 + kb * 32 + quad * 8); acc = mfma16(af, bfr, acc); }
              sacc[tdv] = acc;
#pragma unroll
              for (int jj = 0; jj < 4; ++jj) ST16[(16 * tdv + quad * 4 + jj) * 136 + 16 * w + l15] = (unsigned short)f2bf(acc[jj]); } }
        __syncthreads();
    }
}

__device__ __forceinline__ float gelu_tanh(float x) { const float t = 0.7978845608028654f * (x + 0.044715f * x * x * x); return x * (1.0f - __builtin_amdgcn_rcpf(1.0f + __expf(2.0f * t))); }
__device__ __forceinline__ void s5_final(const Args& a, Frame& F, int l, int wu, unsigned short* Hb, float* Ul) {
    const int b = wu / (64 * NSC), r0 = wu % (64 * NSC), g = r0 / NSC, tcx = r0 % NSC;
    const bool isctx = tcx < 4; const int tc = isctx ? tcx : tcx - 4;
    const unsigned short* PROJ = (const unsigned short*)(F.ws + WS_PROJ);
    const f32x2* END = (const f32x2*)(F.ws + WS_S5END);
    const int lane = F.lane, l15 = lane & 15, quad = lane >> 4;
    f32x4 acc[4];
#pragma unroll
    for (int i = 0; i < 4; ++i) acc[i] = (f32x4){0.f, 0.f, 0.f, 0.f};
#pragma unroll
    for (int dd = 0; dd < 2; ++dd) {
        S5P P; s5_params(a, l, dd, g, lane, P);
        const int scx = dd == 0 ? tcx : (isctx ? 3 - tc : 4 + 63 - tc);
        s5_stage_u(PROJ, b, dd, scx, g, lane, Ul);
        f32x2 lamL = P.lb;
#pragma unroll
        for (int i = 0; i < 6; ++i) { f32x2 t; t.x = lamL.x * lamL.x - lamL.y * lamL.y; t.y = 2.0f * lamL.x * lamL.y; lamL = t; }
        f32x2 hcur = {0.f, 0.f};
        const f32x2* ep = END + ((size_t)((dd * 2 + b) * 64 + g) * NSC) * 64 + lane;
        for (int s0 = 0; s0 < scx; s0 += 4) {
            f32x2 e[4];
#pragma unroll
            for (int k = 0; k < 4; ++k) e[k] = (s0 + k < scx) ? ep[(size_t)(s0 + k) * 64] : (f32x2){0.f, 0.f};
#pragma unroll
            for (int k = 0; k < 4; ++k) if (s0 + k < scx) { f32x2 t; t.x = lamL.x * hcur.x - lamL.y * hcur.y + e[k].x; t.y = lamL.x * hcur.y + lamL.y * hcur.x + e[k].y; hcur = t; } }
        bf16x8 cf[4];
        { const int gi = (l * 2 + dd) * 64 + g;
          const float* cre = kin<I_S5CRE>() + ((size_t)gi * 16 + l15) * 64; const float* cim = kin<I_S5CIM>() + ((size_t)gi * 16 + l15) * 64;
#pragma unroll
          for (int kb = 0; kb < 4; ++kb) { const int k0 = kb * 32 + quad * 8; const float* src = k0 < 64 ? cre + k0 : cim + (k0 - 64); const float sg = k0 < 64 ? 1.f : -1.f;
              const f32x4 x0 = *(const f32x4*)src, x1 = *(const f32x4*)(src + 4);
              cf[kb][0] = (short)f2bf(sg * x0.x); cf[kb][1] = (short)f2bf(sg * x0.y); cf[kb][2] = (short)f2bf(sg * x0.z); cf[kb][3] = (short)f2bf(sg * x0.w);
              cf[kb][4] = (short)f2bf(sg * x1.x); cf[kb][5] = (short)f2bf(sg * x1.y); cf[kb][6] = (short)f2bf(sg * x1.z); cf[kb][7] = (short)f2bf(sg * x1.w); } }
#pragma unroll
        for (int half = 0; half < 2; ++half) {
#pragma unroll 4
            for (int i = 32 * half; i < 32 * half + 32; ++i) { float u[16]; s5_read_u(Ul, i, u); hcur = s5_step(P, hcur, u);
                const int tl = dd ? 63 - i : i; Hb[(tl & 31) * 136 + lane] = (unsigned short)f2bf(hcur.x); Hb[(tl & 31) * 136 + 64 + lane] = (unsigned short)f2bf(hcur.y); }
            asm volatile("s_waitcnt lgkmcnt(0)" ::: "memory");
            const int tbase = (dd ? 1 - half : half) * 2;
#pragma unroll
            for (int t2 = 0; t2 < 2; ++t2)
#pragma unroll
                for (int kb = 0; kb < 4; ++kb) { const bf16x8 hf = *(const bf16x8*)(Hb + (16 * t2 + l15) * 136 + kb * 32 + quad * 8);
                    if (tbase == 0) acc[t2] = mfma16(cf[kb], hf, acc[t2]); else acc[2 + t2] = mfma16(cf[kb], hf, acc[2 + t2]); }
            asm volatile("s_waitcnt lgkmcnt(0)" ::: "memory");
        }
    }
    unsigned short* ZA = (unsigned short*)(F.ws + WS_ZA);
    const f32x4 dvec = *(const f32x4*)(kin<I_S5D>() + l * 1024 + g * 16 + quad * 4);
#pragma unroll
    for (int tt = 0; tt < 4; ++tt) { const int tl = 16 * tt + l15; const int row = isctx ? MLAT + b * CTXL + tc * 64 + tl : b * SEQL + tc * 64 + tl;
        const v2u uu = *(const v2u*)(PROJ + (size_t)row * INP + C_S5 + g * 16 + quad * 4);
        const float z0 = gelu_tanh(acc[tt][0] + dvec.x * bflo(uu.x)), z1 = gelu_tanh(acc[tt][1] + dvec.y * bfhi(uu.x)), z2 = gelu_tanh(acc[tt][2] + dvec.z * bflo(uu.y)), z3 = gelu_tanh(acc[tt][3] + dvec.w * bfhi(uu.y));
        v2u o; o.x = pk2(z0, z1); o.y = pk2(z2, z3); *(v2u*)(ZA + (size_t)row * 1024 + g * 16 + quad * 4) = o; }
}

struct ZbGate { v4u g[4][4]; };
constexpr size_t TB_GATEF = 1792 * 1024;
__device__ __forceinline__ void ph_gate_split(Frame& F, int l) {
    GAS unsigned short* FG = (GAS unsigned short*)(F.ws + WS_TAB + TB_GATEF); const GAS float* gp = (const GAS float*)kin<I_RWGUP>() + (size_t)l * 128 * 1024;
    for (int i = F.bid * (NWAVES * 64) + F.tid; i < 128 * 1024; i += F.G * NWAVES * 64) { const int k = i >> 10, c = i & 1023;
        const int head = c >> 6, ct = (c >> 4) & 3, l15 = c & 15, ks = k >> 5, q = (k >> 3) & 3, e = k & 7;
        FG[((((head * 4 + ct) * 4 + ks) * 64) + q * 16 + l15) * 8 + e] = (unsigned short)f2bf(gp[i]); }
}
__device__ __forceinline__ void zb_gate_frags(Frame& F, int l, int ch, ZbGate& B) {
    const GAS unsigned short* FG = (const GAS unsigned short*)(F.ws + WS_TAB + TB_GATEF) + (size_t)((ch * 8 + F.wave) * 16) * 512 + F.lane * 8;
#pragma unroll
    for (int ct = 0; ct < 4; ++ct)
#pragma unroll
        for (int ks = 0; ks < 4; ++ks) B.g[ct][ks] = *(const GAS v4u*)(FG + (ct * 4 + ks) * 512);
}
__device__ __forceinline__ void zb_unit(Frame& F, int l, int ch, int tb, const ZbGate& B) {
    const int row0 = tb * 32;
    const unsigned short* PROJ = (const unsigned short*)(F.ws + WS_PROJ);
    const unsigned short* YB = (const unsigned short*)(F.ws + WS_YB); unsigned short* ZB = (unsigned short*)(F.ws + WS_ZB);
    unsigned short* sg = (unsigned short*)F.lds;
    { const int rr = F.tid >> 4, j0 = (F.tid & 15) * 8; const v4u z = *(const v4u*)(PROJ + (size_t)(row0 + rr) * INP + C_GLO + j0);
      *(v4u*)(sg + rr * 136 + j0) = (v4u){pk2(sigmoidf_(bflo(z.x)), sigmoidf_(bfhi(z.x))), pk2(sigmoidf_(bflo(z.y)), sigmoidf_(bfhi(z.y))), pk2(sigmoidf_(bflo(z.z)), sigmoidf_(bfhi(z.z))), pk2(sigmoidf_(bflo(z.w)), sigmoidf_(bfhi(z.w)))}; }
    const int lane = F.lane, l15 = lane & 15, q = lane >> 4, h = ch * 8 + F.wave;
    float lnw[4], lnb[4];
#pragma unroll
    for (int ct = 0; ct < 4; ++ct) { const int c = h * 64 + 16 * ct + l15; lnw[ct] = ((const GAS float*)kin<I_RWLNW>())[l * 1024 + c]; lnb[ct] = ((const GAS float*)kin<I_RWLNB>())[l * 1024 + c]; }
    unsigned short yraw[2][2][4][4];
#define ZB_YLOAD(rt_) do { _Pragma("unroll") for (int jj = 0; jj < 4; ++jj) { _Pragma("unroll") for (int ct = 0; ct < 4; ++ct) { const int row = row0 + 16 * (rt_) + 4 * q + jj, c = h * 64 + 16 * ct + l15; \
        yraw[rt_][0][jj][ct] = ((const GAS unsigned short*)YB)[(size_t)row * 1024 + c]; yraw[rt_][1][jj][ct] = ((const GAS unsigned short*)YB)[((size_t)MROWS + row) * 1024 + c]; } } } while (0)
    ZB_YLOAD(0);
    __syncthreads();
#pragma unroll
    for (int rt = 0; rt < 2; ++rt) { v4u af[4]; f32x4 gate[4];
#pragma unroll
        for (int ks = 0; ks < 4; ++ks) af[ks] = *(const v4u*)(sg + (16 * rt + l15) * 136 + 32 * ks + 8 * q);
#pragma unroll
        for (int ct = 0; ct < 4; ++ct) { f32x4 g_ = {0.f, 0.f, 0.f, 0.f};
#pragma unroll
            for (int ks = 0; ks < 4; ++ks) g_ = mfma16b(af[ks], B.g[ct][ks], g_);
            gate[ct] = g_; }
        float yv[4][4];
#pragma unroll
        for (int jj = 0; jj < 4; ++jj)
#pragma unroll
            for (int ct = 0; ct < 4; ++ct) yv[jj][ct] = bf2f(yraw[rt][0][jj][ct]) + bf2f(yraw[rt][1][jj][ct]);
        if (rt == 0) ZB_YLOAD(1);
#pragma unroll
        for (int jj = 0; jj < 4; ++jj) { const int row = row0 + 16 * rt + 4 * q + jj; float y[4], s = 0.f;
#pragma unroll
            for (int ct = 0; ct < 4; ++ct) { y[ct] = yv[jj][ct]; s += y[ct]; }
            const float mean = row16_sum(s) * (1.0f / 64.0f); float vs = 0.f;
#pragma unroll
            for (int ct = 0; ct < 4; ++ct) { y[ct] -= mean; vs += y[ct] * y[ct]; }
            const float rstd = 1.0f / sqrtf(row16_sum(vs) * (1.0f / 64.0f) + 64e-5f);
#pragma unroll
            for (int ct = 0; ct < 4; ++ct) ZB[(size_t)row * 1024 + h * 64 + 16 * ct + l15] = (unsigned short)f2bf((y[ct] * rstd * lnw[ct] + lnb[ct]) * gate[ct][jj]); } }
    __syncthreads();
}
struct ZcIn { v2u p0[4], p1[4], g[4]; };
__device__ __forceinline__ void zc_load(Frame& F, int row, ZcIn& I) {
    const GAS unsigned short* O0 = (const GAS unsigned short*)(F.ws + WS_OG) + (size_t)row * 1024 + 4 * F.lane; const GAS unsigned short* O1 = O0 + (size_t)MROWS * 1024;
    const GAS unsigned short* og = (const GAS unsigned short*)(F.ws + WS_PROJ) + (size_t)row * INP + C_OG + 4 * F.lane;
#pragma unroll
    for (int j = 0; j < 4; ++j) { I.p0[j] = *(const GAS v2u*)(O0 + 256 * j); I.p1[j] = *(const GAS v2u*)(O1 + 256 * j); I.g[j] = *(const GAS v2u*)(og + 256 * j); }
}
struct ZcPar { f32x4 n4[4]; };
__device__ __forceinline__ void zc_params(Frame& F, int l, ZcPar& P) { const GAS float* ng = (const GAS float*)kin<I_GLNG>() + l * 1024 + 4 * F.lane;
#pragma unroll
    for (int j = 0; j < 4; ++j) P.n4[j] = *(const GAS f32x4*)(ng + 256 * j); }
__device__ __forceinline__ void zc_finish(Frame& F, int l, int row, const ZcIn& I, const ZcPar& P) {
    GAS unsigned short* ZC = (GAS unsigned short*)(F.ws + WS_ZC) + (size_t)row * 1024 + 4 * F.lane;
#pragma unroll
    for (int j = 0; j < 4; ++j) { const v2u p0 = I.p0[j], p1 = I.p1[j], g = I.g[j]; const f32x4 n4 = P.n4[j];
        const float o0 = bflo(p0.x) + bflo(p1.x), o1 = bfhi(p0.x) + bfhi(p1.x), o2 = bflo(p0.y) + bflo(p1.y), o3 = bfhi(p0.y) + bfhi(p1.y);
        const float ss = wave_sum((o0 * o0 + o1 * o1) + (o2 * o2 + o3 * o3)); const float rs = 1.0f / sqrtf(ss * (1.0f / 256.0f) + 1e-6f);
        v2u o; o.x = pk2(o0 * rs * n4.x * siluf_(bflo(g.x)), o1 * rs * n4.y * siluf_(bfhi(g.x))); o.y = pk2(o2 * rs * n4.z * siluf_(bflo(g.y)), o3 * rs * n4.w * siluf_(bfhi(g.y)));
        *(GAS v2u*)(ZC + 256 * j) = o; }
}
__device__ __forceinline__ void zc_row(const Args& a, Frame& F, int l, int row) { ZcIn I; ZcPar P; zc_params(F, l, P); zc_load(F, row, I); zc_finish(F, l, row, I, P); }

#define LBAR() do { asm volatile("s_waitcnt lgkmcnt(0)" ::: "memory"); __builtin_amdgcn_s_barrier(); asm volatile("" ::: "memory"); } while (0)

constexpr int RC_A1 = 0, RC_R = 2048, RC_KD = 4096, RC_NB = 6144, RC_V = 8192, RC_A2 = 10240, RC_F = 10752, RC_NE = 11264, RC_GC = 11776, RC_BON = 12032, RC_BYTES = 12288;
constexpr int RW_NCH = (CTXL + SEQL) / 16;
constexpr int RW_NH = RW_NCH;
constexpr int CP_NAT = 72, CP_TR = 16, CP_TT = 20;
constexpr int CP_BYTES = 4 * 16 * CP_NAT * 2 + 3 * 64 * CP_TR * 2 + 16 * 16 * 4 + 16 * CP_TT * 2 + 2 * 64 * 4;
typedef unsigned short bf16x4u __attribute__((ext_vector_type(4)));
__device__ __forceinline__ GAS unsigned char* rec_addr(unsigned char* base0, long sstep, int o) { return (GAS unsigned char*)(base0 + (long)(o / 768) * sstep + (o % 768)); }
__device__ __forceinline__ bf16x8 frag_lo(v2u lo) { v4u t; t.x = lo.x; t.y = lo.y; t.z = 0u; t.w = 0u; return __builtin_bit_cast(bf16x8, t); }
__device__ __forceinline__ v2u cvt4(f32x4 v) { v2u r; r.x = pk2(v[0], v[1]); r.y = pk2(v[2], v[3]); return r; }
__device__ __forceinline__ bf16x8 frag2(f32x4 a0, f32x4 a1) { v4u t; t.x = pk2(a0[0], a0[1]); t.y = pk2(a0[2], a0[3]); t.z = pk2(a1[0], a1[1]); t.w = pk2(a1[2], a1[3]); return __builtin_bit_cast(bf16x8, t); }

__device__ __forceinline__ void rwkv_chunk_prep(Frame& F, int wu, unsigned char* scr) {
    const int chain = wu / RW_NCH, ci = wu % RW_NCH, d = chain >> 5, b = (chain >> 4) & 1, h = chain & 15;
    const int lane = F.lane, l15 = lane & 15, q = lane >> 4;
    const int row0 = seq_row(b, d, 16 * ci); const long sstep = d ? -12288 : 12288;
    unsigned char* base0 = F.ws + WS_PREP + (((size_t)d * MROWS + row0) * 16 + h) * 768;
    const float* BON = (const float*)(F.ws + WS_BONUS);
    unsigned short* nK = (unsigned short*)scr;
    unsigned short* nA = nK + 16 * CP_NAT; unsigned short* nk = nA + 16 * CP_NAT; unsigned short* nR = nk + 16 * CP_NAT;
    unsigned short* tK = nR + 16 * CP_NAT;
    unsigned short* tB = tK + 64 * CP_TR; unsigned short* tD = tB + 64 * CP_TR;
    float* Gl = (float*)(tD + 64 * CP_TR);
    unsigned short* Tl = (unsigned short*)(Gl + 256);
    float* eref = (float*)(Tl + 16 * CP_TT); float* gCv = eref + 64;
    float vr[16], vk[16], vw[16], vkk[16], vka[16];
    const int pl = (lane & 15) * 4 + (lane >> 4);
#pragma unroll
    for (int t = 0; t < 16; ++t) { const GAS unsigned short* p = (const GAS unsigned short*)(base0 + t * sstep) + pl;
        vr[t] = h2f(p[0]); vk[t] = h2f(p[64]); vw[t] = h2f(p[128]); vkk[t] = h2f(p[192]); vka[t] = h2f(p[256]); }
    v2u vfr[4];
#pragma unroll
    for (int vt = 0; vt < 4; ++vt) { float x[4];
#pragma unroll
        for (int jj = 0; jj < 4; ++jj) x[jj] = h2f(((const GAS unsigned short*)(base0 + (4 * q + jj) * sstep))[320 + 4 * l15 + vt]);
        vfr[vt].x = pk2(x[0], x[1]); vfr[vt].y = pk2(x[2], x[3]); }
    float bonv = 0.f; if (lane < 16) bonv = ((const GAS float*)BON)[((size_t)d * MROWS + (row0 + (d ? -lane : lane))) * 16 + h];
    asm volatile("s_waitcnt vmcnt(0)" ::: "memory");
    float lg[16]; { float run = 0.f;
#pragma unroll
        for (int t = 0; t < 16; ++t) { run += vw[t]; lg[t] = run; } }
    const float ref = lg[7], lgC = lg[15];
    eref[lane] = __expf(ref); gCv[lane] = __expf(lgC);
    { unsigned short a1[16], a2[16], a3[16];
#pragma unroll
      for (int t = 0; t < 16; ++t) { const float lm1 = t ? lg[t - 1] : 0.f;
          const float em = __expf(lm1 - ref), ep = __expf(ref - lg[t]), er = __expf(lg[t] - ref), gm = __expf(lm1), ec = __expf(lgC - lg[t]);
          nK[t * CP_NAT + lane] = (unsigned short)f2bf(vkk[t] * em); nA[t * CP_NAT + lane] = (unsigned short)f2bf(vka[t] * ep);
          nk[t * CP_NAT + lane] = (unsigned short)f2bf(vk[t] * ep); nR[t * CP_NAT + lane] = (unsigned short)f2bf(vr[t] * er);
          a1[t] = (unsigned short)f2bf(vkk[t] * gm); a2[t] = (unsigned short)f2bf(-(vka[t] * ec)); a3[t] = (unsigned short)f2bf(vk[t] * ec); }
#pragma unroll
      for (int g4 = 0; g4 < 4; ++g4) { v2u w1, w2, w3;
          w1.x = a1[4 * g4] | ((unsigned)a1[4 * g4 + 1] << 16); w1.y = a1[4 * g4 + 2] | ((unsigned)a1[4 * g4 + 3] << 16);
          w2.x = a2[4 * g4] | ((unsigned)a2[4 * g4 + 1] << 16); w2.y = a2[4 * g4 + 2] | ((unsigned)a2[4 * g4 + 3] << 16);
          w3.x = a3[4 * g4] | ((unsigned)a3[4 * g4 + 1] << 16); w3.y = a3[4 * g4 + 2] | ((unsigned)a3[4 * g4 + 3] << 16);
          *(v2u*)(tK + lane * CP_TR + 4 * g4) = w1; *(v2u*)(tB + lane * CP_TR + 4 * g4) = w2; *(v2u*)(tD + lane * CP_TR + 4 * g4) = w3; } }
    asm volatile("s_waitcnt lgkmcnt(0)" ::: "memory");
    f32x4 Gt = {0.f, 0.f, 0.f, 0.f}, Ht = Gt, ETt = Gt, FTt = Gt;
#pragma unroll
    for (int ks = 0; ks < 2; ++ks) { const int off = l15 * CP_NAT + ks * 32 + q * 8;
        const bf16x8 fK = *(const bf16x8*)(nK + off), fA = *(const bf16x8*)(nA + off), fk = *(const bf16x8*)(nk + off), fR = *(const bf16x8*)(nR + off);
        Gt = mfma16(fK, fA, Gt); Ht = mfma16(fK, fk, Ht); ETt = mfma16(fA, fR, ETt); FTt = mfma16(fk, fR, FTt); }
#pragma unroll
    for (int jj = 0; jj < 4; ++jj) { const int rowi = 4 * q + jj;
        if (!(l15 < rowi)) { Gt[jj] = 0.f; Ht[jj] = 0.f; }
        if (!(rowi <= l15)) { ETt[jj] = 0.f; FTt[jj] = 0.f; }
        Gl[rowi * 16 + l15] = Gt[jj]; }
    asm volatile("s_waitcnt lgkmcnt(0)" ::: "memory");
    { float Tc[16]; const int c = l15;
#pragma unroll
      for (int j = 0; j < 16; ++j) { float acc = (j == c) ? 1.f : 0.f; const f32x4* gr = (const f32x4*)(Gl + j * 16);
#pragma unroll
          for (int s4 = 0; s4 < 4; ++s4) { if (4 * s4 < j) { const f32x4 g = gr[s4];
#pragma unroll
              for (int e = 0; e < 4; ++e) if (4 * s4 + e < j) acc -= g[e] * Tc[4 * s4 + e]; } }
          Tc[j] = acc; if (q == 0) Tl[j * CP_TT + c] = (unsigned short)f2bf(acc); } }
    asm volatile("s_waitcnt lgkmcnt(0)" ::: "memory");
    const bf16x8 Tf = frag_lo(*(const v2u*)(Tl + l15 * CP_TT + 4 * q));
    f32x4 A1T[4];
#pragma unroll
    for (int kt = 0; kt < 4; ++kt) { const bf16x8 af = frag_lo(*(const v2u*)(tK + (16 * kt + l15) * CP_TR + 4 * q)); A1T[kt] = mfma16(af, Tf, (f32x4){0.f, 0.f, 0.f, 0.f}); }
    const f32x4 A2T = mfma16(frag_lo(cvt4(Ht)), Tf, (f32x4){0.f, 0.f, 0.f, 0.f});
    asm volatile("" ::: "memory");
#pragma unroll
    for (int ks = 0; ks < 2; ++ks) {
        *(GAS bf16x8*)rec_addr(base0, sstep, RC_A1 + ks * 1024 + lane * 16) = frag2(A1T[2 * ks], A1T[2 * ks + 1]);
        const v2u r0 = *(const v2u*)(nR + l15 * CP_NAT + 32 * ks + 4 * q), r1 = *(const v2u*)(nR + l15 * CP_NAT + 32 * ks + 16 + 4 * q);
        const f32x4 e0 = *(const f32x4*)(eref + 32 * ks + 4 * q), e1 = *(const f32x4*)(eref + 32 * ks + 16 + 4 * q);
        v4u o; o.x = pk2(bflo(r0.x) * e0.x, bfhi(r0.x) * e0.y); o.y = pk2(bflo(r0.y) * e0.z, bfhi(r0.y) * e0.w); o.z = pk2(bflo(r1.x) * e1.x, bfhi(r1.x) * e1.y); o.w = pk2(bflo(r1.y) * e1.z, bfhi(r1.y) * e1.w);
        *(GAS v4u*)rec_addr(base0, sstep, RC_R + ks * 1024 + lane * 16) = o; }
#pragma unroll
    for (int kt = 0; kt < 4; ++kt) {
        *(GAS v2u*)rec_addr(base0, sstep, RC_KD + kt * 512 + lane * 8) = *(const v2u*)(tD + (16 * kt + l15) * CP_TR + 4 * q);
        *(GAS v2u*)rec_addr(base0, sstep, RC_NB + kt * 512 + lane * 8) = *(const v2u*)(tB + (16 * kt + l15) * CP_TR + 4 * q);
        *(GAS v2u*)rec_addr(base0, sstep, RC_V + kt * 512 + lane * 8) = vfr[kt]; }
    *(GAS v2u*)rec_addr(base0, sstep, RC_A2 + lane * 8) = cvt4(A2T);
    *(GAS v2u*)rec_addr(base0, sstep, RC_F + lane * 8) = cvt4(FTt);
    { f32x4 ne = {-ETt[0], -ETt[1], -ETt[2], -ETt[3]}; *(GAS v2u*)rec_addr(base0, sstep, RC_NE + lane * 8) = cvt4(ne); }
    *(GAS float*)rec_addr(base0, sstep, RC_GC + lane * 4) = gCv[lane];
    if (lane < 16) *(GAS float*)rec_addr(base0, sstep, RC_BON + lane * 4) = bonv;
    asm volatile("s_waitcnt lgkmcnt(0)" ::: "memory");
}

template <int VAR> __device__ __forceinline__ void rwkv_scan2(Frame& F, int chain, const unsigned* cp2, unsigned cp2_need) {
    const int d = chain >> 5, b = (chain >> 4) & 1, h = chain & 15;
    unsigned char* ring = F.lds; LAS unsigned char* ringl = (LAS unsigned char*)F.lds;
    unsigned short* YB = (unsigned short*)(F.ws + WS_YB) + (size_t)d * MROWS * 1024;
    const unsigned char* prep = F.ws + WS_PREP;
    const int lane = F.lane, l15 = lane & 15, q = lane >> 4, w = F.wave;
    const bool compute = w < 4; const int lt = F.tid - 256;
    constexpr int NT = (VAR == 2) ? 2 : 1;
    f32x4 ST[NT][4];
#pragma unroll
    for (int i = 0; i < NT; ++i)
#pragma unroll
        for (int k = 0; k < 4; ++k) ST[i][k] = (f32x4){0.f, 0.f, 0.f, 0.f};
    v4u rg[8][3];
#define RW_LOAD(set, cidx) do { const int row0_ = seq_row(b, d, 16 * (cidx)); const long ss_ = d ? -12288 : 12288; const unsigned char* b0_ = prep + (((size_t)d * MROWS + row0_) * 16 + h) * 768; \
        _Pragma("unroll") for (int i_ = 0; i_ < 3; ++i_) { const int p_ = lt + 256 * i_; rg[set][i_] = *(const GAS v4u*)(b0_ + (long)(p_ / 48) * ss_ + (p_ % 48) * 16); } } while (0)
#define RW_STORE(set, slot) do { _Pragma("unroll") for (int i_ = 0; i_ < 3; ++i_) *(LAS v4u*)(ringl + (slot) * RC_BYTES + (lt + 256 * i_) * 16) = rg[set][i_]; } while (0)
    if (!compute) {
        RW_LOAD(0, 0); RW_LOAD(1, 1); RW_LOAD(2, 2); RW_LOAD(3, 3); RW_LOAD(4, 4); RW_LOAD(5, 5); RW_LOAD(6, 6); RW_LOAD(7, 7); RW_STORE(0, 0); RW_LOAD(0, 8);
        LBAR();
        for (int cb = 0; cb < RW_NCH; cb += 8) {
#pragma unroll
            for (int u = 0; u < 8; ++u) { const int ci = cb + u;
                if (RW_NH < RW_NCH && ci + 9 == RW_NH) {
                    unsigned spins = 0; while ((unsigned)__builtin_amdgcn_readfirstlane((int)__hip_atomic_load(cp2, __ATOMIC_RELAXED, __HIP_MEMORY_SCOPE_AGENT)) < cp2_need && ++spins < (1u << 22)) __builtin_amdgcn_s_sleep(8);
                    __builtin_amdgcn_fence(__ATOMIC_ACQUIRE, "agent"); }
                if (ci + 1 < RW_NCH) { RW_STORE((u + 1) & 7, (ci + 1) & 1); if (ci + 9 < RW_NCH) RW_LOAD((u + 1) & 7, ci + 9); }
                LBAR(); }
        }
    } else if (w >= 4 / NT) {
        LBAR();
        for (int ci = 0; ci < RW_NCH; ++ci) LBAR();
    } else {
        __builtin_amdgcn_s_setprio(3);
        LBAR();
        for (int ci = 0; ci < RW_NCH; ++ci) {
                const unsigned char* rc = ring + (ci & 1) * RC_BYTES;
                const bf16x8 a10 = *(const bf16x8*)(rc + RC_A1 + lane * 16), a11 = *(const bf16x8*)(rc + RC_A1 + 1024 + lane * 16);
                const bf16x8 rr0 = *(const bf16x8*)(rc + RC_R + lane * 16), rr1 = *(const bf16x8*)(rc + RC_R + 1024 + lane * 16);
                const bf16x8 a2 = frag_lo(*(const v2u*)(rc + RC_A2 + lane * 8)), ff = frag_lo(*(const v2u*)(rc + RC_F + lane * 8)), ne = frag_lo(*(const v2u*)(rc + RC_NE + lane * 8));
                v2u vraw[NT]; bf16x8 Vf[NT], SAb[NT]; f32x4 Y[NT];
#pragma unroll
                for (int i = 0; i < NT; ++i) { vraw[i] = *(const v2u*)(rc + RC_V + (NT * w + i) * 512 + lane * 8); Vf[i] = frag_lo(vraw[i]); }
#pragma unroll
                for (int i = 0; i < NT; ++i) { const bf16x8 Bs0 = frag2(ST[i][0], ST[i][1]), Bs1 = frag2(ST[i][2], ST[i][3]);
                    f32x4 SA = mfma16(a10, Bs0, (f32x4){0.f, 0.f, 0.f, 0.f}); SA = mfma16(a11, Bs1, SA); SA = mfma16(a2, Vf[i], SA);
                    f32x4 y = {0.f, 0.f, 0.f, 0.f}; if (VAR != 1) { y = mfma16(rr0, Bs0, y); y = mfma16(rr1, Bs1, y); y = mfma16(ff, Vf[i], y); }
                    SAb[i] = frag_lo(cvt4(SA));
                    if (VAR != 1) y = mfma16(ne, SAb[i], y);
                    Y[i] = y; }
#pragma unroll
                for (int kt = 0; kt < 4; ++kt) { const f32x4 gc = *(const f32x4*)(rc + RC_GC + (16 * kt + 4 * q) * 4);
                    const bf16x8 kd = frag_lo(*(const v2u*)(rc + RC_KD + kt * 512 + lane * 8)), nb = frag_lo(*(const v2u*)(rc + RC_NB + kt * 512 + lane * 8));
#pragma unroll
                    for (int i = 0; i < NT; ++i) { f32x4 acc = ST[i][kt] * gc; acc = mfma16(kd, Vf[i], acc); acc = mfma16(nb, SAb[i], acc); ST[i][kt] = acc; } }
                const f32x4 bon = *(const f32x4*)(rc + RC_BON + 4 * q * 4);
                const int rowb = seq_row(b, d, 16 * ci + 4 * q); const int rs = d ? -1 : 1;
#pragma unroll
                for (int i = 0; i < NT; ++i) { const float v0 = bflo(vraw[i].x), v1 = bfhi(vraw[i].x), v2 = bflo(vraw[i].y), v3 = bfhi(vraw[i].y);
                    GAS unsigned short* yp = (GAS unsigned short*)(YB + (size_t)rowb * 1024 + h * 64 + 16 * (NT * w + i) + l15);
                    if (VAR != 1) { yp[0] = (unsigned short)f2bf(Y[i][0] + bon.x * v0); yp[(long)rs * 1024] = (unsigned short)f2bf(Y[i][1] + bon.y * v1);
                        yp[(long)rs * 2048] = (unsigned short)f2bf(Y[i][2] + bon.z * v2); yp[(long)rs * 3072] = (unsigned short)f2bf(Y[i][3] + bon.w * v3); } }
                LBAR();
        }
    }
    __builtin_amdgcn_s_setprio(0);
    __syncthreads();
#undef RW_LOAD
#undef RW_STORE
}

constexpr int RX_WAVE = 2560, RX_OFF = 3 * RC_BYTES;
__device__ __forceinline__ void rwkv_scan3(Frame& F, int chain) {
    const int d = chain >> 5, b = (chain >> 4) & 1, h = chain & 15;
    unsigned char* ring = F.lds; LAS unsigned char* ringl = (LAS unsigned char*)F.lds;
    unsigned short* YB = (unsigned short*)(F.ws + WS_YB) + (size_t)d * MROWS * 1024;
    const unsigned char* prep = F.ws + WS_PREP;
    const int lane = F.lane, l15 = lane & 15, q = lane >> 4, w = F.wave, j = w & 3;
    const bool compute = w < 4; const int lt = F.tid - 256;
#define RW_LOAD(set, cidx) do { const int row0_ = seq_row(b, d, 16 * (cidx)); const long ss_ = d ? -12288 : 12288; const unsigned char* b0_ = prep + (((size_t)d * MROWS + row0_) * 16 + h) * 768; \
        _Pragma("unroll") for (int i_ = 0; i_ < 3; ++i_) { const int p_ = lt + 256 * i_; rg[set][i_] = *(const GAS v4u*)(b0_ + (long)(p_ / 48) * ss_ + (p_ % 48) * 16); } } while (0)
#define RW_STORE(set, slot) do { _Pragma("unroll") for (int i_ = 0; i_ < 3; ++i_) *(LAS v4u*)(ringl + (slot) * RC_BYTES + (lt + 256 * i_) * 16) = rg[set][i_]; } while (0)
#define RW_OUT(c, s3) do { const unsigned char* rc_ = ring + (s3) * RC_BYTES; const unsigned char* x_ = ring + RX_OFF + ((((c) & 1) * 4 + j) * RX_WAVE); \
        const bf16x8 Bs0_ = *(const bf16x8*)(x_ + lane * 16), Bs1_ = *(const bf16x8*)(x_ + 1024 + lane * 16), SAb_ = frag_lo(*(const v2u*)(x_ + 2048 + lane * 8)); \
        const bf16x8 rr0_ = *(const bf16x8*)(rc_ + RC_R + lane * 16), rr1_ = *(const bf16x8*)(rc_ + RC_R + 1024 + lane * 16); const v2u vraw_ = *(const v2u*)(rc_ + RC_V + j * 512 + lane * 8); \
        const bf16x8 Vf_ = frag_lo(vraw_), ff_ = frag_lo(*(const v2u*)(rc_ + RC_F + lane * 8)), ne_ = frag_lo(*(const v2u*)(rc_ + RC_NE + lane * 8)); const f32x4 bon_ = *(const f32x4*)(rc_ + RC_BON + 4 * q * 4); \
        f32x4 Y_ = mfma16(rr0_, Bs0_, (f32x4){0.f, 0.f, 0.f, 0.f}); Y_ = mfma16(rr1_, Bs1_, Y_); Y_ = mfma16(ff_, Vf_, Y_); Y_ = mfma16(ne_, SAb_, Y_); \
        const int rowb_ = seq_row(b, d, 16 * (c) + 4 * q); const int rs_ = d ? -1 : 1; GAS unsigned short* yp_ = (GAS unsigned short*)(YB + (size_t)rowb_ * 1024 + h * 64 + 16 * j + l15); \
        yp_[0] = (unsigned short)f2bf(Y_[0] + bon_.x * bflo(vraw_.x)); yp_[(long)rs_ * 1024] = (unsigned short)f2bf(Y_[1] + bon_.y * bfhi(vraw_.x)); \
        yp_[(long)rs_ * 2048] = (unsigned short)f2bf(Y_[2] + bon_.z * bflo(vraw_.y)); yp_[(long)rs_ * 3072] = (unsigned short)f2bf(Y_[3] + bon_.w * bfhi(vraw_.y)); } while (0)
    if (!compute) {
        v4u rg[8][3];
        RW_LOAD(0, 0); RW_LOAD(1, 1); RW_LOAD(2, 2); RW_LOAD(3, 3); RW_LOAD(4, 4); RW_LOAD(5, 5); RW_LOAD(6, 6); RW_LOAD(7, 7); RW_STORE(0, 0); RW_LOAD(0, 8);
        LBAR();
        int s1 = 1, sm = 2;
        for (int cb = 0; cb < RW_NCH; cb += 8) {
#pragma unroll
            for (int u = 0; u < 8; ++u) { const int ci = cb + u;
                if (ci + 1 < RW_NCH) { RW_STORE((u + 1) & 7, s1); if (ci + 9 < RW_NCH) RW_LOAD((u + 1) & 7, ci + 9); }
                if (ci >= 1) RW_OUT(ci - 1, sm);
                s1 = s1 == 2 ? 0 : s1 + 1; sm = sm == 2 ? 0 : sm + 1;
                LBAR(); }
        }
        RW_OUT(RW_NCH - 1, sm);
    } else {
        f32x4 ST[4];
#pragma unroll
        for (int i = 0; i < 4; ++i) ST[i] = (f32x4){0.f, 0.f, 0.f, 0.f};
        LBAR();
        int s0 = 0;
        for (int ci = 0; ci < RW_NCH; ++ci) {
            const unsigned char* rc = ring + s0 * RC_BYTES; unsigned char* x = ring + RX_OFF + (((ci & 1) * 4 + j) * RX_WAVE);
            const bf16x8 a10 = *(const bf16x8*)(rc + RC_A1 + lane * 16), a11 = *(const bf16x8*)(rc + RC_A1 + 1024 + lane * 16);
            const v2u vraw = *(const v2u*)(rc + RC_V + j * 512 + lane * 8);
            const bf16x8 Vf = frag_lo(vraw), a2 = frag_lo(*(const v2u*)(rc + RC_A2 + lane * 8));
            const bf16x8 Bs0 = frag2(ST[0], ST[1]), Bs1 = frag2(ST[2], ST[3]);
            *(bf16x8*)(x + lane * 16) = Bs0; *(bf16x8*)(x + 1024 + lane * 16) = Bs1;
            f32x4 SA = mfma16(a2, Vf, (f32x4){0.f, 0.f, 0.f, 0.f}); SA = mfma16(a10, Bs0, SA); SA = mfma16(a11, Bs1, SA);
            f32x4 nst[4];
#pragma unroll
            for (int kt = 0; kt < 4; ++kt) { const f32x4 gc = *(const f32x4*)(rc + RC_GC + (16 * kt + 4 * q) * 4);
                nst[kt] = mfma16(frag_lo(*(const v2u*)(rc + RC_KD + kt * 512 + lane * 8)), Vf, ST[kt] * gc); }
            const v2u sab = cvt4(SA); *(v2u*)(x + 2048 + lane * 8) = sab; const bf16x8 SAb = frag_lo(sab);
#pragma unroll
            for (int kt = 0; kt < 4; ++kt) ST[kt] = mfma16(frag_lo(*(const v2u*)(rc + RC_NB + kt * 512 + lane * 8)), SAb, nst[kt]);
            s0 = s0 == 2 ? 0 : s0 + 1;
            LBAR();
        }
    }
    __syncthreads();
#undef RW_LOAD
#undef RW_STORE
#undef RW_OUT
}

constexpr int GOP_P = 0, GOP_QB = 8192, GOP_KD = 24576, GOP_DEC = 40960, GOP_SZ = 41472;
struct GlaGk { float gup[16]; float gbias; int key; };
struct GlaPre { v4u lq[2], lk[2], lv[4], gk; };
__device__ __forceinline__ void gla_prep_load(Frame& F, int unit, GlaPre& P) {
    const int ch = unit % NSC, r1 = unit / NSC, h = r1 & 3, b = (r1 >> 2) & 1, d = r1 >> 3, tid = F.tid;
    const GAS unsigned short* PROJ = (const GAS unsigned short*)(F.ws + WS_PROJ);
#pragma unroll
    for (int i = 0; i < 2; ++i) { const int p = tid + 512 * i, c = p >> 4, pc = p & 15; const GAS unsigned short* src = PROJ + (size_t)gla_row(b, d, ch * 64 + c) * INP + h * 128 + pc * 8;
        P.lq[i] = *(const GAS v4u*)(src + C_Q); P.lk[i] = *(const GAS v4u*)(src + C_K); }
#pragma unroll
    for (int i = 0; i < 4; ++i) { const int p = tid + 512 * i, c = p >> 5, pc = p & 31; P.lv[i] = *(const GAS v4u*)(PROJ + (size_t)gla_row(b, d, ch * 64 + c) * INP + C_V + h * 256 + pc * 8); }
    P.gk = (v4u){0u, 0u, 0u, 0u}; if (tid < 128) { const int c = tid >> 1, hf = tid & 1; P.gk = *(const GAS v4u*)(PROJ + (size_t)gla_row(b, d, ch * 64 + c) * INP + C_GK + hf * 8); }
}
__device__ __forceinline__ void gla_prep_unit(const Args& a, Frame& F, int l, int unit, GlaGk& G, GlaPre& P, int next_unit) {
    const int ch = unit % NSC, r1 = unit / NSC, h = r1 & 3, b = (r1 >> 2) & 1, d = r1 >> 3;
    const unsigned short* PROJ = (const unsigned short*)(F.ws + WS_PROJ);
    unsigned char* gop = F.ws + WS_GLA + (size_t)unit * GOP_SZ;
    unsigned short* gvt = (unsigned short*)(F.ws + WS_MB) + (size_t)unit * (256 * 64);
    unsigned short* qx = (unsigned short*)F.lds;
    unsigned short* kx = qx + 64 * 136;
    unsigned short* qb = kx + 64 * 136;
    unsigned short* kdT = qb + 64 * 136;
    unsigned short* Pm = kdT + 128 * 72;
    unsigned short* vTL = Pm + 64 * 72;
    float* tot = (float*)(vTL + 256 * 72);
    float* la32 = tot + 512; float* decv = la32 + 128; float* gkl = decv + 128;
    int* rowi = (int*)(gkl + 1024);
    const int tid = F.tid, lane = F.lane, w = F.wave, l15 = lane & 15, quad = lane >> 4;
    const int dk = tid & 127, cg = tid >> 7;
    if (G.key != d * 4 + h) { G.key = d * 4 + h;
      const GAS float* gp = (const GAS float*)kin<I_GLGKUP>() + ((size_t)(l * 2 + d) * 16) * 512 + h * 128 + dk;
#pragma unroll
      for (int j = 0; j < 16; ++j) G.gup[j] = gp[(size_t)j * 512];
      G.gbias = ((const GAS float*)kin<I_GLGKB>())[(l * 2 + d) * 512 + h * 128 + dk]; }
    const float (&gup)[16] = G.gup; const float gbias = G.gbias;
    const float scale = 0.08838834764831845f;
    if (tid < 128) { const int c = tid >> 1, hf = tid & 1; const v4u z = P.gk; float* o = gkl + c * 16 + hf * 8;
        o[0] = bflo(z.x); o[1] = bfhi(z.x); o[2] = bflo(z.y); o[3] = bfhi(z.y); o[4] = bflo(z.z); o[5] = bfhi(z.z); o[6] = bflo(z.w); o[7] = bfhi(z.w); }
    {
#pragma unroll
      for (int i = 0; i < 2; ++i) { const int p = tid + 512 * i, c = p >> 4, pc = p & 15; *(v4u*)(qx + c * 136 + pc * 8) = P.lq[i]; *(v4u*)(kx + c * 136 + pc * 8) = P.lk[i]; }
#pragma unroll
    for (int i = 0; i < 4; ++i) { const int p = tid + 512 * i, c = p >> 5, pc = p & 31; const v4u z = P.lv[i];
        unsigned short* o = vTL + (pc * 8) * 72 + c;
        o[0] = (unsigned short)(z.x & 0xffff); o[72] = (unsigned short)(z.x >> 16); o[144] = (unsigned short)(z.y & 0xffff); o[216] = (unsigned short)(z.y >> 16);
        o[288] = (unsigned short)(z.z & 0xffff); o[360] = (unsigned short)(z.z >> 16); o[432] = (unsigned short)(z.w & 0xffff); o[504] = (unsigned short)(z.w >> 16); } }
    if (next_unit >= 0) gla_prep_load(F, next_unit, P);
    __syncthreads();
    float bl[16]; float run = 0.f;
#pragma unroll
    for (int eb = 0; eb < 16; eb += 2) { f32x4 g4[2][4];
#pragma unroll
        for (int ee = 0; ee < 2; ++ee)
#pragma unroll
            for (int j = 0; j < 4; ++j) g4[ee][j] = *(const LAS f32x4*)((const LAS float*)gkl + (cg * 16 + eb + ee) * 16 + 4 * j);
#pragma unroll
        for (int ee = 0; ee < 2; ++ee) { const int e = eb + ee; float x = gbias;
#pragma unroll
            for (int j = 0; j < 4; ++j) x += g4[ee][j].x * gup[4 * j] + g4[ee][j].y * gup[4 * j + 1] + g4[ee][j].z * gup[4 * j + 2] + g4[ee][j].w * gup[4 * j + 3];
            const float la = (fminf(x, 0.f) - __logf(1.0f + __expf(-fabsf(x)))) * (1.0f / 16.0f);
            if (e == 0 && cg == 2) la32[dk] = la;
            run += la; bl[e] = run; } }
    tot[cg * 128 + dk] = run;
    __syncthreads();
    { const float t0 = tot[dk], t1 = tot[128 + dk], t2 = tot[256 + dk], t3 = tot[384 + dk];
      const float off = cg == 0 ? 0.f : (cg == 1 ? t0 : (cg == 2 ? t0 + t1 : t0 + t1 + t2));
      const float bref = t0 + t1 + la32[dk], blast = (t0 + t1) + (t2 + t3);
      unsigned short kdv[16];
#pragma unroll
      for (int e = 0; e < 16; ++e) { const int c = cg * 16 + e; const float bb = off + bl[e];
          const float q = bf2f(qx[c * 136 + dk]) * scale, k = bf2f(kx[c * 136 + dk]);
          qx[c * 136 + dk] = (unsigned short)f2bf(q * __expf(bb - bref)); kx[c * 136 + dk] = (unsigned short)f2bf(k * __expf(bref - bb));
          qb[c * 136 + dk] = (unsigned short)f2bf(q * __expf(bb)); kdv[e] = (unsigned short)f2bf(k * __expf(blast - bb)); }
      v4u o0, o1; o0.x = kdv[0] | ((unsigned)kdv[1] << 16); o0.y = kdv[2] | ((unsigned)kdv[3] << 16); o0.z = kdv[4] | ((unsigned)kdv[5] << 16); o0.w = kdv[6] | ((unsigned)kdv[7] << 16);
      o1.x = kdv[8] | ((unsigned)kdv[9] << 16); o1.y = kdv[10] | ((unsigned)kdv[11] << 16); o1.z = kdv[12] | ((unsigned)kdv[13] << 16); o1.w = kdv[14] | ((unsigned)kdv[15] << 16);
      *(v4u*)(kdT + dk * 72 + cg * 16) = o0; *(v4u*)(kdT + dk * 72 + cg * 16 + 8) = o1;
      if (cg == 0) decv[dk] = __expf(blast); }
    __syncthreads();
#pragma unroll
    for (int tt = 0; tt < 2; ++tt) { const int t = 2 * w + tt, ti = t >> 2, tj = t & 3; f32x4 acc = {0.f, 0.f, 0.f, 0.f};
        if (tj <= ti) {
#pragma unroll
            for (int kb = 0; kb < 4; ++kb) { const bf16x8 af = *(const bf16x8*)(qx + (16 * ti + l15) * 136 + kb * 32 + quad * 8), bfr = *(const bf16x8*)(kx + (16 * tj + l15) * 136 + kb * 32 + quad * 8);
                acc = mfma16(af, bfr, acc); } }
        const int m = 16 * tj + l15;
#pragma unroll
        for (int jj = 0; jj < 4; ++jj) { const int c = 16 * ti + quad * 4 + jj; Pm[c * 72 + m] = (m <= c) ? (unsigned short)f2bf(acc[jj]) : (unsigned short)0; } }
    __syncthreads();
    { const int c = tid >> 3, pc = tid & 7; *(v4u*)(gop + GOP_P + (c * 64 + pc * 8) * 2) = *(const v4u*)(Pm + c * 72 + pc * 8); }
#pragma unroll
    for (int i = 0; i < 2; ++i) { const int p = tid + 512 * i; { const int c = p >> 4, pc = p & 15; *(v4u*)(gop + GOP_QB + (c * 128 + pc * 8) * 2) = *(const v4u*)(qb + c * 136 + pc * 8); }
        { const int r = p >> 3, pc = p & 7; *(v4u*)(gop + GOP_KD + (r * 64 + pc * 8) * 2) = *(const v4u*)(kdT + r * 72 + pc * 8); } }
#pragma unroll
    for (int i = 0; i < 4; ++i) { const int p = tid + 512 * i, r = p >> 3, pc = p & 7; *(v4u*)(gvt + r * 64 + pc * 8) = *(const v4u*)(vTL + r * 72 + pc * 8); }
    if (tid < 32) *(f32x4*)(gop + GOP_DEC + tid * 16) = *(const f32x4*)(decv + tid * 4);
    __syncthreads();
}

constexpr int GS_P = 0, GS_QB = 9216, GS_KD = 26624, GS_VT = 45056, GS_DEC = 49664, GS_SLOT = 50176, GS_ST = 2 * GS_SLOT;
__device__ __forceinline__ void gla_scan_unit(Frame& F, int unit) {
    const int dvs = unit & 7, h = (unit >> 3) & 3, b = (unit >> 5) & 1, d = unit >> 6;
    const unsigned char* gop0 = F.ws + WS_GLA + (size_t)(((d * 2 + b) * 4 + h) * NSC) * GOP_SZ;
    const unsigned short* gvt0 = (const unsigned short*)(F.ws + WS_MB) + (size_t)(((d * 2 + b) * 4 + h) * NSC) * (256 * 64) + dvs * 32 * 64;
    unsigned short* OGp = (unsigned short*)(F.ws + WS_OG) + (size_t)d * MROWS * 1024 + h * 256 + dvs * 32;
    unsigned char* L = F.lds; unsigned short* ST16 = (unsigned short*)(L + GS_ST);
    const int tid = F.tid, lane = F.lane, w = F.wave, l15 = lane & 15, quad = lane >> 4;
    v4u rg[4][6];
#define GS_LOAD(set, chn) do { const unsigned char* g_ = gop0 + (size_t)(chn) * GOP_SZ; \
        rg[set][0] = *(const GAS v4u*)(g_ + GOP_P + tid * 16); rg[set][1] = *(const GAS v4u*)(g_ + GOP_QB + tid * 16); rg[set][2] = *(const GAS v4u*)(g_ + GOP_QB + (tid + 512) * 16); \
        rg[set][3] = *(const GAS v4u*)(g_ + GOP_KD + tid * 16); rg[set][4] = *(const GAS v4u*)(g_ + GOP_KD + (tid + 512) * 16); \
        if (tid < 256) rg[set][5] = *(const GAS v4u*)(gvt0 + (size_t)(chn) * (256 * 64) + tid * 8); else if (tid < 288) rg[set][5] = *(const GAS v4u*)(g_ + GOP_DEC + (tid - 256) * 16); } while (0)
#define GS_STORE(set, slot) do { unsigned char* s_ = L + (slot) * GS_SLOT; \
        *(v4u*)(s_ + GS_P + ((tid >> 3) * 72 + (tid & 7) * 8) * 2) = rg[set][0]; \
        *(v4u*)(s_ + GS_QB + ((tid >> 4) * 136 + (tid & 15) * 8) * 2) = rg[set][1]; *(v4u*)(s_ + GS_QB + (((tid + 512) >> 4) * 136 + (tid & 15) * 8) * 2) = rg[set][2]; \
        *(v4u*)(s_ + GS_KD + ((tid >> 3) * 72 + (tid & 7) * 8) * 2) = rg[set][3]; *(v4u*)(s_ + GS_KD + (((tid + 512) >> 3) * 72 + (tid & 7) * 8) * 2) = rg[set][4]; \
        if (tid < 256) *(v4u*)(s_ + GS_VT + ((tid >> 3) * 72 + (tid & 7) * 8) * 2) = rg[set][5]; else if (tid < 288) *(v4u*)(s_ + GS_DEC + (tid - 256) * 16) = rg[set][5]; } while (0)
    for (int i = tid; i < 32 * 136 / 2; i += 512) ((unsigned*)ST16)[i] = 0u;
    f32x4 sacc[2];
    sacc[0] = (f32x4){0.f, 0.f, 0.f, 0.f}; sacc[1] = sacc[0];
    GS_LOAD(0, 0); GS_STORE(0, 0); GS_LOAD(1, 1); GS_LOAD(2, 2); GS_LOAD(3, 3);
    LBAR();
    for (int cb = 0; cb < NSC; cb += 4) {
#pragma unroll
        for (int u = 0; u < 4; ++u) { const int ch = cb + u;
            if (ch + 4 < NSC) GS_LOAD(u, ch + 4);
            const unsigned char* S = L + (u & 1) * GS_SLOT; const unsigned short* STc = ST16 + (u & 1) * (32 * 136); unsigned short* STn = ST16 + ((u + 1) & 1) * (32 * 136);
            const unsigned short* Pm = (const unsigned short*)(S + GS_P); const unsigned short* qb = (const unsigned short*)(S + GS_QB);
            const unsigned short* kdT = (const unsigned short*)(S + GS_KD); const unsigned short* vT = (const unsigned short*)(S + GS_VT); const float* decv = (const float*)(S + GS_DEC);
            { const int tdv = w >> 2, tc = w & 3; f32x4 acc = {0.f, 0.f, 0.f, 0.f};
#pragma unroll
              for (int kb = 0; kb < 2; ++kb) { const bf16x8 af = *(const bf16x8*)(vT + (16 * tdv + l15) * 72 + kb * 32 + quad * 8), bfr = *(const bf16x8*)(Pm + (16 * tc + l15) * 72 + kb * 32 + quad * 8); acc = mfma16(af, bfr, acc); }
#pragma unroll
              for (int kb = 0; kb < 4; ++kb) { const bf16x8 af = *(const bf16x8*)(STc + (16 * tdv + l15) * 136 + kb * 32 + quad * 8), bfr = *(const bf16x8*)(qb + (16 * tc + l15) * 136 + kb * 32 + quad * 8); acc = mfma16(af, bfr, acc); }
              const int c = 16 * tc + l15; const int row = gla_row(b, d, ch * 64 + c);
              v2u o; o.x = pk2(acc[0], acc[1]); o.y = pk2(acc[2], acc[3]);
              *(GAS v2u*)(OGp + (size_t)row * 1024 + 16 * tdv + quad * 4) = o; }
            { const float dec = decv[16 * w + l15];
#pragma unroll
              for (int tdv = 0; tdv < 2; ++tdv) { f32x4 acc = sacc[tdv] * dec;
#pragma unroll
                  for (int kb = 0; kb < 2; ++kb) { const bf16x8 af = *(const bf16x8*)(vT + (16 * tdv + l15) * 72 + kb * 32 + quad * 8), bfr = *(const bf16x8*)(kdT + (16 * w + l15) * 72 + kb * 32 + quad * 8); acc = mfma16(af, bfr, acc); }
                  sacc[tdv] = acc;
#pragma unroll
                  for (int jj = 0; jj < 4; ++jj) STn[(16 * tdv + quad * 4 + jj) * 136 + 16 * w + l15] = (unsigned short)f2bf(acc[jj]); } }
            if (ch + 1 < NSC) GS_STORE((u + 1) & 3, (u + 1) & 1);
            LBAR();
        }
    }
    __syncthreads();
#undef GS_LOAD
#undef GS_STORE
}

constexpr int S5_KK = 0, S5_UT = 32768, S5_UPITCH = 2064, S5_HE = S5_UT + 16 * S5_UPITCH, S5_HI = S5_HE + 8192, S5_HPITCH = 136, S5_PARK = 81920;
struct Cx { float x, y; };
__device__ __forceinline__ Cx cmul(Cx a, Cx b) { Cx r; r.x = a.x * b.x - a.y * b.y; r.y = a.x * b.y + a.y * b.x; return r; }
__device__ __forceinline__ Cx cpow_lam(float xr, float xi, float n) { const float m = __expf(n * xr); const float s = __sinf(n * xi), c = __cosf(n * xi); Cx r; r.x = m * c; r.y = m * s; return r; }
__device__ __forceinline__ Cx s5_coef(float lre, float lim, float dt) {
    const float em1 = __expf(lre * dt) - 1.0f, th = lim * dt, sh = __sinf(0.5f * th), cm1 = -2.0f * sh * sh, sn = __sinf(th);
    const float nr = em1 * (1.0f + cm1) + cm1, ni = (1.0f + em1) * sn, den = lre * lre + lim * lim;
    Cx r; r.x = (nr * lre + ni * lim) / den; r.y = (ni * lre - nr * lim) / den; return r;
}
template <int VAR> __device__ __forceinline__ void s5_unit(Frame& F, int l, int unit) {
    const int g = unit & 63, b = (unit >> 6) & 1, d = unit >> 7, gi = (l * 2 + d) * 64 + g;
    const unsigned short* PROJ = (const unsigned short*)(F.ws + WS_PROJ);
    unsigned short* YS = (unsigned short*)(F.ws + (d ? WS_ZC : WS_YS0));
    unsigned char* L = F.lds;
    unsigned short* KK = (unsigned short*)(L + S5_KK); float* HE = (float*)(L + S5_HE); unsigned short* HI = (unsigned short*)(L + S5_HI);
    const int tid = F.tid, lane = F.lane, w = F.wave, l15 = lane & 15, q = lane >> 4;
    const float* are = kin<I_S5ARE>() + gi * 64; const float* aim = kin<I_S5AIM>() + gi * 64; const float dt = expf(kin<I_S5LDT>()[gi]);
    Cx l8[16], cpw[16];
    const float* cre = kin<I_S5CRE>() + ((size_t)gi * 16 + l15) * 64; const float* cim = kin<I_S5CIM>() + ((size_t)gi * 16 + l15) * 64;
#define S5_INIT(n0) do { _Pragma("unroll") for (int k_ = 0; k_ < 16; ++k_) { const int p_ = 32 * (k_ >> 3) + 8 * q + (k_ & 7); Cx c_; c_.x = cre[p_]; c_.y = cim[p_]; \
        const float xr_ = fminf(are[p_], -1e-4f) * dt, xi_ = aim[p_] * dt; cpw[k_] = cmul(c_, cpow_lam(xr_, xi_, (float)(n0))); } } while (0)
#define S5_L8() do { _Pragma("unroll") for (int k_ = 0; k_ < 16; ++k_) { const int p_ = 32 * (k_ >> 3) + 8 * q + (k_ & 7); l8[k_] = cpow_lam(fminf(are[p_], -1e-4f) * dt, aim[p_] * dt, 8.f); } } while (0)
    S5_L8(); S5_INIT(w);
    v4u Bm[4];
    { const float* bre = kin<I_S5BRE>() + (size_t)gi * 64 * 16; const float* bim = kin<I_S5BIM>() + (size_t)gi * 64 * 16; float vr[16], vi[16];
#pragma unroll
      for (int k = 0; k < 16; ++k) { const int p = 32 * (k >> 3) + 8 * q + (k & 7); const float lre = fminf(are[p], -1e-4f), lim = aim[p];
          const Cx cf_ = s5_coef(lre, lim, dt); const float cr = cf_.x, ci = cf_.y; const float br = bre[p * 16 + l15], bi = bim[p * 16 + l15];
          vr[k] = cr * br - ci * bi; vi[k] = cr * bi + ci * br; }
      Bm[0] = (v4u){pk2(vr[0], vr[1]), pk2(vr[2], vr[3]), pk2(vr[4], vr[5]), pk2(vr[6], vr[7])}; Bm[1] = (v4u){pk2(vr[8], vr[9]), pk2(vr[10], vr[11]), pk2(vr[12], vr[13]), pk2(vr[14], vr[15])};
      Bm[2] = (v4u){pk2(vi[0], vi[1]), pk2(vi[2], vi[3]), pk2(vi[4], vi[5]), pk2(vi[6], vi[7])}; Bm[3] = (v4u){pk2(vi[8], vi[9]), pk2(vi[10], vi[11]), pk2(vi[12], vi[13]), pk2(vi[14], vi[15])}; }
#define S5_CF(cf) do { \
        cf[0] = (v4u){pk2(cpw[0].x, cpw[1].x), pk2(cpw[2].x, cpw[3].x), pk2(cpw[4].x, cpw[5].x), pk2(cpw[6].x, cpw[7].x)}; cf[1] = (v4u){pk2(cpw[8].x, cpw[9].x), pk2(cpw[10].x, cpw[11].x), pk2(cpw[12].x, cpw[13].x), pk2(cpw[14].x, cpw[15].x)}; \
        cf[2] = (v4u){pk2(-cpw[0].y, -cpw[1].y), pk2(-cpw[2].y, -cpw[3].y), pk2(-cpw[4].y, -cpw[5].y), pk2(-cpw[6].y, -cpw[7].y)}; cf[3] = (v4u){pk2(-cpw[8].y, -cpw[9].y), pk2(-cpw[10].y, -cpw[11].y), pk2(-cpw[12].y, -cpw[13].y), pk2(-cpw[14].y, -cpw[15].y)}; } while (0)
#define S5_STEP8() do { _Pragma("unroll") for (int k_ = 0; k_ < 16; ++k_) cpw[k_] = cmul(cpw[k_], l8[k_]); } while (0)
#pragma unroll 1
    for (int k = 0; k < 8; ++k) { const int n = w + 8 * k; v4u cf[4]; S5_CF(cf);
        f32x4 acc = {0.f, 0.f, 0.f, 0.f};
#pragma unroll
        for (int ks = 0; ks < 4; ++ks) acc = mfma16b(cf[ks], Bm[ks], acc);
#pragma unroll
        for (int jj = 0; jj < 4; ++jj) KK[(n * 16 + 4 * q + jj) * 16 + l15] = (unsigned short)f2bf(acc[jj]);
        S5_STEP8(); }
    const int p2 = (16 * w + l15) & 63; const bool isim = w >= 4; const int j0 = 8 * (q & 1);
    Cx cur; cur.x = 0.f; cur.y = 0.f;
    LAS float* PS = (LAS float*)((LAS unsigned char*)L + S5_PARK) + tid;
    { Cx bb[8], lam2, pst, l64;
    { const float lre = fminf(are[p2], -1e-4f), lim = aim[p2]; const Cx cf_ = s5_coef(lre, lim, dt); const float cr = cf_.x, ci = cf_.y;
      const float* bre = kin<I_S5BRE>() + ((size_t)gi * 64 + p2) * 16 + j0; const float* bim = kin<I_S5BIM>() + ((size_t)gi * 64 + p2) * 16 + j0;
#pragma unroll
      for (int e = 0; e < 8; ++e) { bb[e].x = cr * bre[e] - ci * bim[e]; bb[e].y = cr * bim[e] + ci * bre[e]; }
      lam2 = cpow_lam(lre * dt, lim * dt, 2.f); pst = cpow_lam(lre * dt, lim * dt, (float)(1 - (q >> 1)));
      const int p3 = lane; const float lre3 = fminf(are[p3], -1e-4f) * dt, lim3 = aim[p3] * dt; l64 = cpow_lam(lre3, lim3, 64.f); }
#pragma unroll
    for (int e = 0; e < 8; ++e) { PS[(2 * e) * 512] = bb[e].x; PS[(2 * e + 1) * 512] = bb[e].y; }
    PS[16 * 512] = lam2.x; PS[17 * 512] = lam2.y; PS[18 * 512] = pst.x; PS[19 * 512] = pst.y; PS[20 * 512] = l64.x; PS[21 * 512] = l64.y; }
    v4u z4[4];
#define S5_ULOAD(mt_) do { _Pragma("unroll") for (int i_ = 0; i_ < 4; ++i_) { const int pc_ = tid + 512 * i_, mm_ = pc_ >> 7, s_ = (pc_ & 127) >> 1, hf_ = pc_ & 1, ch_ = 16 * (mt_) + mm_; \
        z4[i_] = (v4u){0u, 0u, 0u, 0u}; if (ch_ < NSC) z4[i_] = *(const GAS v4u*)((const GAS unsigned short*)PROJ + (size_t)seq_row(b, d, ch_ * 64 + s_) * INP + C_S5 + g * 16 + 8 * hf_); } } while (0)
    S5_ULOAD(0);
    __syncthreads();
#pragma unroll 1
    for (int mt = 0; mt < 5; ++mt) {
        {
#pragma unroll
          for (int i = 0; i < 4; ++i) { const int pc = tid + 512 * i, mm = pc >> 7, s = (pc & 127) >> 1, hf = pc & 1;
              *(LAS v4u*)((LAS unsigned char*)L + S5_UT + mm * S5_UPITCH + (s * 16 + 8 * hf) * 2) = z4[i]; } }
        __syncthreads();
        { f32x4 acc = {0.f, 0.f, 0.f, 0.f}; Cx bb[8], lam2, pp;
#pragma unroll
          for (int e = 0; e < 8; ++e) { bb[e].x = PS[(2 * e) * 512]; bb[e].y = PS[(2 * e + 1) * 512]; }
          lam2.x = PS[16 * 512]; lam2.y = PS[17 * 512]; pp.x = PS[18 * 512]; pp.y = PS[19 * 512];
#pragma unroll 4
          for (int ks = (VAR == 2 ? -1 : 31); ks >= 0; --ks) { float v[8];
#pragma unroll
              for (int e = 0; e < 8; ++e) v[e] = isim ? (pp.x * bb[e].y + pp.y * bb[e].x) : (pp.x * bb[e].x - pp.y * bb[e].y);
              const v4u bf = (v4u){pk2(v[0], v[1]), pk2(v[2], v[3]), pk2(v[4], v[5]), pk2(v[6], v[7])};
              const v4u af = *(const v4u*)(L + S5_UT + l15 * S5_UPITCH + (ks * 32 + 8 * q) * 2);
              acc = mfma16b(af, bf, acc); pp = cmul(pp, lam2); }
#pragma unroll
          for (int jj = 0; jj < 4; ++jj) HE[(4 * q + jj) * 128 + 16 * w + l15] = acc[jj]; }
        __syncthreads();
        if (w == 0) { Cx l64; l64.x = PS[20 * 512]; l64.y = PS[21 * 512];
#pragma unroll 4
            for (int mm = 0; mm < 16; ++mm) { HI[mm * S5_HPITCH + lane] = (unsigned short)f2bf(cur.x); HI[mm * S5_HPITCH + 64 + lane] = (unsigned short)f2bf(cur.y);
                Cx he; he.x = HE[mm * 128 + lane]; he.y = HE[mm * 128 + 64 + lane]; const Cx t = cmul(l64, cur); cur.x = t.x + he.x; cur.y = t.y + he.y; } }
        __syncthreads();
        { v4u hf4[4]; f32x4 acc[8];
#pragma unroll
          for (int ks = 0; ks < 4; ++ks) hf4[ks] = *(const v4u*)(HI + l15 * S5_HPITCH + 32 * ks + 8 * q);
          S5_INIT(w + 1);
#pragma unroll
          for (int k = 0; k < 8; ++k) { v4u cf[4]; S5_CF(cf); f32x4 a_ = {0.f, 0.f, 0.f, 0.f};
#pragma unroll
              for (int ks = 0; ks < 4; ++ks) a_ = mfma16b(hf4[ks], cf[ks], a_);
              acc[k] = a_; S5_STEP8(); }
          const LAS unsigned char* ua = (const LAS unsigned char*)L + S5_UT + l15 * S5_UPITCH + 16 * q; const LAS unsigned short* kq = (const LAS unsigned short*)KK + l15 * 16 + 8 * (q & 1);
          if (VAR != 1) {
#pragma unroll 1
          for (int r = 0; r < 4; ++r) { v4u kfw[8];
#pragma unroll
              for (int dl = 0; dl < 8; ++dl) { const int lag = w - 2 * r + 8 * dl - (q >> 1); kfw[dl] = (v4u){0u, 0u, 0u, 0u}; if (lag >= 0) kfw[dl] = *(const LAS v4u*)(kq + lag * 256); }
#pragma unroll
              for (int m = 0; m < 8; ++m) { const v4u af = *(const LAS v4u*)(ua + (r + 4 * m) * 64);
#pragma unroll
                  for (int k = m; k < 8; ++k) acc[k] = mfma16b(af, kfw[k - m], acc[k]); } } }
          if (mt + 1 < 5) S5_ULOAD(mt + 1);
#pragma unroll
          for (int k = 0; k < 8; ++k) { const int t = w + 8 * k;
#pragma unroll
              for (int jj = 0; jj < 4; ++jj) { const int ch = 16 * mt + 4 * q + jj; if (ch < NSC) ((GAS unsigned short*)YS)[(size_t)seq_row(b, d, ch * 64 + t) * 1024 + g * 16 + l15] = (unsigned short)f2bf(acc[k][jj]); } } }
        __syncthreads();
    }
#undef S5_CF
#undef S5_INIT
#undef S5_L8
#undef S5_STEP8
#undef S5_ULOAD
}
struct ZaIn { v2u a[4], bq[4], u[4]; };
__device__ __forceinline__ void za_load(Frame& F, int row, ZaIn& I) {
    const GAS unsigned short* y0 = (const GAS unsigned short*)(F.ws + WS_YS0) + (size_t)row * 1024 + 16 * F.lane; const GAS unsigned short* y1 = (const GAS unsigned short*)(F.ws + WS_ZC) + (size_t)row * 1024 + 16 * F.lane;
    const GAS unsigned short* up = (const GAS unsigned short*)(F.ws + WS_PROJ) + (size_t)row * INP + C_S5 + 16 * F.lane;
#pragma unroll
    for (int j = 0; j < 4; ++j) { I.a[j] = *(const GAS v2u*)(y0 + 4 * j); I.bq[j] = *(const GAS v2u*)(y1 + 4 * j); I.u[j] = *(const GAS v2u*)(up + 4 * j); }
}
struct ZaPar { f32x4 dv[4]; };
__device__ __forceinline__ void za_params(Frame& F, int l, ZaPar& P) { const GAS float* dp = (const GAS float*)kin<I_S5D>() + l * 1024 + 16 * F.lane;
#pragma unroll
    for (int j = 0; j < 4; ++j) P.dv[j] = *(const GAS f32x4*)(dp + 4 * j); }
__device__ __forceinline__ void za_finish(Frame& F, int l, int row, const ZaIn& I, const ZaPar& P) {
    GAS unsigned short* za = (GAS unsigned short*)(F.ws + WS_ZA) + (size_t)row * 1024 + 16 * F.lane;
#pragma unroll
    for (int j = 0; j < 4; ++j) { const f32x4 dv = P.dv[j];
        v2u o; o.x = pk2(gelu_tanh(bflo(I.a[j].x) + bflo(I.bq[j].x) + dv.x * bflo(I.u[j].x)), gelu_tanh(bfhi(I.a[j].x) + bfhi(I.bq[j].x) + dv.y * bfhi(I.u[j].x)));
        o.y = pk2(gelu_tanh(bflo(I.a[j].y) + bflo(I.bq[j].y) + dv.z * bflo(I.u[j].y)), gelu_tanh(bfhi(I.a[j].y) + bfhi(I.bq[j].y) + dv.w * bfhi(I.u[j].y)));
        *(GAS v2u*)(za + 4 * j) = o; }
}
__device__ __forceinline__ void za_row(Frame& F, int l, int row) { ZaIn I; ZaPar P; za_params(F, l, P); za_load(F, row, I); za_finish(F, l, row, I, P); }

template <int NCOLT> struct EpiStoreBf16 {
    static constexpr bool PERM = true, AFTER_DRAIN = false;
    unsigned short* O; int ldc;
    __device__ __forceinline__ void operator()(const pg8::f32x4 (&acc)[2][2][4][2], const pg8::Unit& u, int wr, int wc, int fr, int fq) const {
        const int row0 = u.pm * 256 + wr * 64 + fr, col0 = (NCOLT ? (u.pn % NCOLT) : u.pn) * 256 + wc * 32 + 8 * fq;
#pragma unroll
        for (int ai = 0; ai < 2; ++ai)
#pragma unroll
            for (int m = 0; m < 4; ++m) { unsigned short* rowp = O + (size_t)(row0 + ai * 128 + m * 16) * ldc + col0;
#pragma unroll
                for (int bj = 0; bj < 2; ++bj) { const pg8::f32x4 v0 = acc[ai][bj][m][0], v1 = acc[ai][bj][m][1];
                    v4u w; w.x = pg8::cvt_pk_bf16(v0[0], v0[1]); w.y = pg8::cvt_pk_bf16(v0[2], v0[3]); w.z = pg8::cvt_pk_bf16(v1[0], v1[1]); w.w = pg8::cvt_pk_bf16(v1[2], v1[3]);
                    *(v4u*)(rowp + bj * 128) = w; } }
    }
};
__device__ __forceinline__ f32x4 sig4_bf(const unsigned short* p) { const v2u g = *(const v2u*)p; f32x4 r; r.x = sigmoidf_(bflo(g.x)); r.y = sigmoidf_(bfhi(g.x)); r.z = sigmoidf_(bflo(g.y)); r.w = sigmoidf_(bfhi(g.y)); return r; }
__device__ __forceinline__ void epi_glu_body(const pg8::f32x4 (&acc)[2][2][4][2], float* __restrict__ MF, const unsigned short* __restrict__ PROJ, int row0, int oc0) {
#pragma unroll
    for (int ai = 0; ai < 2; ++ai)
#pragma unroll
        for (int m = 0; m < 4; ++m) { const int r = row0 + ai * 128 + m * 16;
#pragma unroll
            for (int n = 0; n < 2; ++n) { const int oc = oc0 + 16 * n; const f32x4 ga = sig4_bf(PROJ + (size_t)r * INP + C_GA + oc);
                const pg8::f32x4 val = acc[ai][0][m][n], gt = acc[ai][1][m][n]; f32x4 o;
                o.x = ga.x * val[0] * sigmoidf_(gt[0]); o.y = ga.y * val[1] * sigmoidf_(gt[1]); o.z = ga.z * val[2] * sigmoidf_(gt[2]); o.w = ga.w * val[3] * sigmoidf_(gt[3]);
                *(f32x4*)(MF + (size_t)r * DM + oc) = o; } }
}
struct EpiGlu {
    static constexpr bool PERM = false, AFTER_DRAIN = false;
    float* MF; const unsigned short* PROJ;
    __device__ __forceinline__ void operator()(const pg8::f32x4 (&acc)[2][2][4][2], const pg8::Unit& u, int wr, int wc, int fr, int fq) const {
        epi_glu_body(acc, MF, PROJ, u.pm * 256 + wr * 64 + fr, u.pn * 128 + wc * 32 + 4 * fq);
    }
};
template <int MODE> __device__ __forceinline__ void epi_acc_body(const pg8::f32x4 (&acc)[2][2][4][2], float* __restrict__ MF, unsigned short* __restrict__ MB, const unsigned short* __restrict__ PROJ, int gcol, const float* __restrict__ modg, int row0, int c0, const float* __restrict__ xs = nullptr) {
#pragma unroll
    for (int ai = 0; ai < 2; ++ai)
#pragma unroll
        for (int m = 0; m < 4; ++m) { const int r = row0 + ai * 128 + m * 16; f32x4 g[4], o[4];
#pragma unroll
            for (int i = 0; i < 4; ++i) { const int c = c0 + (i >> 1) * 128 + (i & 1) * 16;
                if (MODE >= 2) g[i] = *(const f32x4*)(modg + (size_t)row_modidx(r) * 12288 + c); else g[i] = sig4_bf(PROJ + (size_t)r * INP + gcol + c);
                if (MODE == 3) o[i] = *(const f32x4*)(xs + (size_t)r * DM + c); else o[i] = *(const f32x4*)(MF + (size_t)r * DM + c); }
#pragma unroll
            for (int i = 0; i < 4; ++i) { const int c = c0 + (i >> 1) * 128 + (i & 1) * 16; const pg8::f32x4 v = acc[ai][i >> 1][m][i & 1];
                o[i].x += g[i].x * v[0]; o[i].y += g[i].y * v[1]; o[i].z += g[i].z * v[2]; o[i].w += g[i].w * v[3];
                if (MODE == 1) { v2u w; w.x = pk2(o[i].x, o[i].y); w.y = pk2(o[i].z, o[i].w); *(v2u*)(MB + (size_t)r * DM + c) = w; } else *(f32x4*)(MF + (size_t)r * DM + c) = o[i]; } }
}
template <int MODE> struct EpiAcc {
    static constexpr bool PERM = false, AFTER_DRAIN = false;
    float* MF; unsigned short* MB; const unsigned short* PROJ; int gcol; const float* modg;
    __device__ __forceinline__ void operator()(const pg8::f32x4 (&acc)[2][2][4][2], const pg8::Unit& u, int wr, int wc, int fr, int fq) const {
        epi_acc_body<MODE>(acc, MF, MB, PROJ, gcol, modg, u.pm * 256 + wr * 64 + fr, u.pn * 256 + wc * 32 + 4 * fq);
    }
};
struct EpiAccX0 {
    static constexpr bool PERM = false, AFTER_DRAIN = false;
    float* X; const float* xlat; const float* xctx; const float* modg;
    __device__ __forceinline__ void operator()(const pg8::f32x4 (&acc)[2][2][4][2], const pg8::Unit& u, int wr, int wc, int fr, int fq) const {
        const float* xs = u.pm < MLAT / 256 ? xlat : xctx - (size_t)MLAT * DM;
        epi_acc_body<3>(acc, X, nullptr, nullptr, 0, modg, u.pm * 256 + wr * 64 + fr, u.pn * 256 + wc * 32 + 4 * fq, xs);
    }
};
struct EpiMoe1 {
    static constexpr bool PERM = false, AFTER_DRAIN = false;
    unsigned short* HID;
    __device__ __forceinline__ void operator()(const pg8::f32x4 (&acc)[2][2][4][2], const pg8::Unit& u, int wr, int wc, int fr, int fq) const {
        const int row0 = u.pm * 256 + wr * 64 + fr, hc0 = (u.pn & 1) * 128 + wc * 32 + 4 * fq;
#pragma unroll
        for (int ai = 0; ai < 2; ++ai)
#pragma unroll
            for (int m = 0; m < 4; ++m) { const int r = row0 + ai * 128 + m * 16;
#pragma unroll
                for (int n = 0; n < 2; ++n) { const pg8::f32x4 gt = acc[ai][0][m][n], up = acc[ai][1][m][n];
                    v2u w; w.x = pk2(siluf_(gt[0]) * up[0], siluf_(gt[1]) * up[1]); w.y = pk2(siluf_(gt[2]) * up[2], siluf_(gt[3]) * up[3]);
                    *(v2u*)(HID + (size_t)r * 256 + hc0 + 16 * n) = w; } }
    }
};

__device__ __forceinline__ void st_wt16(__amdgpu_buffer_rsrc_t rs, int off, f32x4 v) { __builtin_amdgcn_raw_buffer_store_b128(__builtin_bit_cast(v4u, v), rs, off, 0, 16); }
__device__ __forceinline__ void mrg_wait(unsigned* cnt, unsigned need, unsigned* tmo) {
    unsigned spins = 0;
    while ((unsigned)__builtin_amdgcn_readfirstlane((int)__hip_atomic_load((gu32*)cnt, RLX_AGENT)) < need) { __builtin_amdgcn_s_sleep(2);
        if (++spins > (1u << 20)) { __hip_atomic_store((gu32*)tmo, 0x4d5247u, RLX_AGENT); break; } }
    __builtin_amdgcn_fence(__ATOMIC_ACQUIRE, "agent"); asm volatile("s_waitcnt vmcnt(0)" ::: "memory");
}
__device__ __forceinline__ void mrg_publish(unsigned* cnt, bool leader) { asm volatile("s_waitcnt vmcnt(0)" ::: "memory"); if (leader) __hip_atomic_fetch_add((gu32*)cnt, 1u, RLX_AGENT); }
__device__ __forceinline__ void epi_glu_wt(const pg8::f32x4 (&acc)[2][2][4][2], __amdgpu_buffer_rsrc_t rs, const unsigned short* __restrict__ PROJ, int row0, int oc0) {
#pragma unroll
    for (int ai = 0; ai < 2; ++ai)
#pragma unroll
        for (int m = 0; m < 4; ++m) { const int r = row0 + ai * 128 + m * 16;
#pragma unroll
            for (int n = 0; n < 2; ++n) { const int oc = oc0 + 16 * n; const f32x4 ga = sig4_bf(PROJ + (size_t)r * INP + C_GA + oc);
                const pg8::f32x4 val = acc[ai][0][m][n], gt = acc[ai][1][m][n]; f32x4 o;
                o.x = ga.x * val[0] * sigmoidf_(gt[0]); o.y = ga.y * val[1] * sigmoidf_(gt[1]); o.z = ga.z * val[2] * sigmoidf_(gt[2]); o.w = ga.w * val[3] * sigmoidf_(gt[3]);
                st_wt16(rs, (r * DM + oc) * 4, o); } }
}
template <int MODE> __device__ __forceinline__ void epi_acc_wt(const pg8::f32x4 (&acc)[2][2][4][2], __amdgpu_buffer_rsrc_t rs, float* __restrict__ MF, unsigned short* __restrict__ MB, const unsigned short* __restrict__ PROJ, int gcol, int row0, int c0) {
#pragma unroll
    for (int ai = 0; ai < 2; ++ai)
#pragma unroll
        for (int m = 0; m < 4; ++m) { const int r = row0 + ai * 128 + m * 16; f32x4 g[4], o[4];
#pragma unroll
            for (int i = 0; i < 4; ++i) { const int c = c0 + (i >> 1) * 128 + (i & 1) * 16; g[i] = sig4_bf(PROJ + (size_t)r * INP + gcol + c); o[i] = *(const GAS f32x4*)(MF + (size_t)r * DM + c); }
#pragma unroll
            for (int i = 0; i < 4; ++i) { const int c = c0 + (i >> 1) * 128 + (i & 1) * 16; const pg8::f32x4 v = acc[ai][i >> 1][m][i & 1];
                o[i].x += g[i].x * v[0]; o[i].y += g[i].y * v[1]; o[i].z += g[i].z * v[2]; o[i].w += g[i].w * v[3];
                if (MODE == 1) { v2u w; w.x = pk2(o[i].x, o[i].y); w.y = pk2(o[i].z, o[i].w); *(v2u*)(MB + (size_t)r * DM + c) = w; } else st_wt16(rs, (r * DM + c) * 4, o[i]); } }
}
struct MergeOrder {
    int nM, G, c, lo, hi;
    __device__ __forceinline__ bool next(int i, pg8::Unit& u) const { const int L = lo + i * G + c; if (L >= hi) return false;
        if (L < nM * 16) { u.pm = L >> 4; u.pn = L & 15; } else if (L < nM * 24) { const int r = L - nM * 16; u.pm = 34 + (r >> 3); u.pn = 16 + (r & 7); } else { const int r = L - nM * 24; u.pm = 68 + (r >> 3); u.pn = 24 + (r & 7); }
        return true; }
    __device__ __forceinline__ void a_ready(const pg8::Unit&) const {}
    __device__ __forceinline__ void done(const pg8::Unit&) const {}
};
struct GluCtxOrder {
    int c;
    __device__ __forceinline__ bool next(int i, pg8::Unit& u) const {
        int q;
        if (i == 0) { if (c < 32) { u.pm = 32 + (c >> 4); u.pn = c & 15; return true; } q = c - 32; }
        else if (i == 1) { if (c < 16) { u.pm = 34 + 32 + (c >> 3); u.pn = 16 + (c & 7); return true; } q = 224 + c - 16; }
        else if (i == 2) { if (c < 16) { u.pm = 68 + 32 + (c >> 3); u.pn = 24 + (c & 7); return true; } q = 464 + c - 16; if (q >= 512) return false; }
        else return false;
        u.pm = q >> 4; u.pn = q & 15; return true; }
    __device__ __forceinline__ void a_ready(const pg8::Unit&) const {}
    __device__ __forceinline__ void done(const pg8::Unit&) const {}
};
struct EpiMergeCtx {
    static constexpr bool PERM = false, AFTER_DRAIN = false;
    float* MF; unsigned short* MB; const unsigned short* PROJ; unsigned* cnt; unsigned* tmo;
    __device__ __forceinline__ void operator()(const pg8::f32x4 (&acc)[2][2][4][2], const pg8::Unit& u, int wr, int wc, int fr, int fq) const {
        const int type = u.pm >= 68 ? 2 : (u.pm >= 34 ? 1 : 0), pm = u.pm - 34 * type; const bool leader = (fr == 0 && fq == 0);
        const int row0 = pm * 256 + wr * 64 + fr;
        if (type == 0 && pm < MLAT / 256) { epi_glu_body(acc, MF, PROJ, row0, u.pn * 128 + wc * 32 + 4 * fq); return; }
        const __amdgpu_buffer_rsrc_t rs = __builtin_amdgcn_make_buffer_rsrc((void*)MF, 0, MROWS * DM * 4, 0x00020000);
        if (type == 0) { unsigned* c = cnt + (pm * 8 + (u.pn >> 1)) * 16; epi_glu_wt(acc, rs, PROJ, row0, u.pn * 128 + wc * 32 + 4 * fq); mrg_publish(c, leader); }
        else if (type == 1) { const int pn = u.pn - 16; unsigned* c = cnt + (pm * 8 + pn) * 16; mrg_wait(c, 16u, tmo); epi_acc_wt<0>(acc, rs, MF, MB, PROJ, C_GB, row0, pn * 256 + wc * 32 + 4 * fq); mrg_publish(c, leader); }
        else { const int pn = u.pn - 24; unsigned* c = cnt + (pm * 8 + pn) * 16; mrg_wait(c, 24u, tmo); epi_acc_wt<1>(acc, rs, MF, MB, PROJ, C_GC, row0, pn * 256 + wc * 32 + 4 * fq); }
    }
};
struct EpiMerge {
    static constexpr bool PERM = false, AFTER_DRAIN = false;
    float* MF; unsigned short* MB; const unsigned short* PROJ; unsigned* cnt; unsigned* tmo;
    __device__ __forceinline__ void operator()(const pg8::f32x4 (&acc)[2][2][4][2], const pg8::Unit& u, int wr, int wc, int fr, int fq) const {
        const int type = u.pm >= 68 ? 2 : (u.pm >= 34 ? 1 : 0), pm = u.pm - 34 * type; const bool leader = (fr == 0 && fq == 0);
        const int row0 = pm * 256 + wr * 64 + fr;
        const __amdgpu_buffer_rsrc_t rs = __builtin_amdgcn_make_buffer_rsrc((void*)MF, 0, MROWS * DM * 4, 0x00020000);
        if (type == 0) { unsigned* c = cnt + (pm * 8 + (u.pn >> 1)) * 16; epi_glu_wt(acc, rs, PROJ, row0, u.pn * 128 + wc * 32 + 4 * fq); mrg_publish(c, leader); }
        else if (type == 1) { const int pn = u.pn - 16; unsigned* c = cnt + (pm * 8 + pn) * 16; mrg_wait(c, 16u, tmo); epi_acc_wt<0>(acc, rs, MF, MB, PROJ, C_GB, row0, pn * 256 + wc * 32 + 4 * fq); mrg_publish(c, leader); }
        else { const int pn = u.pn - 24; unsigned* c = cnt + (pm * 8 + pn) * 16; mrg_wait(c, 24u, tmo); epi_acc_wt<1>(acc, rs, MF, MB, PROJ, C_GC, row0, pn * 256 + wc * 32 + 4 * fq); }
    }
};
template <int NN> struct DenseOrder {
    int nM, G, c;
    __device__ __forceinline__ bool next(int i, pg8::Unit& u) const { const int L = i * G + c; if (L >= nM * NN) return false; u.pm = L / NN; u.pn = L % NN; return true; }
    __device__ __forceinline__ void a_ready(const pg8::Unit&) const {}
    __device__ __forceinline__ void done(const pg8::Unit&) const {}
};
struct InProjOrder {
    int npc, G, c;
    __device__ __forceinline__ bool next(int i, pg8::Unit& u) const { const int L = i * G + c; if (L >= 32 * 54 + 2 * npc) return false;
        if (L < 32 * 54) { u.pm = L / 54; u.pn = L % 54; } else { const int r = L - 32 * 54; u.pm = 32 + r / npc; u.pn = r % npc; } return true; }
    __device__ __forceinline__ void a_ready(const pg8::Unit&) const {}
    __device__ __forceinline__ void done(const pg8::Unit&) const {}
};
struct InProjXcdOrder {
    int npc, c;
    __device__ __forceinline__ bool next(int i, pg8::Unit& u) const { const int x = c & 7, e = i * 32 + (c >> 3);
        if (e < 216) { u.pm = 4 * x + (e & 3); u.pn = e >> 2; return true; }
        const int j = (e - 216) * 8 + x; if (j >= 2 * npc) return false;
        u.pm = 32 + j / npc; u.pn = j % npc; return true; }
    __device__ __forceinline__ void a_ready(const pg8::Unit&) const {}
    __device__ __forceinline__ void done(const pg8::Unit&) const {}
};
struct InProjDeferOrder {
    int G, c;
    __device__ __forceinline__ bool next(int i, pg8::Unit& u) const { const int L = i * G + c; if (L >= 50) return false; u.pm = 32 + L / 25; u.pn = 29 + L % 25; return true; }
    __device__ __forceinline__ void a_ready(const pg8::Unit&) const {}
    __device__ __forceinline__ void done(const pg8::Unit&) const {}
};
template <int NPN> struct MoeOrder {
    const int* tile_e; int ntiles, G, c;
    __device__ __forceinline__ bool next(int i, pg8::Unit& u) const { const int cx = (G & 7) ? c : ((c & 7) * (G >> 3) + (c >> 3));
        const int L = i * G + cx; if (L >= ntiles * NPN) return false; const int t = L / NPN, j = L % NPN;
        u.pm = t; u.pn = __builtin_amdgcn_readfirstlane(tile_e[t]) * NPN + j; return true; }
    __device__ __forceinline__ void a_ready(const pg8::Unit&) const {}
    __device__ __forceinline__ void done(const pg8::Unit&) const {}
};

template <int NPN> struct MoeGatherOrder {
    static constexpr bool GATHER = true;
    const LAS int* tile_e; const LAS int* seg; const GAS int* postab; int ntiles, G, c;
    __device__ __forceinline__ bool next(int i, pg8::Unit& u) const { const int cx = (G & 7) ? c : ((c & 7) * (G >> 3) + (c >> 3));
        const int L = i * G + cx; if (L >= ntiles * NPN) return false; const int t = L / NPN, j = L % NPN;
        u.pm = t; u.pn = __builtin_amdgcn_readfirstlane(tile_e[t]) * NPN + j; return true; }
    __device__ __forceinline__ int src_row(const pg8::Unit& u, int r) const { const int e = tile_e[u.pm], p = u.pm * 256 + r - seg[e]; return p < seg[33 + e] ? postab[e * POSTAB_CAP + p] : 0; }
    __device__ __forceinline__ void a_ready(const pg8::Unit&) const {}
    __device__ __forceinline__ void done(const pg8::Unit&) const {}
};
constexpr size_t TB_WGH = 512 * 1024, TB_WGL = 768 * 1024;
__device__ __forceinline__ void ph_wg_split(const Args& a, Frame& F, int l) {
    unsigned short* WGH = (unsigned short*)(F.ws + WS_TAB + TB_WGH); unsigned short* WGL = (unsigned short*)(F.ws + WS_TAB + TB_WGL);
    const float* wg1 = kin<I_MWG1>() + (size_t)l * DM * 4; const float* wg2 = kin<I_MWG2>() + (size_t)l * DM * 32;
    for (int i = F.bid * 512 + F.tid; i < 48 * DM; i += F.G * 512) { const int n = i / DM, k = i % DM;
        const float w = n < 4 ? wg1[(size_t)k * 4 + n] : (n < 36 ? wg2[(size_t)k * 32 + (n - 4)] : 0.f);
        const int fo = ((((k >> 5) * 3 + (n >> 4)) * 64) + ((k >> 3) & 3) * 16 + (n & 15)) * 8 + (k & 7);
        const unsigned hi = f2bf(w); WGH[fo] = (unsigned short)hi; WGL[fo] = (unsigned short)f2bf(w - __builtin_bit_cast(float, hi << 16)); }
}
__device__ __forceinline__ void router_kloop(const float* __restrict__ xr, const float* __restrict__ g2, const float* __restrict__ sh, const float* __restrict__ sc, unsigned short* __restrict__ ur,
                                             const unsigned short* __restrict__ bh, const unsigned short* __restrict__ bl, float rs, f32x4 (&acc)[3]) {
#pragma unroll 2
        for (int ks = 0; ks < 64; ++ks) { const int ko = 32 * ks;
            const f32x4 x0 = *(const f32x4*)(xr + ko), x1 = *(const f32x4*)(xr + ko + 4), g0 = *(const f32x4*)(g2 + ko), g1 = *(const f32x4*)(g2 + ko + 4);
            const f32x4 s0 = *(const f32x4*)(sh + ko), s1 = *(const f32x4*)(sh + ko + 4), c0 = *(const f32x4*)(sc + ko), c1 = *(const f32x4*)(sc + ko + 4);
            const f32x4 y0 = (x0 * rs * g0) * (1.0f + c0) + s0, y1 = (x1 * rs * g1) * (1.0f + c1) + s1;
            const float yy[8] = {y0.x, y0.y, y0.z, y0.w, y1.x, y1.y, y1.z, y1.w};
            unsigned hb[8], lb[8];
#pragma unroll
            for (int e = 0; e < 8; ++e) { hb[e] = f2bf(yy[e]); lb[e] = f2bf(yy[e] - __builtin_bit_cast(float, hb[e] << 16)); }
            v4u hv, lv; hv.x = hb[0] | (hb[1] << 16); hv.y = hb[2] | (hb[3] << 16); hv.z = hb[4] | (hb[5] << 16); hv.w = hb[6] | (hb[7] << 16);
            lv.x = lb[0] | (lb[1] << 16); lv.y = lb[2] | (lb[3] << 16); lv.z = lb[4] | (lb[5] << 16); lv.w = lb[6] | (lb[7] << 16);
            *(v4u*)(ur + ko) = hv;
            const bf16x8 ah = __builtin_bit_cast(bf16x8, hv), al = __builtin_bit_cast(bf16x8, lv);
#pragma unroll
            for (int ct = 0; ct < 3; ++ct) { const bf16x8 wh = *(const bf16x8*)(bh + (size_t)ct * 16 * DM + ko), wl = *(const bf16x8*)(bl + (size_t)ct * 16 * DM + ko);
                acc[ct] = mfma16(ah, wh, acc[ct]); acc[ct] = mfma16(ah, wl, acc[ct]); acc[ct] = mfma16(al, wh, acc[ct]); } }
}
__device__ __forceinline__ void router_tile_pass2(const f32x4 (&x)[8][2], float rs, const float* __restrict__ Ar, const float* __restrict__ Br, GAS unsigned short* __restrict__ ur,
                                                  const GAS unsigned short* __restrict__ bh, const GAS unsigned short* __restrict__ bl, f32x4 (&acc)[3]) {
    bf16x8 W[2][6];
#pragma unroll
    for (int ct = 0; ct < 3; ++ct) { W[0][2 * ct] = *(const GAS bf16x8*)(bh + ct * 512); W[0][2 * ct + 1] = *(const GAS bf16x8*)(bl + ct * 512); }
#pragma unroll
    for (int s = 0; s < 8; ++s) { const int ko = 32 * s;
        if (s + 1 < 8) {
#pragma unroll
            for (int ct = 0; ct < 3; ++ct) { W[(s + 1) & 1][2 * ct] = *(const GAS bf16x8*)(bh + ((s + 1) * 3 + ct) * 512); W[(s + 1) & 1][2 * ct + 1] = *(const GAS bf16x8*)(bl + ((s + 1) * 3 + ct) * 512); } }
        __builtin_amdgcn_sched_barrier(0);
        const f32x4 a0 = *(const f32x4*)(Ar + ko), a1 = *(const f32x4*)(Ar + ko + 4), b0 = *(const f32x4*)(Br + ko), b1 = *(const f32x4*)(Br + ko + 4);
        const f32x4 y0 = (x[s][0] * rs) * a0 + b0, y1 = (x[s][1] * rs) * a1 + b1;
        const float yy[8] = {y0.x, y0.y, y0.z, y0.w, y1.x, y1.y, y1.z, y1.w};
        unsigned hb[8], lb[8];
#pragma unroll
        for (int e = 0; e < 8; ++e) { hb[e] = f2bf(yy[e]); lb[e] = f2bf(yy[e] - __builtin_bit_cast(float, hb[e] << 16)); }
        v4u hv, lv; hv.x = hb[0] | (hb[1] << 16); hv.y = hb[2] | (hb[3] << 16); hv.z = hb[4] | (hb[5] << 16); hv.w = hb[6] | (hb[7] << 16);
        lv.x = lb[0] | (lb[1] << 16); lv.y = lb[2] | (lb[3] << 16); lv.z = lb[4] | (lb[5] << 16); lv.w = lb[6] | (lb[7] << 16);
        *(GAS v4u*)(ur + ko) = hv;
        const bf16x8 ah = __builtin_bit_cast(bf16x8, hv), al = __builtin_bit_cast(bf16x8, lv);
#pragma unroll
        for (int ct = 0; ct < 3; ++ct) { const bf16x8 wh = W[s & 1][2 * ct], wl = W[s & 1][2 * ct + 1];
            acc[ct] = mfma16(ah, wh, acc[ct]); acc[ct] = mfma16(ah, wl, acc[ct]); acc[ct] = mfma16(al, wh, acc[ct]); } }
}
__device__ __forceinline__ void ph_router(const Args& a, Frame& F, int l, int nrows, bool count) {
    const GAS float* X = (const GAS float*)(F.ws + WS_X); GAS unsigned short* U = (GAS unsigned short*)(F.ws + WS_U);
    const GAS float* MOD = (const GAS float*)(F.ws + WS_MOD);
    const GAS unsigned short* WGH = (const GAS unsigned short*)(F.ws + WS_TAB + TB_WGH); const GAS unsigned short* WGL = (const GAS unsigned short*)(F.ws + WS_TAB + TB_WGL);
    int* EXPERT = (int*)(F.ws + WS_TAB + TB_EXPERT); float* RWT = (float*)(F.ws + WS_TAB + TB_RWT);
    const GAS float* g2base = (const GAS float*)kin<I_G2>() + l * DM; const float* bg1 = kin<I_MBG1>() + l * 4; const float* bg2 = kin<I_MBG2>() + l * 32;
    float* Am = (float*)F.lds; float* Bm = Am + 3 * DM; float* ssP = Bm + 3 * DM; float* red = ssP + 128; float* lgs = red + 8 * 16 * 48;
    const int lane = F.lane, l15 = lane & 15, q = lane >> 4, w = F.wave;
    { float gg[12], s1[12], s0[12];
#pragma unroll
      for (int j = 0; j < 12; ++j) { const int i = F.tid + j * NWAVES * 64, mr = i / DM, c = i % DM; const GAS float* sh = MOD + ((size_t)(l * 3 + mr)) * 12288 + 3 * DM; gg[j] = g2base[c]; s1[j] = sh[DM + c]; s0[j] = sh[c]; }
#pragma unroll
      for (int j = 0; j < 12; ++j) { const int i = F.tid + j * NWAVES * 64; Am[i] = gg[j] * (1.0f + s1[j]); Bm[i] = s0[j]; } }
    float* bias = lgs + 16 * 48;
    if (F.tid < 48) bias[F.tid] = F.tid < 4 ? ((const GAS float*)bg1)[F.tid] : (F.tid < 36 ? ((const GAS float*)bg2)[F.tid - 4] : 0.f);
    int pend_row = -1, pend_e0 = 0, pend_e1 = 0; unsigned pend_p0 = 0u, pend_p1 = 0u;
    __syncthreads();
    for (int tile = F.bid; tile < nrows / 16; tile += F.G) {
        const int row = tile * 16 + l15, mr = row_modidx(tile * 16);
        const GAS float* xr = X + (size_t)row * DM + 256 * w + 8 * q;
        f32x4 x[8][2];
#pragma unroll
        for (int s = 0; s < 8; ++s) { x[s][0] = *(const GAS f32x4*)(xr + 32 * s); x[s][1] = *(const GAS f32x4*)(xr + 32 * s + 4); }
        float ss = 0.f;
#pragma unroll
        for (int s = 0; s < 8; ++s) ss += (x[s][0].x * x[s][0].x + x[s][0].y * x[s][0].y) + (x[s][0].z * x[s][0].z + x[s][0].w * x[s][0].w) + (x[s][1].x * x[s][1].x + x[s][1].y * x[s][1].y) + (x[s][1].z * x[s][1].z + x[s][1].w * x[s][1].w);
        ss += __shfl_xor(ss, 16); ss += __shfl_xor(ss, 32);
        if (q == 0) ssP[w * 16 + l15] = ss;
        __syncthreads();
        float tot = 0.f;
#pragma unroll
        for (int ww = 0; ww < 8; ++ww) tot += ssP[ww * 16 + l15];
        const float rs = 1.0f / sqrtf(tot * (1.0f / DM) + 1e-6f);
        GAS unsigned short* ur = U + (size_t)row * LDU + 256 * w + 8 * q;
        const GAS unsigned short* bh = WGH + (size_t)(24 * w) * 512 + lane * 8; const GAS unsigned short* bl = WGL + (size_t)(24 * w) * 512 + lane * 8;
        const float* Ar = Am + mr * DM + 256 * w + 8 * q; const float* Br = Bm + mr * DM + 256 * w + 8 * q;
        f32x4 acc[3];
#pragma unroll
        for (int i = 0; i < 3; ++i) acc[i] = (f32x4){0.f, 0.f, 0.f, 0.f};
        router_tile_pass2(x, rs, Ar, Br, ur, bh, bl, acc);
#pragma unroll
        for (int ct = 0; ct < 3; ++ct)
#pragma unroll
            for (int jj = 0; jj < 4; ++jj) red[(w * 16 + 4 * q + jj) * 48 + 16 * ct + l15] = acc[ct][jj];
        __syncthreads();
        for (int o = F.tid; o < 16 * 48; o += NWAVES * 64) { float s_ = 0.f;
#pragma unroll
            for (int ww = 0; ww < 8; ++ww) s_ += red[ww * 768 + o];
            lgs[o] = s_ + bias[o % 48]; }
        __syncthreads();
        if (F.tid < 16) { const float* lg = lgs + F.tid * 48; const int orow = tile * 16 + F.tid;
            float mx = -3.0e38f; int grp = 0; float l1[4];
#pragma unroll
            for (int e = 0; e < 4; ++e) { l1[e] = lg[e]; if (l1[e] > mx) { mx = l1[e]; grp = e; } }
            float den = 0.f;
#pragma unroll
            for (int e = 0; e < 4; ++e) den += expf(l1[e] - mx);
            const float ptop = 1.0f / den;
            float v0 = -3.0e38f, v1 = -3.0e38f; int i0 = 0, i1 = 0;
            for (int e = 0; e < 8; ++e) { const float x = lg[4 + grp * 8 + e];
                if (x > v0) { v1 = v0; i1 = i0; v0 = x; i0 = e; } else if (x > v1) { v1 = x; i1 = e; } }
            const float w0 = ptop / (1.0f + expf(v1 - v0)), w1 = ptop - w0;
            const int e0 = grp * 8 + i0, e1 = grp * 8 + i1; EXPERT[orow * 2] = e0; EXPERT[orow * 2 + 1] = e1; RWT[orow * 2] = w0; RWT[orow * 2 + 1] = w1;
            if (count) { int* SLOT = (int*)(F.ws + WS_TAB + TB_SLOT);
                int* POSTAB = (int*)(F.ws + WS_POSTAB);
                if (pend_row >= 0) { SLOT[pend_row * 2] = (int)pend_p0; SLOT[pend_row * 2 + 1] = (int)pend_p1; POSTAB[pend_e0 * POSTAB_CAP + (int)pend_p0] = pend_row; POSTAB[pend_e1 * POSTAB_CAP + (int)pend_p1] = pend_row; }
                pend_p0 = __hip_atomic_fetch_add((unsigned*)(F.ctl + CW_CNT + l * 64 + e0), 1u, RLX_AGENT); pend_p1 = __hip_atomic_fetch_add((unsigned*)(F.ctl + CW_CNT + l * 64 + e1), 1u, RLX_AGENT); pend_row = orow; pend_e0 = e0; pend_e1 = e1; } }
    }
    if (F.tid < 16 && pend_row >= 0) { int* SLOT = (int*)(F.ws + WS_TAB + TB_SLOT); int* POSTAB = (int*)(F.ws + WS_POSTAB); SLOT[pend_row * 2] = (int)pend_p0; SLOT[pend_row * 2 + 1] = (int)pend_p1;
        POSTAB[pend_e0 * POSTAB_CAP + (int)pend_p0] = pend_row; POSTAB[pend_e1 * POSTAB_CAP + (int)pend_p1] = pend_row; }
    __syncthreads();
}
__device__ __forceinline__ void ph_scatter(const Args& a, Frame& F, int l, int nrows) {
    int* seg = (int*)F.lds;
    if (F.tid < 64) {
        const int e = F.tid & 31; const int c = (int)__hip_atomic_load((unsigned*)(F.ctl + CW_CNT + l * 64 + e), RLX_AGENT); const int pad = (c + 255) & ~255; int s = pad;
#pragma unroll
        for (int off = 1; off < 32; off <<= 1) { const int t = __shfl_up(s, off, 32); if (e >= off) s += t; }
        if (F.tid < 32) { seg[e] = s - pad; seg[33 + e] = c; if (e == 31) seg[32] = s; } }
    __syncthreads();
    int* SEG = (int*)(F.ws + WS_TAB + TB_SEG) + l * 40; int* TILEE = (int*)(F.ws + WS_TAB + TB_TILEE) + l * 128;
    if (F.bid == 0) { if (F.tid <= 32) SEG[F.tid] = seg[F.tid]; if (F.tid == 0) SEG[36] = seg[32] >> 8;
        if (F.tid < 128) { const int t = F.tid; int e = 0; for (int q = 0; q < 32; ++q) if (t * 256 >= seg[q]) e = q; TILEE[t] = e; } }
    const int gw = F.bid * NWAVES + F.wave, NGW = F.G * NWAVES;
    const int* EXPERT = (const int*)(F.ws + WS_TAB + TB_EXPERT); int* SLOT = (int*)(F.ws + WS_TAB + TB_SLOT);
    const unsigned short* U = (const unsigned short*)(F.ws + WS_U); unsigned short* VG = (unsigned short*)(F.ws + WS_VG);
    int* ROWIDX = (int*)(F.ws + WS_TAB + TB_ROWIDX);
    for (int q = F.bid * (NWAVES * 64) + F.tid; q < nrows * 2; q += F.G * NWAVES * 64) { const int slot = seg[EXPERT[q]] + SLOT[q]; SLOT[q] = slot; ROWIDX[slot] = q >> 1; }
    for (int idx = F.bid * (NWAVES * 64) + F.tid; idx < 32 * 256; idx += F.G * NWAVES * 64) { const int e = idx >> 8, i = idx & 255, c = seg[33 + e]; if (c + i < ((c + 255) & ~255)) ROWIDX[seg[e] + c + i] = 0; }
    (void)gw; (void)NGW; (void)U; (void)VG;
}

#ifndef MK_PER_PHASE
#define MK_PER_PHASE 0
#endif
#ifndef CTX_FOLD
#define CTX_FOLD 1
#endif
#ifndef RW_SCAN_VAR
#define RW_SCAN_VAR 0
#endif
#ifndef S5_PREP_UNITS_LAST
#define S5_PREP_UNITS_LAST 64
#endif
#ifndef S5_PREP_UNITS
#define S5_PREP_UNITS 64
#endif
constexpr int PH_PER_LAYER = 14, PH_TOTAL = 2 + NLAY * PH_PER_LAYER + 1;

#ifdef DBG_ONLY
#define LSEL(j) ((j) == DBG_ONLY)
#else
#define LSEL(j) true
#endif
#ifndef CV_EARLY
#define CV_EARLY 1
#endif
#define CVQ_DRAIN(word, lo_, hi_) do { for (;;) { if (F.tid == 0) F.MISC[0] = __hip_atomic_fetch_add((unsigned*)(F.ctl + (word)), 1u, RLX_AGENT); __syncthreads(); const int t_ = (int)F.MISC[0]; __syncthreads(); \
        if ((lo_) + 64 * t_ >= (hi_)) break; ph_convert_range(args, F, l + 1, (lo_) + 64 * t_, ((lo_) + 64 * t_ + 64) < (hi_) ? ((lo_) + 64 * t_ + 64) : (hi_), F.wave, NWAVES); } } while (0)
#define LAUNDER() do { int t_ = threadIdx.x; asm volatile("" : "+v"(t_)); F.tid = t_; F.lane = t_ & 63; GAS unsigned char* w_ = (GAS unsigned char*)args.ws; asm volatile("" : "+s"(w_)); F.ws = (unsigned char*)w_; F.ctl = (gu32*)(w_ + WS_CTL); GAS float* o_ = (GAS float*)args.out; asm volatile("" : "+s"(o_)); F.out = (float*)o_; } while (0)
#ifndef DUP_MASK
#define DUP_MASK 0
#endif
#define REP(j) for (int rep_ = 0; rep_ < (((DUP_MASK) >> (j)) & 1) + 1; ++rep_)
#define IN(k) (lo <= (k) && (k) < hi)
#define BOTH(k) (IN(k) && IN((k) + 1))
#define GRID_BAR() do { if (MK_PER_PHASE) { if (F.tid == 0) __hip_atomic_store(F.ctl + CW_TMO, 0xBADBA0u, RLX_AGENT); } else { xcd_barrier(bar); } } while (0)
template <int l> __device__ __forceinline__ void layer_phases(const Args& args, Frame& F, const XcdBarrier& bar, const int lo, const int hi, unsigned char* lds, LAS unsigned char* ldsl) {
    const int gw = F.bid * NWAVES + F.wave, NGW = F.G * NWAVES;
        const int pb = 2 + l * PH_PER_LAYER;
        const bool lastl = (l == NLAY - 1);
        const int mrows = lastl ? MLAT : MROWS;
        if (LSEL(0) && IN(pb + 0)) { LAUNDER(); ph_convert(args, F, l, (CV_EARLY && l > 0) ? CV_MOE0 : 0); ph_wg_split(args, F, l); ph_lora_split(F, l); ph_gate_split(F, l); __syncthreads(); if ((DUP_MASK) & 1) { ph_convert(args, F, l); __syncthreads(); } ph_rowpass(args, F, l, 0, l > 0 ? 1 : 0, MROWS, MROWS); if (BOTH(pb + 0)) GRID_BAR(); }
        REP(1) if (LSEL(1) && IN(pb + 1)) { LAUNDER();
            pg8::Gemm g{(const pg8::bf16_t*)(F.ws + WS_U), (const pg8::bf16_t*)(F.ws + WS_WIN), MROWS, INP, DM, LDU, LDU};
            EpiStoreBf16<0> E{(unsigned short*)(F.ws + WS_PROJ), INP};
#ifdef INPROJ_XCD
            if (F.G == 256) { InProjXcdOrder S{lastl ? 26 : 29, F.bid}; pg8::gemm_phase<EpiStoreBf16<0>, InProjXcdOrder, true, true>(ldsl + RING_OFF, g, S, E); } else
#endif
            { InProjOrder S{lastl ? 26 : 29, F.G, F.bid};
            pg8::gemm_phase<EpiStoreBf16<0>, InProjOrder, true, true>(ldsl + RING_OFF, g, S, E); }
            if (BOTH(pb + 1)) GRID_BAR();
        }
        REP(2) if (LSEL(2) && IN(pb + 2)) { LAUNDER();
            {
                constexpr int NS5A = (l == NLAY - 1 ? S5_PREP_UNITS_LAST : S5_PREP_UNITS), NRW = 4 * (MROWS / 32), NGL = 16 * NSC;
#define QNEXT(word) ({ if (F.tid == 0) F.MISC[0] = __hip_atomic_fetch_add((unsigned*)(F.ctl + (word)), 1u, RLX_AGENT); LBAR(); const int t_ = (int)F.MISC[0]; LBAR(); t_; })
#define QLOOP_BEGIN(word, N) { int t_ = QNEXT(word); while (t_ < (N)) { unsigned nx_ = 0u; const bool pf_ = t_ + 2 * F.G < (N); if (pf_ && F.tid == 0) nx_ = __hip_atomic_fetch_add((unsigned*)(F.ctl + (word)), 1u, RLX_AGENT); const int t = t_;
#define QLOOP_END(word) if (pf_) { if (F.tid == 0) F.MISC[0] = nx_; LBAR(); t_ = (int)F.MISC[0]; LBAR(); } else t_ = QNEXT(word); } }
                for (;;) { const int t = QNEXT(CW_Q2 + l * 64 + 32 * rep_); if (t >= NS5A) break; s5_unit<0>(F, l, t); }
                {
                  QLOOP_BEGIN(CW_Q2 + l * 64 + 32 * rep_ + 1, NRW) const int dc = t / (MROWS / 32), tb = t % (MROWS / 32);
                      LAUNDER();
                      { RwLora B; rwkv_lora_frags(F, l, dc >> 1, dc & 1, B); rwkv_prep_unit<0>(F, l, dc >> 1, dc & 1, tb, B); }
                      LAUNDER();
#ifndef CP_SEPARATE
                      {
                          const int d_ = dc >> 1, R0 = tb * 32; const bool lat = R0 < MLAT;
                          const int b_ = lat ? (R0 >> 12) : ((R0 - MLAT) >> 8), c0 = lat ? ((R0 & (SEQL - 1)) >> 4) : (((R0 - MLAT) & (CTXL - 1)) >> 4);
                          const int chain = d_ * 32 + b_ * 16 + (dc & 1) * 8 + F.wave;
#pragma unroll 1
                          for (int rt = 0; rt < 2; ++rt) { const int cn = c0 + rt, ci = lat ? CTXL / 16 + (d_ ? SEQL / 16 - 1 - cn : cn) : (d_ ? CTXL / 16 - 1 - cn : cn);
                              rwkv_chunk_prep(F, chain * RW_NCH + ci, lds + F.wave * CP_BYTES); }
                          LBAR(); }
#endif
                  QLOOP_END(CW_Q2 + l * 64 + 32 * rep_ + 1) }
                { GlaGk Gk; Gk.key = -1; GlaPre P; QLOOP_BEGIN(CW_Q2 + l * 64 + 32 * rep_ + 2, NGL) gla_prep_load(F, t, P); gla_prep_unit(args, F, l, t, Gk, P, -1); QLOOP_END(CW_Q2 + l * 64 + 32 * rep_ + 2) }

            }
            if (BOTH(pb + 2)) GRID_BAR();
        }
        REP(3) if (LSEL(3) && IN(pb + 3)) { LAUNDER();
#ifdef CP_SEPARATE
            for (int wu = gw; wu < 64 * RW_NCH; wu += NGW) rwkv_chunk_prep(F, wu, lds + F.wave * CP_BYTES);
            if (BOTH(pb + 3)) GRID_BAR();
#endif
        }
        REP(4) if (LSEL(4) && IN(pb + 4)) { LAUNDER();
            const int nrw = F.G / 4, ngl = F.G / 2;
            unsigned* cp2 = (unsigned*)(F.ctl + CW_CP2 + l * 64 + 32 * rep_);
#ifdef RW_SCAN3
            if (F.bid < nrw) { for (int ci = F.bid; ci < 64; ci += nrw) rwkv_scan3(F, ci); }
#else
            if (F.bid < nrw) { for (int ci = F.bid; ci < 64; ci += nrw) rwkv_scan2<RW_SCAN_VAR>(F, ci, cp2, (unsigned)ngl); }
#endif
            if (F.bid >= nrw && F.bid < nrw + ngl) { for (int j = F.bid - nrw; j < 128; j += ngl) {
                const int u = (ngl == 128 && (nrw & 7) == 0) ? (((j & 7) + 8 * (j >> 6)) * 8 + ((j >> 3) & 7)) : j; gla_scan_unit(F, u); } }
            else if (F.bid >= nrw + ngl) { if (!lastl) {
                pg8::Gemm g{(const pg8::bf16_t*)(F.ws + WS_U), (const pg8::bf16_t*)(F.ws + WS_WIN), MROWS, INP, DM, LDU, LDU};
                InProjDeferOrder S{F.G - nrw - ngl, F.bid - nrw - ngl};
                EpiStoreBf16<0> E{(unsigned short*)(F.ws + WS_PROJ), INP};
                pg8::gemm_phase<EpiStoreBf16<0>, InProjDeferOrder, true, true>(ldsl + RING_OFF, g, S, E); }
            }
            if (F.bid >= nrw) { constexpr int NS5A = (l == NLAY - 1 ? S5_PREP_UNITS_LAST : S5_PREP_UNITS); const int cap = F.bid < nrw + ngl ? 1 : 256;
                for (int n = 0; n < cap; ++n) { const int t = QNEXT(CW_Q4 + l * 64 + 32 * rep_); if (t >= 256 - NS5A) break; s5_unit<0>(F, l, NS5A + t); } }
            __syncthreads();
#ifdef EXTRA_ROLE
            GRID_BAR();
            if (EXTRA_ROLE == 1) { if (F.bid < F.G / 4) { for (int ci = F.bid; ci < 64; ci += F.G / 4) rwkv_scan2<0>(F, ci, cp2, 0u); } }
            if (EXTRA_ROLE == 11) { if (F.bid < F.G / 4) { for (int ci = F.bid; ci < 64; ci += F.G / 4) rwkv_scan2<1>(F, ci, cp2, 0u); } }
            if (EXTRA_ROLE == 2) { if (F.bid >= F.G / 4 && F.bid < F.G / 4 + F.G / 2) { for (int u = F.bid - F.G / 4; u < 128; u += F.G / 2) gla_scan_unit(F, u); } }
            if (EXTRA_ROLE == 3) { unsigned short* Hb = (unsigned short*)(lds + F.wave * 12800); float* Ul = (float*)(lds + F.wave * 12800 + 8704);
              for (;;) { int t = 0; if (F.lane == 0) t = (int)__hip_atomic_fetch_add((unsigned*)(F.ctl + CW_S5Q + l * 64 + 48), 1u, RLX_AGENT);
                  t = __builtin_amdgcn_readfirstlane(t); if (t >= 2 * 64 * NSC) break; s5_final(args, F, l, t, Hb, Ul); } }
            if (EXTRA_ROLE == 7) { for (int u = F.bid; u < 256; u += F.G) s5_unit<0>(F, l, u); }
            if (EXTRA_ROLE == 9) { for (int u = F.bid; u < 256; u += F.G) s5_unit<1>(F, l, u); }
            if (EXTRA_ROLE == 10) { for (int u = F.bid; u < 256; u += F.G) s5_unit<2>(F, l, u); }
            if (EXTRA_ROLE == 5) { GlaGk Gk; Gk.key = -1; GlaPre P; if (F.bid < 16 * NSC) gla_prep_load(F, F.bid, P); for (int u = F.bid; u < 16 * NSC; u += F.G) gla_prep_unit(args, F, l, u, Gk, P, u + F.G < 16 * NSC ? u + F.G : -1); }
            __syncthreads();
#endif
            if (BOTH(pb + 4)) GRID_BAR();
        }
        if (LSEL(5) && IN(pb + 5)) { LAUNDER();
            for (int rp = 0; rp < 1 + (((DUP_MASK) >> 5) & 1); ++rp)
            { const int ntb = mrows / 32;
              { ZbGate B; zb_gate_frags(F, l, 0, B); for (int v = F.bid; v < ntb; v += F.G) zb_unit(F, l, 0, v, B); }
              { ZbGate B; zb_gate_frags(F, l, 1, B); for (int v = F.bid; v < 2 * ntb; v += F.G) if (v >= ntb) zb_unit(F, l, 1, v - ntb, B); } }
            if (((DUP_MASK) >> 20) & 1) for (int row = gw; row < mrows; row += NGW) za_row(F, l, row);
            { ZaPar ZP; za_params(F, l, ZP);
            for (int r0 = gw; r0 < mrows; r0 += 5 * NGW) { ZaIn I[5];
#pragma unroll
                for (int k = 0; k < 5; ++k) if (r0 + k * NGW < mrows) za_load(F, r0 + k * NGW, I[k]);
#pragma unroll
                for (int k = 0; k < 5; ++k) if (r0 + k * NGW < mrows) za_finish(F, l, r0 + k * NGW, I[k], ZP); } }
            asm volatile("s_waitcnt vmcnt(0)" ::: "memory");
            { ZcPar ZP; zc_params(F, l, ZP);
            for (int r0 = gw; r0 < mrows; r0 += 5 * NGW) { ZcIn I[5];
#pragma unroll
                for (int k = 0; k < 5; ++k) if (r0 + k * NGW < mrows) zc_load(F, r0 + k * NGW, I[k]);
#pragma unroll
                for (int k = 0; k < 5; ++k) if (r0 + k * NGW < mrows) zc_finish(F, l, r0 + k * NGW, I[k], ZP); } }
            if (((DUP_MASK) >> 21) & 1) { asm volatile("s_waitcnt vmcnt(0)" ::: "memory"); for (int row = gw; row < mrows; row += NGW) zc_row(args, F, l, row); }
            if (BOTH(pb + 5)) GRID_BAR();
        }
#ifdef MIX_A
        REP(6) if (LSEL(6) && IN(pb + 6)) { LAUNDER();
            pg8::Gemm g{(const pg8::bf16_t*)(F.ws + WS_ZA), (const pg8::bf16_t*)(F.ws + WS_WGLU), 3 * MROWS, 8192, 1024, 1024, 1024};
            const int nM_ = mrows / 256; MergeOrder S{nM_, F.G, F.bid, 0, nM_ * 16};
            EpiMerge E{(float*)(F.ws + WS_MF), (unsigned short*)(F.ws + WS_MB), (const unsigned short*)(F.ws + WS_PROJ), (unsigned*)(F.ctl + CW_MRG + l * MRG_LSTRIDE), (unsigned*)(F.ctl + CW_TMO)};
            pg8::gemm_phase<EpiMerge, MergeOrder, true, true>(ldsl + RING_OFF, g, S, E);
            GRID_BAR();
        }
        REP(7) if (LSEL(7) && IN(pb + 7)) { LAUNDER();
            pg8::Gemm g{(const pg8::bf16_t*)(F.ws + WS_ZB), (const pg8::bf16_t*)(F.ws + WS_WRW), mrows, DM, 1024, 1024, 1024};
            pg8::StaticOrder S; S.init(mrows, DM, F.G, F.bid);
            EpiAcc<0> E{(float*)(F.ws + WS_MF), nullptr, (const unsigned short*)(F.ws + WS_PROJ), C_GB, nullptr};
            pg8::gemm_phase<EpiAcc<0>, pg8::StaticOrder, true, true>(ldsl + RING_OFF, g, S, E);
            if (BOTH(pb + 7)) GRID_BAR();
        }
        REP(8) if (LSEL(8) && IN(pb + 8)) { LAUNDER();
            pg8::Gemm g{(const pg8::bf16_t*)(F.ws + WS_ZC), (const pg8::bf16_t*)(F.ws + WS_WGL), mrows, DM, 1024, 1024, 1024};
            pg8::StaticOrder S; S.init(mrows, DM, F.G, F.bid);
            EpiAcc<1> E{(float*)(F.ws + WS_MF), (unsigned short*)(F.ws + WS_MB), (const unsigned short*)(F.ws + WS_PROJ), C_GC, nullptr};
            pg8::gemm_phase<EpiAcc<1>, pg8::StaticOrder, true, true>(ldsl + RING_OFF, g, S, E);
            if (BOTH(pb + 8)) GRID_BAR();
        }
#elif defined(MIX_B)
        REP(6) if (LSEL(6) && IN(pb + 6)) { LAUNDER();
            pg8::Gemm g{(const pg8::bf16_t*)(F.ws + WS_ZA), (const pg8::bf16_t*)(F.ws + WS_WGLU), mrows, 4096, 1024, 1024, 1024};
            pg8::StaticOrder S; S.init(mrows, 4096, F.G, F.bid);
            EpiGlu E{(float*)(F.ws + WS_MF), (const unsigned short*)(F.ws + WS_PROJ)};
            pg8::gemm_phase<EpiGlu, pg8::StaticOrder, true, true>(ldsl + RING_OFF, g, S, E);
            if (BOTH(pb + 6)) GRID_BAR();
        }
        REP(7) if (LSEL(7) && IN(pb + 7)) { LAUNDER();
            pg8::Gemm g{(const pg8::bf16_t*)(F.ws + WS_ZA), (const pg8::bf16_t*)(F.ws + WS_WGLU), 3 * MROWS, 8192, 1024, 1024, 1024};
            const int nM_ = mrows / 256;
            for (int part = 1; part < 3; ++part) { MergeOrder S{nM_, F.G, F.bid, part == 1 ? nM_ * 16 : nM_ * 24, part == 1 ? nM_ * 24 : nM_ * 32};
            EpiMerge E{(float*)(F.ws + WS_MF), (unsigned short*)(F.ws + WS_MB), (const unsigned short*)(F.ws + WS_PROJ), (unsigned*)(F.ctl + CW_MRG + l * MRG_LSTRIDE), (unsigned*)(F.ctl + CW_TMO)};
            pg8::gemm_phase<EpiMerge, MergeOrder, true, true>(ldsl + RING_OFF, g, S, E); GRID_BAR(); }
        }
#elif defined(OLD_MERGE)
        const bool ctxfold = CTX_FOLD && !lastl && F.G == 256;
        const int mrows_rg = ctxfold ? MLAT : mrows;
        REP(6) if (LSEL(6) && IN(pb + 6)) { LAUNDER();
            if (ctxfold) {
                pg8::Gemm g{(const pg8::bf16_t*)(F.ws + WS_ZA), (const pg8::bf16_t*)(F.ws + WS_WGLU), 3 * MROWS, 8192, 1024, 1024, 1024};
                GluCtxOrder S{F.bid};
                EpiMergeCtx E{(float*)(F.ws + WS_MF), (unsigned short*)(F.ws + WS_MB), (const unsigned short*)(F.ws + WS_PROJ), (unsigned*)(F.ctl + CW_MRG + l * MRG_LSTRIDE), (unsigned*)(F.ctl + CW_TMO)};
                pg8::gemm_phase<EpiMergeCtx, GluCtxOrder, true, true>(ldsl + RING_OFF, g, S, E);
            } else {
            pg8::Gemm g{(const pg8::bf16_t*)(F.ws + WS_ZA), (const pg8::bf16_t*)(F.ws + WS_WGLU), mrows, 4096, 1024, 1024, 1024};
            pg8::StaticOrder S; S.init(mrows, 4096, F.G, F.bid);
            EpiGlu E{(float*)(F.ws + WS_MF), (const unsigned short*)(F.ws + WS_PROJ)};
            pg8::gemm_phase<EpiGlu, pg8::StaticOrder, true, true>(ldsl + RING_OFF, g, S, E); }
            if constexpr (CV_EARLY && l + 1 < NLAY) { LAUNDER(); CVQ_DRAIN(CW_CVQ + l * 64, 0, CV_MRG0); }
            if (BOTH(pb + 6)) GRID_BAR();
        }
        REP(7) if (LSEL(7) && IN(pb + 7)) { LAUNDER();
            pg8::Gemm g{(const pg8::bf16_t*)(F.ws + WS_ZB), (const pg8::bf16_t*)(F.ws + WS_WRW), mrows_rg, DM, 1024, 1024, 1024};
            pg8::StaticOrder S; S.init(mrows_rg, DM, F.G, F.bid);
            EpiAcc<0> E{(float*)(F.ws + WS_MF), nullptr, (const unsigned short*)(F.ws + WS_PROJ), C_GB, nullptr};
            pg8::gemm_phase<EpiAcc<0>, pg8::StaticOrder, true, true>(ldsl + RING_OFF, g, S, E);
            if (BOTH(pb + 7)) GRID_BAR();
        }
        REP(8) if (LSEL(8) && IN(pb + 8)) { LAUNDER();
            pg8::Gemm g{(const pg8::bf16_t*)(F.ws + WS_ZC), (const pg8::bf16_t*)(F.ws + WS_WGL), mrows_rg, DM, 1024, 1024, 1024};
            pg8::StaticOrder S; S.init(mrows_rg, DM, F.G, F.bid);
            EpiAcc<1> E{(float*)(F.ws + WS_MF), (unsigned short*)(F.ws + WS_MB), (const unsigned short*)(F.ws + WS_PROJ), C_GC, nullptr};
            pg8::gemm_phase<EpiAcc<1>, pg8::StaticOrder, true, true>(ldsl + RING_OFF, g, S, E);
            if (BOTH(pb + 8)) GRID_BAR();
        }
#else
        REP(6) if (LSEL(6) && IN(pb + 6)) { LAUNDER();
            pg8::Gemm g{(const pg8::bf16_t*)(F.ws + WS_ZA), (const pg8::bf16_t*)(F.ws + WS_WGLU), 3 * MROWS, 8192, 1024, 1024, 1024};
#ifdef MRG_SPLIT
            const int nM_ = mrows / 256;
            for (int part = 0; part < 3; ++part) { MergeOrder S{nM_, F.G, F.bid, part == 0 ? 0 : (part == 1 ? nM_ * 16 : nM_ * 24), part == 0 ? nM_ * 16 : (part == 1 ? nM_ * 24 : nM_ * 32)};
            EpiMerge E{(float*)(F.ws + WS_MF), (unsigned short*)(F.ws + WS_MB), (const unsigned short*)(F.ws + WS_PROJ), (unsigned*)(F.ctl + CW_MRG + l * MRG_LSTRIDE), (unsigned*)(F.ctl + CW_TMO)};
            pg8::gemm_phase<EpiMerge, MergeOrder, true, true>(ldsl + RING_OFF, g, S, E); GRID_BAR(); }
#else
            MergeOrder S{mrows / 256, F.G, F.bid, 0, (mrows / 256) * 32};
            EpiMerge E{(float*)(F.ws + WS_MF), (unsigned short*)(F.ws + WS_MB), (const unsigned short*)(F.ws + WS_PROJ), (unsigned*)(F.ctl + CW_MRG + l * MRG_LSTRIDE), (unsigned*)(F.ctl + CW_TMO)};
            pg8::gemm_phase<EpiMerge, MergeOrder, true, true>(ldsl + RING_OFF, g, S, E);
            if (BOTH(pb + 6)) GRID_BAR();
#endif
        }
#endif
        REP(9) if (LSEL(9) && IN(pb + 9)) { LAUNDER();
            pg8::Gemm g{(const pg8::bf16_t*)(F.ws + WS_MB), (const pg8::bf16_t*)(F.ws + WS_WOUT), mrows, DM, DM, DM, DM};
            pg8::StaticOrder S; S.init(mrows, DM, F.G, F.bid);
            if constexpr (l == 0) {
                EpiAccX0 E{(float*)(F.ws + WS_X), kin<I_X>(), kin<I_CTX>(), (const float*)(F.ws + WS_MOD) + (size_t)(l * 3) * 12288 + 2 * DM};
                pg8::gemm_phase<EpiAccX0, pg8::StaticOrder, true, true>(ldsl + RING_OFF, g, S, E);
            } else {
                EpiAcc<2> E{(float*)(F.ws + WS_X), nullptr, nullptr, 0, (const float*)(F.ws + WS_MOD) + (size_t)(l * 3) * 12288 + 2 * DM};
                pg8::gemm_phase<EpiAcc<2>, pg8::StaticOrder, true, true>(ldsl + RING_OFF, g, S, E); }
            if (BOTH(pb + 9)) GRID_BAR();
        }
        REP(10) if (LSEL(10) && IN(pb + 10)) { LAUNDER(); ph_router(args, F, l, mrows, rep_ == 0); if (BOTH(pb + 10)) GRID_BAR(); }
        REP(12) if (LSEL(12) && IN(pb + 12)) { LAUNDER();
            LAS int* segL = (LAS int*)(ldsl + RING_BYTES); LAS int* tileL = segL + 96;
            if (F.tid < 64) { const int e = F.tid & 31; const int c = (int)__hip_atomic_load((unsigned*)(F.ctl + CW_CNT + l * 64 + e), RLX_AGENT); const int pad = (c + 255) & ~255; int s = pad;
#pragma unroll
                for (int off = 1; off < 32; off <<= 1) { const int t = __shfl_up(s, off, 32); if (e >= off) s += t; }
                if (F.tid < 32) { segL[e] = s - pad; segL[33 + e] = c; if (e == 31) segL[32] = s; } }
            __syncthreads();
            { int* SEGw = (int*)(F.ws + WS_TAB + TB_SEG) + l * 40; int* TILEEw = (int*)(F.ws + WS_TAB + TB_TILEE) + l * 128;
              if (F.tid < 128) { const int t = F.tid; int e = 0; for (int q = 0; q < 32; ++q) if (t * 256 >= segL[q]) e = q; tileL[t] = e; if (F.bid == 0) TILEEw[t] = e; }
              if (F.bid == 0) { if (F.tid <= 32) SEGw[F.tid] = segL[F.tid]; if (F.tid == 0) SEGw[36] = segL[32] >> 8; } }
            __syncthreads();
            const int nt = __builtin_amdgcn_readfirstlane(segL[32] >> 8);
            pg8::Gemm g{(const pg8::bf16_t*)(F.ws + WS_U), (const pg8::bf16_t*)(F.ws + WS_WGU), MOE_ROWS, 32 * 512, DM, LDU, DM};
            MoeGatherOrder<2> S{tileL, segL, (const GAS int*)(F.ws + WS_POSTAB), nt, F.G, F.bid};
            EpiMoe1 E{(unsigned short*)(F.ws + WS_HID)};
            pg8::gemm_phase<EpiMoe1, MoeGatherOrder<2>, true, true>(ldsl + RING_OFF, g, S, E);
            if constexpr (CV_EARLY && l + 1 < NLAY) { LAUNDER(); CVQ_DRAIN(CW_CVQ + l * 64 + 32, CV_MRG0, CV_MOE0); }
            if (BOTH(pb + 12)) GRID_BAR();
        }
        REP(13) if (LSEL(13) && IN(pb + 13)) { LAUNDER();
            const int* SEG = (const int*)(F.ws + WS_TAB + TB_SEG) + l * 40; const int nt = __builtin_amdgcn_readfirstlane(SEG[36]);
            int kdn = 256; asm volatile("" : "+s"(kdn));
            pg8::Gemm g{(const pg8::bf16_t*)(F.ws + WS_HID), (const pg8::bf16_t*)(F.ws + WS_WDN), MOE_ROWS, 32 * DM, kdn, 256, 256};
            MoeOrder<8> S{(const int*)(F.ws + WS_TAB + TB_TILEE) + l * 128, nt, F.G, F.bid};
            EpiStoreBf16<8> E{(unsigned short*)(F.ws + WS_EO), DM};
            pg8::gemm_phase<EpiStoreBf16<8>, MoeOrder<8>, true, true>(ldsl + RING_OFF, g, S, E);
            if (BOTH(pb + 13)) GRID_BAR();
        }
    }

__global__ void __launch_bounds__(NWAVES * 64, 2) mega_fwd(Args args) {
    extern __shared__ __attribute__((aligned(16))) unsigned char lds[];
    Frame F;
    F.lds = lds; F.MISC = (volatile LAS unsigned*)((LAS unsigned char*)lds + MISC_OFF);
    F.tid = threadIdx.x; F.lane = F.tid & 63; F.wave = __builtin_amdgcn_readfirstlane(F.tid >> 6);
    F.G = gridDim.x; F.bid = blockIdx.x;
    F.ctl = (gu32*)(args.ws + WS_CTL); F.ws = args.ws; F.out = args.out;
    for (int u = F.tid; u < (LDS_BYTES - LDSCTL_OFF) / 4; u += NWAVES * 64) ((LAS unsigned*)((LAS unsigned char*)lds + LDSCTL_OFF))[u] = 0u;
    __syncthreads();
    XcdBarrier bar; bar.bar = (unsigned*)(F.ctl + CW_BAR); bar.x = 0; bar.st = nullptr;
    if (!MK_PER_PHASE) bar = xcd_barrier_post((unsigned*)(F.ctl + CW_BAR), F.MISC + 8);
    const int lo = args.ph_lo, hi = args.ph_hi;
    LAS unsigned char* ldsl = (LAS unsigned char*)lds;
    const int gw = F.bid * NWAVES + F.wave, NGW = F.G * NWAVES;

    if (LSEL(100) && IN(0)) { LAUNDER(); ph_mod_partial(args, F); if (BOTH(0)) GRID_BAR(); }
    if (LSEL(101) && IN(1)) { LAUNDER(); ph_mod_reduce(args, F); if (BOTH(1)) GRID_BAR(); }

    layer_phases<0>(args, F, bar, lo, hi, lds, ldsl);
    layer_phases<1>(args, F, bar, lo, hi, lds, ldsl);
    if (LSEL(102) && IN(PH_TOTAL - 1)) { LAUNDER(); ph_rowpass(args, F, NLAY, 2, 1, MLAT, MLAT); }
}

extern "C" void kernel_launch(void* const* d_in, const int* in_sizes, int n_in, void* d_out, int out_size, void* d_ws, size_t ws_size, hipStream_t stream) {
    static int grid = 0;
    if (grid == 0) {
        if (n_in != N_INPUTS || out_size != MLAT * DM || ws_size < WS_END) { fprintf(stderr, "kernel_launch: unexpected shapes (n_in %d out %d ws %zu)\n", n_in, out_size, ws_size); grid = -1; return; }
        int dev = 0, cus = 0;
        if (hipGetDevice(&dev) != hipSuccess || hipDeviceGetAttribute(&cus, hipDeviceAttributeMultiprocessorCount, dev) != hipSuccess) { grid = -1; return; }
        if (hipFuncSetAttribute((const void*)mega_fwd, hipFuncAttributeMaxDynamicSharedMemorySize, LDS_BYTES) != hipSuccess) { fprintf(stderr, "kernel_launch: hipFuncSetAttribute failed\n"); grid = -1; return; }
        int per_cu = 0;
        if (hipOccupancyMaxActiveBlocksPerMultiprocessor(&per_cu, (const void*)mega_fwd, NWAVES * 64, LDS_BYTES) != hipSuccess || per_cu < 1) fprintf(stderr, "kernel_launch: occupancy query reports %d\n", per_cu);
        (void)hipGetLastError();
        grid = cus;
    }
    if (grid < 0) return;
    if (hipMemsetAsync((char*)d_ws + WS_CTL, 0, CTL_ZERO_BYTES, stream) != hipSuccess) return;
    Args a{};
    for (int i = 0; i < N_INPUTS; ++i) a.in[i] = (const float*)d_in[i];
    a.out = (float*)d_out; a.ws = (unsigned char*)d_ws;
#if MK_PER_PHASE
    for (int p = 0; p < PH_TOTAL; ++p) { a.ph_lo = p; a.ph_hi = p + 1; hipLaunchKernelGGL(mega_fwd, dim3(grid), dim3(NWAVES * 64), LDS_BYTES, stream, a); }
#else
    a.ph_lo = 0; a.ph_hi = PH_TOTAL; hipLaunchKernelGGL(mega_fwd, dim3(grid), dim3(NWAVES * 64), LDS_BYTES, stream, a);
#endif
}
```
